# Optimizing an MI355X kernel written in HIP

```python
import math
import jax, jax.numpy as jnp
from jax import lax
import numpy as np

D_MODEL = 1024
BATCH = 8
SEQ = 2048
DEPTH = 1

D_MIX = D_MODEL
D_A = D_MIX // 2
D_B = D_MIX - D_A
N_GROUPS_A = 8
GROUP_DIM_A = D_A // N_GROUPS_A
HEAD_DIM = 64
N_HEADS_B = D_B // HEAD_DIM
CHUNK = 128
Q_BLOCK = 128
D_IN_PROJ = 3 * D_A + 4 * D_B
LN_EPS = 1e-5
DEEPNORM_ALPHA = (2.0 * DEPTH) ** 0.25
DEEPNORM_BETA = (8.0 * DEPTH) ** -0.25

kernel_name = "hymba_gmlp_stickbreaking_deepnorm_adaln"


def layer_norm(x, g, b):
    xf = x.astype(jnp.float32)
    mu = jnp.mean(xf, axis=-1, keepdims=True)
    var = jnp.mean(jnp.square(xf - mu), axis=-1, keepdims=True)
    y = (xf - mu) * lax.rsqrt(var + LN_EPS) * g.astype(jnp.float32) + b.astype(jnp.float32)
    return y.astype(x.dtype)


def chunked_sgu(u, v, ln_g, ln_b, w_s, b_s):
    bsz, seq, _ = u.shape
    n_chunks = seq // CHUNK
    v = layer_norm(v, ln_g, ln_b)
    v = v.reshape(bsz, n_chunks, CHUNK, N_GROUPS_A, GROUP_DIM_A)
    causal = jnp.tril(jnp.ones((CHUNK, CHUNK), dtype=bool))
    w = jnp.where(causal[None], w_s, 0.0).astype(v.dtype)
    mixed = jnp.einsum('gts,bnsgc->bntgc', w, v) + b_s.T[None, None, :, :, None]
    return u * mixed.reshape(bsz, seq, D_A)


def stick_breaking_attention(q, k, v):
    bsz, n_heads, seq, dh = q.shape
    n_blocks = seq // Q_BLOCK
    scale = 1.0 / math.sqrt(dh)
    q_blocks = q.reshape(bsz, n_heads, n_blocks, Q_BLOCK, dh).transpose(2, 0, 1, 3, 4)
    s_pos = jnp.arange(seq)

    def one_block(args):
        qb, blk = args
        z = jnp.einsum('bhtd,bhsd->bhts', qb, k).astype(jnp.float32) * scale
        t_pos = blk * Q_BLOCK + jnp.arange(Q_BLOCK)
        causal = s_pos[None, :] < t_pos[:, None]
        log_beta = jax.nn.log_sigmoid(z)
        log_1m_beta = jnp.where(causal, -jax.nn.softplus(z), 0.0)
        log_stick = lax.cumsum(log_1m_beta, axis=3, reverse=True) - log_1m_beta
        a = jnp.where(causal, jnp.exp(log_beta + log_stick), 0.0).astype(v.dtype)
        return jnp.einsum('bhts,bhsd->bhtd', a, v)

    out = lax.map(one_block, (q_blocks, jnp.arange(n_blocks)))
    return out.transpose(1, 0, 3, 2, 4).reshape(bsz, seq, n_heads * dh)


def setup_inputs(seed: int = 0) -> dict:
    key = jax.random.key(seed)
    ks = jax.random.split(key, 12)
    f32 = jnp.float32
    x = jax.random.normal(ks[0], (BATCH, SEQ, D_MODEL), f32)
    c = jax.random.normal(ks[1], (BATCH, D_MODEL), f32)
    w_ada = jax.random.normal(ks[2], (DEPTH, D_MODEL, 3 * D_MODEL), f32) * (0.5 * D_MODEL ** -0.5)
    b_ada = jax.random.normal(ks[3], (DEPTH, 3 * D_MODEL), f32) * 0.02
    w_in = jax.random.normal(ks[4], (DEPTH, D_MODEL, D_IN_PROJ), f32) * D_MODEL ** -0.5
    sgu_ln_g = 1.0 + 0.05 * jax.random.normal(ks[5], (DEPTH, D_A), f32)
    sgu_ln_b = 0.02 * jax.random.normal(ks[6], (DEPTH, D_A), f32)
    w_spatial = jax.random.normal(ks[7], (DEPTH, N_GROUPS_A, CHUNK, CHUNK), f32) * CHUNK ** -0.5
    b_spatial = 1.0 + 0.1 * jax.random.normal(ks[8], (DEPTH, N_GROUPS_A, CHUNK), f32)
    w_out = jax.random.normal(ks[9], (DEPTH, D_MIX, D_MODEL), f32) * (DEEPNORM_BETA * D_MIX ** -0.5)
    ln_g = 1.0 + 0.05 * jax.random.normal(ks[10], (DEPTH, D_MODEL), f32)
    ln_b = 0.02 * jax.random.normal(ks[11], (DEPTH, D_MODEL), f32)
    return {"x": x, "c": c, "w_ada": w_ada, "b_ada": b_ada, "w_in": w_in,
            "sgu_ln_g": sgu_ln_g, "sgu_ln_b": sgu_ln_b, "w_spatial": w_spatial,
            "b_spatial": b_spatial, "w_out": w_out, "ln_g": ln_g, "ln_b": ln_b}


def reference(x, c, w_ada, b_ada, w_in, sgu_ln_g, sgu_ln_b, w_spatial, b_spatial, w_out, ln_g, ln_b):
    bsz, seq, _ = x.shape
    split_points = np.cumsum([D_A, D_A, D_A, D_B, D_B, D_B])
    silu_c = jax.nn.silu(c)
    for layer in range(DEPTH):
        mod = silu_c @ w_ada[layer] + b_ada[layer]
        shift, scale, gate = jnp.split(mod, 3, axis=-1)
        h = x * (1.0 + scale[:, None, :]) + shift[:, None, :]

        proj = h @ w_in[layer]
        u_a, v_a, z_a, q, k, v_b, z_b = jnp.split(proj, split_points, axis=-1)

        y_a = chunked_sgu(jax.nn.gelu(u_a), jax.nn.gelu(v_a), sgu_ln_g[layer], sgu_ln_b[layer],
                          w_spatial[layer], b_spatial[layer])

        def heads(t):
            return t.reshape(bsz, seq, N_HEADS_B, HEAD_DIM).transpose(0, 2, 1, 3)
        y_b = stick_breaking_attention(heads(q), heads(k), heads(v_b))

        y = jnp.concatenate([jax.nn.silu(z_a) * y_a, jax.nn.silu(z_b) * y_b], axis=-1)
        y = y @ w_out[layer]

        x = layer_norm(DEEPNORM_ALPHA * x + gate[:, None, :] * y, ln_g[layer], ln_b[layer])
    return x
```

```cpp
#include <hip/hip_runtime.h>
#include <hip/hip_cooperative_groups.h>
#include <cstdint>
#include <cstdio>
namespace cg = cooperative_groups;

#ifndef MODE
#define MODE 0
#endif

typedef unsigned short bf16_t;
typedef short bf16x8 __attribute__((ext_vector_type(8)));
typedef _Float16 f16x8 __attribute__((ext_vector_type(8)));
typedef float f32x4 __attribute__((ext_vector_type(4)));
typedef float f32x16 __attribute__((ext_vector_type(16)));
typedef unsigned u32x2 __attribute__((ext_vector_type(2)));
typedef unsigned u32x4 __attribute__((ext_vector_type(4)));

constexpr int D_MODEL = 1024, BATCH = 8, SEQ = 2048, NTOK = BATCH * SEQ;
constexpr int NPROJ = 3584, CHUNK = 128, NGRP = 8, NHEAD = 8;
constexpr int C_U = 0, C_V = 512, C_ZA = 1024, C_Q = 1536, C_K = 2048, C_VB = 2560, C_ZB = 3072;
constexpr float LN_EPS = 1e-5f;
constexpr float ALPHA = 1.189207115002721f;
constexpr float LOG2E = 1.4426950408889634f;
constexpr float QSCALE = 0.125f * LOG2E;
constexpr int NT = 512;
constexpr int LDS_BYTES = 131072;

__device__ __forceinline__ bf16_t f2bf(float f) { unsigned u = __float_as_uint(f); u += 0x7fffu + ((u >> 16) & 1u); return (bf16_t)(u >> 16); }
__device__ __forceinline__ float bf2f(bf16_t b) { return __uint_as_float(((unsigned)b) << 16); }
__device__ __forceinline__ float bflo(unsigned w) { return __uint_as_float(w << 16); }
__device__ __forceinline__ float bfhi(unsigned w) { return __uint_as_float(w & 0xffff0000u); }
__device__ __forceinline__ unsigned cvt_pk_bf16(float lo, float hi) { unsigned r; asm volatile("v_cvt_pk_bf16_f32 %0, %1, %2" : "=v"(r) : "v"(lo), "v"(hi)); return r; }
__device__ __forceinline__ unsigned cvt_pk_f16(float lo, float hi) { unsigned r; asm volatile("v_cvt_pk_f16_f32 %0, %1, %2" : "=v"(r) : "v"(lo), "v"(hi)); return r; }
__device__ __forceinline__ float sigmoidf_(float v) { return __builtin_amdgcn_rcpf(1.0f + __builtin_amdgcn_exp2f(-v * LOG2E)); }
__device__ __forceinline__ float siluf_(float v) { return v * sigmoidf_(v); }
__device__ __forceinline__ float geluf_(float v) { return v * sigmoidf_(1.5957691216057308f * (v + 0.044715f * v * v * v)); }

constexpr size_t OFF_MOD = 0;
constexpr size_t OFF_HB = 1 << 20;
constexpr size_t OFF_WIN = OFF_HB + (size_t)NTOK * D_MODEL * 2;
constexpr size_t OFF_WOUT = OFF_WIN + (size_t)NPROJ * D_MODEL * 2;
constexpr size_t OFF_WSP = OFF_WOUT + (size_t)D_MODEL * D_MODEL * 2;
constexpr size_t OFF_PROJ = OFF_WSP + (size_t)NGRP * CHUNK * CHUNK * 2;
constexpr size_t OFF_Y = OFF_PROJ + (size_t)NTOK * NPROJ * 2;

struct Params {
    const float* x; const float* c; const float* w_ada; const float* b_ada; const float* w_in; const float* sgu_g; const float* sgu_b;
    const float* w_sp; const float* b_sp; const float* w_out; const float* ln_g; const float* ln_b;
    float* out; unsigned char* ws; int phase; int pad;
};

__device__ void p0_prologue(const Params& p, unsigned char* lds) {
    int tid = threadIdx.x; asm volatile("" : "+v"(tid)); const int lane = tid & 63, wave = tid >> 6;
    float* mod = (float*)(p.ws + OFF_MOD);
    float* sc = (float*)lds;
    float* red = (float*)(lds + 32768);
    for (int it = blockIdx.x; it < 96; it += gridDim.x) {
        for (int i = tid; i < 8 * 1024; i += NT) sc[i] = siluf_(p.c[i]);
        __syncthreads();
        const int q = tid & 7, r = tid >> 3; const int c0 = it * 32 + q * 4;
        float acc[8][4];
#pragma unroll
        for (int b = 0; b < 8; ++b) { acc[b][0] = 0.f; acc[b][1] = 0.f; acc[b][2] = 0.f; acc[b][3] = 0.f; }
#pragma unroll 4
        for (int i = 0; i < 16; ++i) { const int k = r + 64 * i; const f32x4 w = *(const f32x4*)(p.w_ada + (size_t)k * 3072 + c0);
#pragma unroll
            for (int b = 0; b < 8; ++b) { const float s = sc[b * 1024 + k]; acc[b][0] += s * w[0]; acc[b][1] += s * w[1]; acc[b][2] += s * w[2]; acc[b][3] += s * w[3]; } }
#pragma unroll
        for (int b = 0; b < 8; ++b)
#pragma unroll
            for (int j = 0; j < 4; ++j) { float v = acc[b][j]; v += __shfl_xor(v, 8); v += __shfl_xor(v, 16); v += __shfl_xor(v, 32); acc[b][j] = v; }
        if (lane < 8) {
#pragma unroll
            for (int b = 0; b < 8; ++b)
#pragma unroll
                for (int j = 0; j < 4; ++j) red[(wave * 8 + q) * 32 + b * 4 + j] = acc[b][j];
        }
        __syncthreads();
        if (tid < 256) { const int b = tid >> 5, col = tid & 31, qq = col >> 2, j = col & 3; float s = 0.f;
#pragma unroll
            for (int w = 0; w < 8; ++w) s += red[(w * 8 + qq) * 32 + b * 4 + j];
            mod[b * 3072 + it * 32 + col] = s + p.b_ada[it * 32 + col]; }
        __syncthreads();
    }
    float* tb = (float*)(lds + 49152);
    for (int tile = blockIdx.x; tile < 896 + 256; tile += gridDim.x) {
        const float* W; bf16_t* Wt; int N, tk, tn;
        if (tile < 896) { W = p.w_in; Wt = (bf16_t*)(p.ws + OFF_WIN); N = NPROJ; tk = tile / 56; tn = tile % 56; }
        else { const int t2 = tile - 896; W = p.w_out; Wt = (bf16_t*)(p.ws + OFF_WOUT); N = D_MODEL; tk = t2 / 16; tn = t2 % 16; }
        const int k0 = tk * 64, n0 = tn * 64;
        { const int n4 = tid & 15, kk = tid >> 4;
#pragma unroll
          for (int i = 0; i < 2; ++i) { const int k = kk + 32 * i; const f32x4 v = *(const f32x4*)(W + (size_t)(k0 + k) * N + n0 + n4 * 4);
              tb[k * 65 + n4 * 4 + 0] = v[0]; tb[k * 65 + n4 * 4 + 1] = v[1]; tb[k * 65 + n4 * 4 + 2] = v[2]; tb[k * 65 + n4 * 4 + 3] = v[3]; } }
        __syncthreads();
        { const int n = tid >> 3, ks = tid & 7; u32x4 o;
          o[0] = cvt_pk_bf16(tb[(ks * 8 + 0) * 65 + n], tb[(ks * 8 + 1) * 65 + n]); o[1] = cvt_pk_bf16(tb[(ks * 8 + 2) * 65 + n], tb[(ks * 8 + 3) * 65 + n]);
          o[2] = cvt_pk_bf16(tb[(ks * 8 + 4) * 65 + n], tb[(ks * 8 + 5) * 65 + n]); o[3] = cvt_pk_bf16(tb[(ks * 8 + 6) * 65 + n], tb[(ks * 8 + 7) * 65 + n]);
          *(u32x4*)(Wt + (size_t)(n0 + n) * D_MODEL + k0 + ks * 8) = o; }
        __syncthreads();
    }
    bf16_t* wsp = (bf16_t*)(p.ws + OFF_WSP);
    for (int i = blockIdx.x * NT + tid; i < NGRP * CHUNK * CHUNK / 8; i += gridDim.x * NT) {
        const int e = i * 8, t = (e >> 7) & 127, s0 = e & 127;
        const f32x4 a = *(const f32x4*)(p.w_sp + e), b = *(const f32x4*)(p.w_sp + e + 4);
        float v[8] = {a[0], a[1], a[2], a[3], b[0], b[1], b[2], b[3]};
#pragma unroll
        for (int j = 0; j < 8; ++j) v[j] = (s0 + j <= t) ? v[j] : 0.f;
        u32x4 o; o[0] = cvt_pk_bf16(v[0], v[1]); o[1] = cvt_pk_bf16(v[2], v[3]); o[2] = cvt_pk_bf16(v[4], v[5]); o[3] = cvt_pk_bf16(v[6], v[7]);
        *(u32x4*)(wsp + e) = o;
    }
}

__device__ void p_hconv(const Params& p) {
    const float* mod = (const float*)(p.ws + OFF_MOD); bf16_t* hb = (bf16_t*)(p.ws + OFF_HB);
    int tid = threadIdx.x; asm volatile("" : "+v"(tid));
    for (size_t i = (size_t)blockIdx.x * NT + tid; i < (size_t)NTOK * D_MODEL / 8; i += (size_t)gridDim.x * NT) {
        const size_t e = i * 8; const int col = (int)(e & 1023); const int b = (int)(e >> 21);
        const f32x4 x0 = *(const f32x4*)(p.x + e), x1 = *(const f32x4*)(p.x + e + 4);
        const f32x4 sh0 = *(const f32x4*)(mod + b * 3072 + col), sh1 = *(const f32x4*)(mod + b * 3072 + col + 4);
        const f32x4 sc0 = *(const f32x4*)(mod + b * 3072 + 1024 + col), sc1 = *(const f32x4*)(mod + b * 3072 + 1024 + col + 4);
        const f32x4 h0 = x0 * (1.0f + sc0) + sh0, h1 = x1 * (1.0f + sc1) + sh1;
        u32x4 o; o[0] = cvt_pk_bf16(h0[0], h0[1]); o[1] = cvt_pk_bf16(h0[2], h0[3]); o[2] = cvt_pk_bf16(h1[0], h1[1]); o[3] = cvt_pk_bf16(h1[2], h1[3]);
        *(u32x4*)(hb + e) = o;
    }
}

constexpr int BM = 256, BK = 64, HALF = 128, NXCD = 8, WGM = 8, HT = HALF * BK;
__device__ __forceinline__ int lds_byte(int r, int c) { int st = (r >> 4) * 2 + (c >> 5), rr = r & 15, cc = c & 31, ob = rr * 64 + cc * 2; return st * 1024 + (ob ^ (((ob >> 9) & 1) << 5)); }
__device__ __forceinline__ void stage_rc(int b, int& R, int& C) { int st = b / 1024, sb = b % 1024, swz = sb ^ (((sb >> 9) & 1) << 5); R = (st >> 1) * 16 + swz / 64; C = (st & 1) * 32 + (swz % 64) / 2; }

struct TileOrder {
    int nM, nN, nwg, G, c;
    __device__ void init(int M, int N, int G_, int c_) { nM = M / BM; nN = N / BM; nwg = nM * nN; G = G_; c = c_; }
    __device__ bool next(int i, int& pm, int& pn) const {
        const long L = (long)i * G + c; if (L >= nwg) return false;
        int wgid = (int)L; { const int q = nwg / NXCD, r = nwg % NXCD, xcd = wgid % NXCD, off = wgid / NXCD; wgid = (xcd < r ? xcd * (q + 1) : r * (q + 1) + (xcd - r) * q) + off; }
        const int nig = WGM * nN, gid = wgid / nig, fm = gid * WGM, gsz = (nM - fm) < WGM ? (nM - fm) : WGM;
        pm = fm + ((wgid % nig) % gsz); pn = (wgid % nig) / gsz; return true;
    }
};

__device__ __forceinline__ void gemm_tile(const bf16_t* __restrict__ A, const bf16_t* __restrict__ Bt, const int K, const int brow, const int bcol, bf16_t* shm, f32x4 (&acc)[2][2][4][2]) {
#define SA(b, h) (shm + ((b) * 2 + (h)) * HT)
#define SB(b, h) (shm + (4 + (b) * 2 + (h)) * HT)
#define STAGE(P, BASE, br, kt) do { const char* _gb = (const char*)(BASE) + ((size_t)(br) * K + (size_t)(kt) * BK) * 2; \
    for (int _i = 0; _i < 2; ++_i) { int _b = gtx * 16 + _i * 8192; \
      __builtin_amdgcn_global_load_lds((const unsigned*)(_gb + soff[_i]), (__attribute__((address_space(3))) unsigned*)((char*)(P) + _b), 16, 0, 0); } } while (0)
#define LDA(dst, b, h) for (int m = 0; m < 4; ++m) for (int k = 0; k < 2; ++k) \
    dst[m][k] = *reinterpret_cast<const bf16x8*>((char*)SA(b, h) + lds_byte(wr * 64 + m * 16 + fr, k * 32 + fq * 8))
#define LDB(dst, b, h) for (int n = 0; n < 2; ++n) for (int k = 0; k < 2; ++k) \
    dst[n][k] = *reinterpret_cast<const bf16x8*>((char*)SB(b, h) + lds_byte(wc * 32 + n * 16 + fr, k * 32 + fq * 8))
#define MMA(ai, bj, At_, Bt_) do { __builtin_amdgcn_s_setprio(1); \
    for (int m = 0; m < 4; ++m) for (int n = 0; n < 2; ++n) for (int k = 0; k < 2; ++k) \
      acc[ai][bj][m][n] = __builtin_amdgcn_mfma_f32_16x16x32_bf16(Bt_[n][k], At_[m][k], acc[ai][bj][m][n], 0, 0, 0); \
    __builtin_amdgcn_s_setprio(0); } while (0)
#define WAIT_V(n) asm volatile("s_waitcnt vmcnt(" #n ")" ::: "memory")
#define WAIT_L(n) asm volatile("s_waitcnt lgkmcnt(" #n ")" ::: "memory")
#define BAR __builtin_amdgcn_s_barrier()
#define SCHED __builtin_amdgcn_sched_barrier(0)
    int gtx = threadIdx.x; asm volatile("" : "+v"(gtx));
    const int wid = gtx >> 6, lane = gtx & 63, wr = __builtin_amdgcn_readfirstlane(wid >> 2), wc = wid & 3, fr = lane & 15, fq = lane >> 4;
#pragma unroll
    for (int a = 0; a < 2; ++a)
#pragma unroll
        for (int b = 0; b < 2; ++b)
#pragma unroll
            for (int m = 0; m < 4; ++m)
#pragma unroll
                for (int n = 0; n < 2; ++n) acc[a][b][m][n] = (f32x4){0.f, 0.f, 0.f, 0.f};
    bf16x8 At[4][2], B0[2][2], B1[2][2];
    unsigned soff[2];
    for (int _i = 0; _i < 2; ++_i) { int _r, _c; stage_rc(gtx * 16 + _i * 8192, _r, _c); soff[_i] = (unsigned)(_r * K + _c) * 2u; }
    const int nt = K / BK;
    STAGE(SB(0, 0), Bt, bcol, 0); STAGE(SA(0, 0), A, brow, 0);
    STAGE(SB(0, 1), Bt, bcol + HALF, 0); STAGE(SA(0, 1), A, brow + HALF, 0);
    if (wr == 1) BAR;
    WAIT_V(4); BAR;
    STAGE(SB(1, 0), Bt, bcol, 1); STAGE(SA(1, 0), A, brow, 1); STAGE(SB(1, 1), Bt, bcol + HALF, 1);
    WAIT_V(6); BAR;
    for (int t = 0; t < nt - 2; t += 2) {
        LDB(B0, 0, 0); SCHED; LDA(At, 0, 0); STAGE(SA(1, 1), A, brow + HALF, t + 1);
        WAIT_L(8); BAR; WAIT_L(0); MMA(0, 0, At, B0); BAR; SCHED;
        LDB(B1, 0, 1); STAGE(SB(0, 0), Bt, bcol, t + 2);
        BAR; WAIT_L(0); MMA(0, 1, At, B1); BAR;
        LDA(At, 0, 1); STAGE(SA(0, 0), A, brow, t + 2);
        BAR; WAIT_L(0); MMA(1, 0, At, B0); BAR; SCHED;
        STAGE(SB(0, 1), Bt, bcol + HALF, t + 2);
        WAIT_V(6); BAR; MMA(1, 1, At, B1); BAR;
        LDB(B0, 1, 0); SCHED; LDA(At, 1, 0); STAGE(SA(0, 1), A, brow + HALF, t + 2);
        WAIT_L(8); BAR; WAIT_L(0); MMA(0, 0, At, B0); BAR; SCHED;
        LDB(B1, 1, 1); STAGE(SB(1, 0), Bt, bcol, t + 3);
        BAR; WAIT_L(0); MMA(0, 1, At, B1); BAR;
        LDA(At, 1, 1); STAGE(SA(1, 0), A, brow, t + 3);
        BAR; WAIT_L(0); MMA(1, 0, At, B0); BAR; SCHED;
        STAGE(SB(1, 1), Bt, bcol + HALF, t + 3);
        WAIT_V(6); BAR; MMA(1, 1, At, B1); BAR;
    }
    { LDB(B0, 0, 0); LDA(At, 0, 0); STAGE(SA(1, 1), A, brow + HALF, nt - 1);
      BAR; WAIT_L(0); MMA(0, 0, At, B0); BAR;
      LDB(B1, 0, 1); BAR; WAIT_L(0); MMA(0, 1, At, B1); BAR;
      LDA(At, 0, 1); WAIT_V(4); BAR; WAIT_L(0); MMA(1, 0, At, B0); MMA(1, 1, At, B1); BAR; }
    { LDB(B0, 1, 0); LDA(At, 1, 0); WAIT_V(2); BAR; WAIT_L(0); MMA(0, 0, At, B0); BAR;
      LDB(B1, 1, 1); WAIT_V(0); BAR; WAIT_L(0); MMA(0, 1, At, B1); BAR;
      LDA(At, 1, 1); BAR; WAIT_L(0); MMA(1, 0, At, B0); MMA(1, 1, At, B1); BAR; }
    if (wr == 0) BAR;
#undef SA
#undef SB
#undef STAGE
#undef LDA
#undef LDB
#undef MMA
}

__device__ void p_inproj(const Params& p, unsigned char* lds) {
    const bf16_t* hb = (const bf16_t*)(p.ws + OFF_HB); const bf16_t* winT = (const bf16_t*)(p.ws + OFF_WIN); bf16_t* proj = (bf16_t*)(p.ws + OFF_PROJ);
    TileOrder ord; ord.init(NTOK, NPROJ, gridDim.x, blockIdx.x);
    for (int i = 0;; ++i) {
        int pm, pn; if (!ord.next(i, pm, pn)) break;
        f32x4 acc[2][2][4][2];
        gemm_tile(hb, winT, D_MODEL, pm * BM, pn * BM, (bf16_t*)lds, acc);
        int tx = threadIdx.x; asm volatile("" : "+v"(tx));
        const int wid = tx >> 6, lane = tx & 63, wr = wid >> 2, wc = wid & 3, fr = lane & 15, fq = lane >> 4;
        const int seg = pn >> 1;
#pragma unroll
        for (int ai = 0; ai < 2; ++ai)
#pragma unroll
            for (int m = 0; m < 4; ++m) {
                const int row = pm * BM + ai * HALF + wr * 64 + m * 16 + fr;
                bf16_t* rowp = proj + (size_t)row * NPROJ + pn * BM + wc * 32 + fq * 4;
#pragma unroll
                for (int bj = 0; bj < 2; ++bj)
#pragma unroll
                    for (int n = 0; n < 2; ++n) {
                        f32x4 v = acc[ai][bj][m][n];
                        if (seg <= 1) { v[0] = geluf_(v[0]); v[1] = geluf_(v[1]); v[2] = geluf_(v[2]); v[3] = geluf_(v[3]); }
                        else if (seg == 2 || seg == 6) { v[0] = siluf_(v[0]); v[1] = siluf_(v[1]); v[2] = siluf_(v[2]); v[3] = siluf_(v[3]); }
                        else if (seg == 3) { v = v * QSCALE; }
                        u32x2 o; o[0] = cvt_pk_bf16(v[0], v[1]); o[1] = cvt_pk_bf16(v[2], v[3]);
                        *(u32x2*)(rowp + bj * HALF + n * 16) = o;
                    }
            }
        asm volatile("s_waitcnt vmcnt(0)" ::: "memory");
    }
}

__device__ void p_outproj(const Params& p, unsigned char* lds) {
    const bf16_t* yb = (const bf16_t*)(p.ws + OFF_Y); const bf16_t* woutT = (const bf16_t*)(p.ws + OFF_WOUT); const float* mod = (const float*)(p.ws + OFF_MOD);
    TileOrder ord; ord.init(NTOK, D_MODEL, gridDim.x, blockIdx.x);
    for (int i = 0;; ++i) {
        int pm, pn; if (!ord.next(i, pm, pn)) break;
        f32x4 acc[2][2][4][2];
        gemm_tile(yb, woutT, D_MODEL, pm * BM, pn * BM, (bf16_t*)lds, acc);
        int tx = threadIdx.x; asm volatile("" : "+v"(tx));
        const int wid = tx >> 6, lane = tx & 63, wr = wid >> 2, wc = wid & 3, fr = lane & 15, fq = lane >> 4;
        const int b = (pm * BM) / SEQ; const int col0 = pn * BM + wc * 32 + fq * 4;
        f32x4 gate[2][2];
#pragma unroll
        for (int bj = 0; bj < 2; ++bj)
#pragma unroll
            for (int n = 0; n < 2; ++n) gate[bj][n] = *(const f32x4*)(mod + b * 3072 + 2048 + col0 + bj * HALF + n * 16);
#pragma unroll
        for (int ai = 0; ai < 2; ++ai)
#pragma unroll
            for (int m = 0; m < 4; ++m) {
                const int row = pm * BM + ai * HALF + wr * 64 + m * 16 + fr; const size_t off = (size_t)row * D_MODEL + col0;
#pragma unroll
                for (int bj = 0; bj < 2; ++bj)
#pragma unroll
                    for (int n = 0; n < 2; ++n) {
                        const f32x4 xv = *(const f32x4*)(p.x + off + bj * HALF + n * 16);
                        *(f32x4*)(p.out + off + bj * HALF + n * 16) = xv * ALPHA + gate[bj][n] * acc[ai][bj][m][n];
                    }
            }
        asm volatile("s_waitcnt vmcnt(0)" ::: "memory");
    }
}

constexpr int KROW = 72;
__device__ __forceinline__ void attn_unit(const Params& p, unsigned char* lds, const int b, const int h, const int qb) {
    const bf16_t* proj = (const bf16_t*)(p.ws + OFF_PROJ); bf16_t* yb = (bf16_t*)(p.ws + OFF_Y);
    int tid = threadIdx.x; asm volatile("" : "+v"(tid)); const int lane = tid & 63, wave = __builtin_amdgcn_readfirstlane(tid >> 6), c = lane & 31, hh = lane >> 5;
    bf16_t* Ks = (bf16_t*)lds;
    bf16_t* Vt = (bf16_t*)(lds + 2 * 64 * KROW * 2);
    const size_t tokbase = (size_t)b * SEQ; const int q0 = qb * 256, tq0 = q0 + wave * 32;
    bf16x8 qf[4];
    { const bf16_t* qp = proj + (tokbase + tq0 + c) * NPROJ + C_Q + h * 64 + hh * 8;
#pragma unroll
      for (int ks = 0; ks < 4; ++ks) qf[ks] = *(const bf16x8*)(qp + ks * 16); }
    f16x8 uf[2];
#pragma unroll
    for (int ks2 = 0; ks2 < 2; ++ks2)
#pragma unroll
        for (int jj = 0; jj < 8; ++jj) { const int key = 16 * ks2 + 8 * (jj >> 2) + 4 * hh + (jj & 3); uf[ks2][jj] = (key >= c) ? (_Float16)1.0f : (_Float16)0.0f; }
    f32x16 o0, o1;
#pragma unroll
    for (int r = 0; r < 16; ++r) { o0[r] = 0.f; o1[r] = 0.f; }
    float R = 0.f;
    const int ntile = (q0 + 256) / 64;
    const int skey = tid >> 3, sch = tid & 7; const int spk = (skey & ~12) | ((skey & 4) << 1) | ((skey & 8) >> 1);
    u32x4 kreg, vreg;
    { const bf16_t* kp = proj + (tokbase + (ntile - 1) * 64 + skey) * NPROJ + h * 64 + sch * 8; kreg = *(const u32x4*)(kp + C_K); vreg = *(const u32x4*)(kp + C_VB); }
    int buf = 0;
    { *(u32x4*)(Ks + (buf * 64 + skey) * KROW + sch * 8) = kreg;
      bf16_t* vp = Vt + (buf * 64 + sch * 8) * KROW + spk;
#pragma unroll
      for (int e = 0; e < 4; ++e) { vp[(2 * e) * KROW] = (bf16_t)(vreg[e] & 0xffffu); vp[(2 * e + 1) * KROW] = (bf16_t)(vreg[e] >> 16); } }
    __syncthreads();
    for (int kt = ntile - 1; kt >= 0; --kt) {
        if (kt > 0) { const bf16_t* kp = proj + (tokbase + (kt - 1) * 64 + skey) * NPROJ + h * 64 + sch * 8; kreg = *(const u32x4*)(kp + C_K); vreg = *(const u32x4*)(kp + C_VB); }
        const bf16_t* Kb = Ks + buf * 64 * KROW; const bf16_t* Vb = Vt + buf * 64 * KROW;
#pragma unroll
        for (int sub = 1; sub >= 0; --sub) {
            const int ks0 = kt * 64 + sub * 32;
            if (ks0 <= tq0) {
                const bool diag = (ks0 == tq0);
                f32x16 z;
#pragma unroll
                for (int r = 0; r < 16; ++r) z[r] = 0.f;
#pragma unroll
                for (int ks = 0; ks < 4; ++ks) { const bf16x8 kf = *(const bf16x8*)(Kb + (sub * 32 + c) * KROW + ks * 16 + hh * 8); z = __builtin_amdgcn_mfma_f32_32x32x16_bf16(kf, qf[ks], z, 0, 0, 0); }
                float nsp[16];
#pragma unroll
                for (int r = 0; r < 16; ++r) {
                    const float zz = z[r];
                    const float l = __builtin_amdgcn_logf(1.0f + __builtin_amdgcn_exp2f(-fabsf(zz)));
                    float v = -(fmaxf(zz, 0.f) + l);
                    if (diag) { const int s = (r & 3) + 8 * (r >> 2) + 4 * hh; if (s >= c) v = 0.f; }
                    nsp[r] = v;
                }
                f16x8 lf[2];
                { unsigned w[8];
#pragma unroll
                  for (int i = 0; i < 8; ++i) w[i] = cvt_pk_f16(nsp[2 * i], nsp[2 * i + 1]);
                  u32x4 t0 = {w[0], w[1], w[2], w[3]}, t1 = {w[4], w[5], w[6], w[7]};
                  lf[0] = __builtin_bit_cast(f16x8, t0); lf[1] = __builtin_bit_cast(f16x8, t1); }
                f32x16 cum;
#pragma unroll
                for (int r = 0; r < 16; ++r) cum[r] = R;
                cum = __builtin_amdgcn_mfma_f32_32x32x16_f16(uf[0], lf[0], cum, 0, 0, 0);
                cum = __builtin_amdgcn_mfma_f32_32x32x16_f16(uf[1], lf[1], cum, 0, 0, 0);
                float a[16];
#pragma unroll
                for (int r = 0; r < 16; ++r) {
                    float v = __builtin_amdgcn_exp2f(z[r] + cum[r]);
                    if (diag) { const int s = (r & 3) + 8 * (r >> 2) + 4 * hh; if (s >= c) v = 0.f; }
                    a[r] = v;
                }
                R = __shfl(cum[0], c);
                bf16x8 pf[2];
                { unsigned w[8];
#pragma unroll
                  for (int i = 0; i < 8; ++i) w[i] = cvt_pk_bf16(a[2 * i], a[2 * i + 1]);
                  u32x4 t0 = {w[0], w[1], w[2], w[3]}, t1 = {w[4], w[5], w[6], w[7]};
                  pf[0] = __builtin_bit_cast(bf16x8, t0); pf[1] = __builtin_bit_cast(bf16x8, t1); }
#pragma unroll
                for (int ks2 = 0; ks2 < 2; ++ks2) {
                    const bf16x8 v0 = *(const bf16x8*)(Vb + (c) * KROW + sub * 32 + ks2 * 16 + hh * 8);
                    const bf16x8 v1 = *(const bf16x8*)(Vb + (32 + c) * KROW + sub * 32 + ks2 * 16 + hh * 8);
                    o0 = __builtin_amdgcn_mfma_f32_32x32x16_bf16(v0, pf[ks2], o0, 0, 0, 0);
                    o1 = __builtin_amdgcn_mfma_f32_32x32x16_bf16(v1, pf[ks2], o1, 0, 0, 0);
                }
            }
        }
        if (kt > 0) {
            const int nb = buf ^ 1;
            *(u32x4*)(Ks + (nb * 64 + skey) * KROW + sch * 8) = kreg;
            bf16_t* vp = Vt + (nb * 64 + sch * 8) * KROW + spk;
#pragma unroll
            for (int e = 0; e < 4; ++e) { vp[(2 * e) * KROW] = (bf16_t)(vreg[e] & 0xffffu); vp[(2 * e + 1) * KROW] = (bf16_t)(vreg[e] >> 16); }
        }
        __syncthreads();
        buf ^= 1;
    }
    { const size_t tok = tokbase + tq0 + c; const bf16_t* zp = proj + tok * NPROJ + C_ZB + h * 64; bf16_t* yp = yb + tok * D_MODEL + 512 + h * 64;
#pragma unroll
      for (int dt = 0; dt < 2; ++dt)
#pragma unroll
          for (int g = 0; g < 4; ++g) { const int d0 = dt * 32 + 8 * g + 4 * hh; const u32x2 zz = *(const u32x2*)(zp + d0);
              const float v0 = dt ? o1[4 * g + 0] : o0[4 * g + 0], v1 = dt ? o1[4 * g + 1] : o0[4 * g + 1], v2 = dt ? o1[4 * g + 2] : o0[4 * g + 2], v3 = dt ? o1[4 * g + 3] : o0[4 * g + 3];
              u32x2 o; o[0] = cvt_pk_bf16(bflo(zz[0]) * v0, bfhi(zz[0]) * v1); o[1] = cvt_pk_bf16(bflo(zz[1]) * v2, bfhi(zz[1]) * v3);
              *(u32x2*)(yp + d0) = o; } }
}

constexpr int VROW = 136;
__device__ __forceinline__ void sgu_item(const Params& p, unsigned char* lds, const int ch, const int hf) {
    const bf16_t* proj = (const bf16_t*)(p.ws + OFF_PROJ); bf16_t* yb = (bf16_t*)(p.ws + OFF_Y); const bf16_t* wsp = (const bf16_t*)(p.ws + OFF_WSP);
    int tid = threadIdx.x; asm volatile("" : "+v"(tid)); const int lane = tid & 63, wave = __builtin_amdgcn_readfirstlane(tid >> 6), c = lane & 31, hh = lane >> 5;
    float* stats = (float*)(lds + 65536);
    bf16_t* vnT = (bf16_t*)(lds + 65536 + 1024);
    const size_t tok0 = (size_t)ch * CHUNK;
    { const int token = tid >> 2, qd = tid & 3; const bf16_t* vp = proj + (tok0 + token) * NPROJ + C_V + qd * 128; float s = 0.f, ss = 0.f;
#pragma unroll 4
      for (int i = 0; i < 16; ++i) { const u32x4 w = *(const u32x4*)(vp + i * 8);
#pragma unroll
          for (int e = 0; e < 4; ++e) { const float a = bflo(w[e]), bb = bfhi(w[e]); s += a + bb; ss += a * a + bb * bb; } }
      s += __shfl_xor(s, 1); ss += __shfl_xor(ss, 1); s += __shfl_xor(s, 2); ss += __shfl_xor(ss, 2);
      const float mean = s * (1.0f / 512.f); const float var = fmaxf(ss * (1.0f / 512.f) - mean * mean, 0.f);
      if (qd == 0) { stats[token * 2] = mean; stats[token * 2 + 1] = 1.0f / sqrtf(var + LN_EPS); } }
    __syncthreads();
    for (int gi = 0; gi < 4; ++gi) {
        const int g = hf * 4 + gi;
        { const int s = tid & 127, cc = tid >> 7; const float mean = stats[s * 2], rstd = stats[s * 2 + 1];
          const bf16_t* vp = proj + (tok0 + s) * NPROJ + C_V + g * 64 + cc * 16;
#pragma unroll
          for (int i = 0; i < 2; ++i) { const u32x4 w = *(const u32x4*)(vp + i * 8);
#pragma unroll
              for (int e = 0; e < 4; ++e) { const int chn = g * 64 + cc * 16 + i * 8 + 2 * e;
                  const float a = (bflo(w[e]) - mean) * rstd * p.sgu_g[chn] + p.sgu_b[chn], bb = (bfhi(w[e]) - mean) * rstd * p.sgu_g[chn + 1] + p.sgu_b[chn + 1];
                  vnT[(cc * 16 + i * 8 + 2 * e) * VROW + s] = f2bf(a); vnT[(cc * 16 + i * 8 + 2 * e + 1) * VROW + s] = f2bf(bb); } } }
        __syncthreads();
        { const int tt = wave >> 1, ct = wave & 1; f32x16 acc;
#pragma unroll
          for (int r = 0; r < 16; ++r) acc[r] = 0.f;
          const bf16_t* wrow = wsp + ((size_t)g * CHUNK + tt * 32 + c) * CHUNK + hh * 8; const bf16_t* vrow = vnT + (ct * 32 + c) * VROW + hh * 8;
          const int nks = 2 * (tt + 1);
          for (int ks = 0; ks < nks; ++ks) { const bf16x8 af = *(const bf16x8*)(vrow + ks * 16); const bf16x8 bfr = *(const bf16x8*)(wrow + ks * 16);
              acc = __builtin_amdgcn_mfma_f32_32x32x16_bf16(af, bfr, acc, 0, 0, 0); }
          const int t = tt * 32 + c; const size_t tok = tok0 + t; const float bs = p.b_sp[g * CHUNK + t];
          const bf16_t* up = proj + tok * NPROJ + C_U + g * 64 + ct * 32; const bf16_t* zp = proj + tok * NPROJ + C_ZA + g * 64 + ct * 32; bf16_t* yp = yb + tok * D_MODEL + g * 64 + ct * 32;
#pragma unroll
          for (int g4 = 0; g4 < 4; ++g4) { const int c0 = 8 * g4 + 4 * hh; const u32x2 uu = *(const u32x2*)(up + c0), zz = *(const u32x2*)(zp + c0);
              u32x2 o; o[0] = cvt_pk_bf16(bflo(zz[0]) * bflo(uu[0]) * (acc[4 * g4 + 0] + bs), bfhi(zz[0]) * bfhi(uu[0]) * (acc[4 * g4 + 1] + bs));
              o[1] = cvt_pk_bf16(bflo(zz[1]) * bflo(uu[1]) * (acc[4 * g4 + 2] + bs), bfhi(zz[1]) * bfhi(uu[1]) * (acc[4 * g4 + 3] + bs));
              *(u32x2*)(yp + c0) = o; } }
        __syncthreads();
    }
}

__device__ void p_mixers(const Params& p, unsigned char* lds) {
    for (int it = blockIdx.x; it < 256; it += gridDim.x) {
        const int xcd = it & 7, slot = it >> 3; const int bh = xcd * 8 + (slot >> 2), pr = slot & 3;
        for (int u = 0; u < 2; ++u) attn_unit(p, lds, bh >> 3, bh & 7, u ? pr : 7 - pr);
    }
    for (int it = blockIdx.x; it < 256; it += gridDim.x) sgu_item(p, lds, it >> 1, it & 1);
}

__device__ void p_ln(const Params& p) {
    int tid = threadIdx.x; asm volatile("" : "+v"(tid)); const int lane = tid & 63, wave = tid >> 6;
    for (int row = blockIdx.x * 8 + wave; row < NTOK; row += gridDim.x * 8) {
        float* rp = p.out + (size_t)row * D_MODEL; f32x4 v[4]; float s = 0.f;
#pragma unroll
        for (int j = 0; j < 4; ++j) { v[j] = *(const f32x4*)(rp + lane * 4 + 256 * j); s += (v[j][0] + v[j][1]) + (v[j][2] + v[j][3]); }
#pragma unroll
        for (int o = 32; o; o >>= 1) s += __shfl_xor(s, o);
        const float mu = s * (1.0f / 1024.f); float q = 0.f;
#pragma unroll
        for (int j = 0; j < 4; ++j) { const f32x4 d = v[j] - mu; q += (d[0] * d[0] + d[1] * d[1]) + (d[2] * d[2] + d[3] * d[3]); }
#pragma unroll
        for (int o = 32; o; o >>= 1) q += __shfl_xor(q, o);
        const float rstd = 1.0f / sqrtf(q * (1.0f / 1024.f) + LN_EPS);
#pragma unroll
        for (int j = 0; j < 4; ++j) { const int col = lane * 4 + 256 * j; const f32x4 g = *(const f32x4*)(p.ln_g + col), bb = *(const f32x4*)(p.ln_b + col);
            *(f32x4*)(rp + col) = (v[j] - mu) * rstd * g + bb; }
    }
}

#if MODE == 0
__global__ void __launch_bounds__(NT, 2) mega(Params p) {
    extern __shared__ __attribute__((aligned(16))) unsigned char lds[];
    cg::grid_group grid = cg::this_grid();
    p0_prologue(p, lds); grid.sync();
    p_hconv(p); grid.sync();
    p_inproj(p, lds); grid.sync();
    p_mixers(p, lds); grid.sync();
    p_outproj(p, lds); grid.sync();
    p_ln(p);
}
#else
__global__ void __launch_bounds__(NT, 2) mega(Params p) { extern __shared__ __attribute__((aligned(16))) unsigned char lds[]; p0_prologue(p, lds); }
__global__ void __launch_bounds__(NT, 2) k_ph1(Params p) { p_hconv(p); }
__global__ void __launch_bounds__(NT, 2) k_ph2(Params p) { extern __shared__ __attribute__((aligned(16))) unsigned char lds[]; p_inproj(p, lds); }
__global__ void __launch_bounds__(NT, 2) k_ph3(Params p) { extern __shared__ __attribute__((aligned(16))) unsigned char lds[]; p_mixers(p, lds); }
__global__ void __launch_bounds__(NT, 2) k_ph4(Params p) { extern __shared__ __attribute__((aligned(16))) unsigned char lds[]; p_outproj(p, lds); }
__global__ void __launch_bounds__(NT, 2) k_ph5(Params p) { p_ln(p); }
#endif

extern "C" void kernel_launch(void* const* d_in, const int* in_sizes, int n_in, void* d_out, int out_size, void* d_ws, size_t ws_size, hipStream_t stream) {
    static int grid_blocks = 0;
    if (!grid_blocks) {
        int dev = 0, cus = 0, per_cu = 0;
        (void)hipGetDevice(&dev);
        (void)hipDeviceGetAttribute(&cus, hipDeviceAttributeMultiprocessorCount, dev);
        if (hipFuncSetAttribute((const void*)mega, hipFuncAttributeMaxDynamicSharedMemorySize, LDS_BYTES) != hipSuccess) fprintf(stderr, "hipFuncSetAttribute failed\n");
        if (hipOccupancyMaxActiveBlocksPerMultiprocessor(&per_cu, (const void*)mega, NT, LDS_BYTES) != hipSuccess || per_cu < 1) { fprintf(stderr, "occupancy query: %d\n", per_cu); per_cu = 1; }
        (void)hipGetLastError();
        if (per_cu > 1) per_cu = 1;
        grid_blocks = cus * per_cu;
    }
    Params p{};
    p.x = (const float*)d_in[0]; p.c = (const float*)d_in[1]; p.w_ada = (const float*)d_in[2]; p.b_ada = (const float*)d_in[3]; p.w_in = (const float*)d_in[4];
    p.sgu_g = (const float*)d_in[5]; p.sgu_b = (const float*)d_in[6]; p.w_sp = (const float*)d_in[7]; p.b_sp = (const float*)d_in[8]; p.w_out = (const float*)d_in[9];
    p.ln_g = (const float*)d_in[10]; p.ln_b = (const float*)d_in[11]; p.out = (float*)d_out; p.ws = (unsigned char*)d_ws; p.phase = 0; p.pad = 0;
#if MODE == 0
    void* args[] = {&p};
    hipError_t e = hipLaunchCooperativeKernel((const void*)mega, dim3(grid_blocks), dim3(NT), args, LDS_BYTES, stream);
    if (e != hipSuccess) fprintf(stderr, "cooperative launch failed: %s (grid %d)\n", hipGetErrorString(e), grid_blocks);
#else
    hipFuncSetAttribute((const void*)k_ph2, hipFuncAttributeMaxDynamicSharedMemorySize, LDS_BYTES);
    hipFuncSetAttribute((const void*)k_ph3, hipFuncAttributeMaxDynamicSharedMemorySize, LDS_BYTES);
    hipFuncSetAttribute((const void*)k_ph4, hipFuncAttributeMaxDynamicSharedMemorySize, LDS_BYTES);
    hipLaunchKernelGGL(mega, dim3(grid_blocks), dim3(NT), LDS_BYTES, stream, p);
    hipLaunchKernelGGL(k_ph1, dim3(grid_blocks), dim3(NT), 0, stream, p);
    hipLaunchKernelGGL(k_ph2, dim3(grid_blocks), dim3(NT), LDS_BYTES, stream, p);
    hipLaunchKernelGGL(k_ph3, dim3(grid_blocks), dim3(NT), LDS_BYTES, stream, p);
    hipLaunchKernelGGL(k_ph4, dim3(grid_blocks), dim3(NT), LDS_BYTES, stream, p);
    hipLaunchKernelGGL(k_ph5, dim3(grid_blocks), dim3(NT), 0, stream, p);
#endif
}
```

```cpp
#include <hip/hip_runtime.h>
#include <hip/hip_cooperative_groups.h>
#include <cstdint>
#include <cstdio>
namespace cg = cooperative_groups;

#ifndef MODE
#define MODE 0
#endif

typedef unsigned short bf16_t;
typedef short bf16x8 __attribute__((ext_vector_type(8)));
typedef _Float16 f16x8 __attribute__((ext_vector_type(8)));
typedef float f32x4 __attribute__((ext_vector_type(4)));
typedef float f32x16 __attribute__((ext_vector_type(16)));
typedef unsigned u32x2 __attribute__((ext_vector_type(2)));
typedef unsigned u32x4 __attribute__((ext_vector_type(4)));

constexpr int D_MODEL = 1024, BATCH = 8, SEQ = 2048, NTOK = BATCH * SEQ;
constexpr int NPROJ = 3584, CHUNK = 128, NGRP = 8, NHEAD = 8;
constexpr int C_U = 0, C_V = 512, C_ZA = 1024, C_Q = 1536, C_K = 2048, C_VB = 2560, C_ZB = 3072;
constexpr float LN_EPS = 1e-5f;
constexpr float ALPHA = 1.189207115002721f;
constexpr float LOG2E = 1.4426950408889634f;
constexpr float QSCALE = 0.125f * LOG2E;
constexpr int NT = 512;
constexpr int LDS_BYTES = 131072 + 16;

__device__ __forceinline__ bf16_t f2bf(float f) { unsigned u = __float_as_uint(f); u += 0x7fffu + ((u >> 16) & 1u); return (bf16_t)(u >> 16); }
__device__ __forceinline__ float bf2f(bf16_t b) { return __uint_as_float(((unsigned)b) << 16); }
__device__ __forceinline__ float bflo(unsigned w) { return __uint_as_float(w << 16); }
__device__ __forceinline__ float bfhi(unsigned w) { return __uint_as_float(w & 0xffff0000u); }
__device__ __forceinline__ unsigned cvt_pk_bf16(float lo, float hi) { unsigned r; asm volatile("v_cvt_pk_bf16_f32 %0, %1, %2" : "=v"(r) : "v"(lo), "v"(hi)); return r; }
__device__ __forceinline__ unsigned cvt_pk_f16(float lo, float hi) { unsigned r; asm volatile("v_cvt_pk_f16_f32 %0, %1, %2" : "=v"(r) : "v"(lo), "v"(hi)); return r; }
__device__ __forceinline__ float sigmoidf_(float v) { return __builtin_amdgcn_rcpf(1.0f + __builtin_amdgcn_exp2f(-v * LOG2E)); }
__device__ __forceinline__ float siluf_(float v) { return v * sigmoidf_(v); }
__device__ __forceinline__ float geluf_(float v) { return v * sigmoidf_(1.5957691216057308f * (v + 0.044715f * v * v * v)); }

constexpr size_t OFF_MOD = 0;
constexpr size_t OFF_HB = 1 << 20;
constexpr size_t OFF_WIN = OFF_HB + (size_t)NTOK * D_MODEL * 2;
constexpr size_t OFF_WOUT = OFF_WIN + (size_t)NPROJ * D_MODEL * 2;
constexpr size_t OFF_WSP = OFF_WOUT + (size_t)D_MODEL * D_MODEL * 2;
constexpr size_t OFF_PROJ = OFF_WSP + (size_t)NGRP * CHUNK * CHUNK * 2;
constexpr size_t OFF_Y = OFF_PROJ + (size_t)NTOK * NPROJ * 2;

struct Params {
    const float* x; const float* c; const float* w_ada; const float* b_ada; const float* w_in; const float* sgu_g; const float* sgu_b;
    const float* w_sp; const float* b_sp; const float* w_out; const float* ln_g; const float* ln_b;
    float* out; unsigned char* ws; int phase; int pad;
};


#define XB_TMO      128
#define XB_XCNT(j)  (256  + 64 * (j))
#define XB_XSUB(j)  (1280 + 64 * (j))
#define XB_XGEN(j)  (2304 + 64 * (j))
#define XB_TOP      3328
#define XB_TOPGEN   3392
#define XCD_BAR_WORDS 3456
#define XB_SPIN_CAP (1u << 18)
#define LAS __attribute__((address_space(3)))
__device__ __forceinline__ unsigned xb_ld(unsigned* p)              { return __hip_atomic_load(p, __ATOMIC_RELAXED, __HIP_MEMORY_SCOPE_AGENT); }
__device__ __forceinline__ unsigned xb_add(unsigned* p, unsigned v) { return __hip_atomic_fetch_add(p, v, __ATOMIC_RELAXED, __HIP_MEMORY_SCOPE_AGENT); }
__device__ __forceinline__ unsigned xb_xcc_id() { return (unsigned)__builtin_amdgcn_s_getreg((3 << 11) | 20) & 0xFu; }
#define XB_SPIN(cond, bar) do { unsigned _sp = 0; while (cond) { __builtin_amdgcn_s_sleep(1); \
    if ((++_sp & 255u) == 0u) { if (xb_ld(&(bar)[XB_TMO])) break; if (_sp > XB_SPIN_CAP) { atomicAdd(&(bar)[XB_TMO], 1u); break; } } } } while (0)
struct XcdBarrier { unsigned* bar; unsigned x; volatile LAS unsigned* st; };
__device__ __forceinline__ XcdBarrier xcd_barrier_post(unsigned* bar, volatile LAS unsigned* st) {
    XcdBarrier b; b.bar = bar; b.x = xb_xcc_id(); b.st = st;
    if (threadIdx.x == 0) (void)xb_add(&bar[XB_XCNT(b.x)], 1u);
    return b;
}
__device__ __forceinline__ void xcd_barrier_complete(unsigned* bar, unsigned x, unsigned& nloc, unsigned& nx) {
    const unsigned G = gridDim.x * gridDim.y * gridDim.z;
    unsigned sum, cnt, mine, sp = 0u;
    for (;;) {
        sum = 0u; cnt = 0u; mine = 0u;
#pragma unroll
        for (unsigned j = 0; j < 16; ++j) { const unsigned c = xb_ld(&bar[XB_XCNT(j)]); sum += c; cnt += (c > 0u) ? 1u : 0u; mine = (j == x) ? c : mine; }
        if (sum == G) break;
        __builtin_amdgcn_s_sleep(1);
        if ((++sp & 255u) == 0u) { if (xb_ld(&bar[XB_TMO])) break; if (sp > XB_SPIN_CAP) { atomicAdd(&bar[XB_TMO], 1u); break; } }
    }
    nloc = mine > 0u ? mine : 1u; nx = cnt > 0u ? cnt : 1u;
}
__device__ __forceinline__ void xcd_barrier(const XcdBarrier& b) {
    asm volatile("s_waitcnt vmcnt(0)" ::: "memory");
    __syncthreads();
    if (threadIdx.x == 0) {
        unsigned* bar = b.bar;
        __builtin_amdgcn_s_waitcnt(0);
        unsigned nloc = b.st[0], nx = b.st[1];
        if (nloc == 0u) { xcd_barrier_complete(bar, b.x, nloc, nx); b.st[0] = nloc; b.st[1] = nx; }
        const unsigned old = xb_add(&bar[XB_XSUB(b.x)], 1u);
        const unsigned gen = old / nloc;
        if (old + 1u == (gen + 1u) * nloc) {
            __builtin_amdgcn_fence(__ATOMIC_RELEASE, "agent");
            asm volatile("s_waitcnt vmcnt(0)" ::: "memory");
            const unsigned og = xb_add(&bar[XB_TOP], 1u);
            const unsigned tg = og / nx;
            if (og + 1u == (tg + 1u) * nx) xb_add(&bar[XB_TOPGEN], 1u);
            else XB_SPIN(xb_ld(&bar[XB_TOPGEN]) == tg, bar);
            __builtin_amdgcn_fence(__ATOMIC_ACQUIRE, "agent");
            xb_add(&bar[XB_XGEN(b.x)], 1u);
            asm volatile("s_waitcnt vmcnt(0)" ::: "memory");
        } else {
            XB_SPIN(xb_ld(&bar[XB_XGEN(b.x)]) == gen, bar);
            __builtin_amdgcn_fence(__ATOMIC_ACQUIRE, "agent");
            asm volatile("s_waitcnt vmcnt(0)" ::: "memory");
        }
    }
    __syncthreads();
}
constexpr size_t OFF_BAR = 128 * 1024;

__device__ void p0_prologue(const Params& p, unsigned char* lds) {
    int tid = threadIdx.x; asm volatile("" : "+v"(tid)); const int lane = tid & 63, wave = tid >> 6;
    float* mod = (float*)(p.ws + OFF_MOD);
    float* sc = (float*)lds;
    float* red = (float*)(lds + 32768);
    for (int it = blockIdx.x; it < 96; it += gridDim.x) {
        for (int i = tid; i < 8 * 1024; i += NT) sc[i] = siluf_(p.c[i]);
        __syncthreads();
        const int q = tid & 7, r = tid >> 3; const int c0 = it * 32 + q * 4;
        float acc[8][4];
#pragma unroll
        for (int b = 0; b < 8; ++b) { acc[b][0] = 0.f; acc[b][1] = 0.f; acc[b][2] = 0.f; acc[b][3] = 0.f; }
#pragma unroll 4
        for (int i = 0; i < 16; ++i) { const int k = r + 64 * i; const f32x4 w = *(const f32x4*)(p.w_ada + (size_t)k * 3072 + c0);
#pragma unroll
            for (int b = 0; b < 8; ++b) { const float s = sc[b * 1024 + k]; acc[b][0] += s * w[0]; acc[b][1] += s * w[1]; acc[b][2] += s * w[2]; acc[b][3] += s * w[3]; } }
#pragma unroll
        for (int b = 0; b < 8; ++b)
#pragma unroll
            for (int j = 0; j < 4; ++j) { float v = acc[b][j]; v += __shfl_xor(v, 8); v += __shfl_xor(v, 16); v += __shfl_xor(v, 32); acc[b][j] = v; }
        if (lane < 8) {
#pragma unroll
            for (int b = 0; b < 8; ++b)
#pragma unroll
                for (int j = 0; j < 4; ++j) red[(wave * 8 + q) * 32 + b * 4 + j] = acc[b][j];
        }
        __syncthreads();
        if (tid < 256) { const int b = tid >> 5, col = tid & 31, qq = col >> 2, j = col & 3; float s = 0.f;
#pragma unroll
            for (int w = 0; w < 8; ++w) s += red[(w * 8 + qq) * 32 + b * 4 + j];
            mod[b * 3072 + it * 32 + col] = s + p.b_ada[it * 32 + col]; }
        __syncthreads();
    }
    float* tb = (float*)(lds + 49152);
    for (int tile = blockIdx.x; tile < 896 + 256; tile += gridDim.x) {
        const float* W; bf16_t* Wt; int N, tk, tn;
        if (tile < 896) { W = p.w_in; Wt = (bf16_t*)(p.ws + OFF_WIN); N = NPROJ; tk = tile / 56; tn = tile % 56; }
        else { const int t2 = tile - 896; W = p.w_out; Wt = (bf16_t*)(p.ws + OFF_WOUT); N = D_MODEL; tk = t2 / 16; tn = t2 % 16; }
        const int k0 = tk * 64, n0 = tn * 64;
        { const int n4 = tid & 15, kk = tid >> 4;
#pragma unroll
          for (int i = 0; i < 2; ++i) { const int k = kk + 32 * i; const f32x4 v = *(const f32x4*)(W + (size_t)(k0 + k) * N + n0 + n4 * 4);
              tb[k * 65 + n4 * 4 + 0] = v[0]; tb[k * 65 + n4 * 4 + 1] = v[1]; tb[k * 65 + n4 * 4 + 2] = v[2]; tb[k * 65 + n4 * 4 + 3] = v[3]; } }
        __syncthreads();
        { const int n = tid >> 3, ks = tid & 7; u32x4 o;
          o[0] = cvt_pk_bf16(tb[(ks * 8 + 0) * 65 + n], tb[(ks * 8 + 1) * 65 + n]); o[1] = cvt_pk_bf16(tb[(ks * 8 + 2) * 65 + n], tb[(ks * 8 + 3) * 65 + n]);
          o[2] = cvt_pk_bf16(tb[(ks * 8 + 4) * 65 + n], tb[(ks * 8 + 5) * 65 + n]); o[3] = cvt_pk_bf16(tb[(ks * 8 + 6) * 65 + n], tb[(ks * 8 + 7) * 65 + n]);
          *(u32x4*)(Wt + (size_t)(n0 + n) * D_MODEL + k0 + ks * 8) = o; }
        __syncthreads();
    }
    bf16_t* wsp = (bf16_t*)(p.ws + OFF_WSP);
    for (int i = blockIdx.x * NT + tid; i < NGRP * CHUNK * CHUNK / 8; i += gridDim.x * NT) {
        const int e = i * 8, t = (e >> 7) & 127, s0 = e & 127;
        const f32x4 a = *(const f32x4*)(p.w_sp + e), b = *(const f32x4*)(p.w_sp + e + 4);
        float v[8] = {a[0], a[1], a[2], a[3], b[0], b[1], b[2], b[3]};
#pragma unroll
        for (int j = 0; j < 8; ++j) v[j] = (s0 + j <= t) ? v[j] : 0.f;
        u32x4 o; o[0] = cvt_pk_bf16(v[0], v[1]); o[1] = cvt_pk_bf16(v[2], v[3]); o[2] = cvt_pk_bf16(v[4], v[5]); o[3] = cvt_pk_bf16(v[6], v[7]);
        *(u32x4*)(wsp + e) = o;
    }
}

__device__ void p_hconv(const Params& p) {
    const float* mod = (const float*)(p.ws + OFF_MOD); bf16_t* hb = (bf16_t*)(p.ws + OFF_HB);
    int tid = threadIdx.x; asm volatile("" : "+v"(tid));
    const size_t stride = (size_t)gridDim.x * NT, total = (size_t)NTOK * D_MODEL / 8;
    for (size_t i0 = (size_t)blockIdx.x * NT + tid; i0 < total; i0 += 4 * stride) {
        f32x4 x0[4], x1[4];
#pragma unroll
        for (int u = 0; u < 4; ++u) { const size_t i = i0 + u * stride; if (i < total) { x0[u] = __builtin_nontemporal_load((const f32x4*)(p.x + i * 8)); x1[u] = __builtin_nontemporal_load((const f32x4*)(p.x + i * 8 + 4)); } }
#pragma unroll
        for (int u = 0; u < 4; ++u) { const size_t i = i0 + u * stride; if (i < total) {
            const size_t e = i * 8; const int col = (int)(e & 1023); const int b = (int)(e >> 21);
            const f32x4 sh0 = *(const f32x4*)(mod + b * 3072 + col), sh1 = *(const f32x4*)(mod + b * 3072 + col + 4);
            const f32x4 sc0 = *(const f32x4*)(mod + b * 3072 + 1024 + col), sc1 = *(const f32x4*)(mod + b * 3072 + 1024 + col + 4);
            const f32x4 h0 = x0[u] * (1.0f + sc0) + sh0, h1 = x1[u] * (1.0f + sc1) + sh1;
            u32x4 o; o[0] = cvt_pk_bf16(h0[0], h0[1]); o[1] = cvt_pk_bf16(h0[2], h0[3]); o[2] = cvt_pk_bf16(h1[0], h1[1]); o[3] = cvt_pk_bf16(h1[2], h1[3]);
            *(u32x4*)(hb + e) = o; } }
    }
}

constexpr int BM = 256, BK = 64, HALF = 128, NXCD = 8, WGM = 8, HT = HALF * BK;
__device__ __forceinline__ int lds_byte(int r, int c) { int st = (r >> 4) * 2 + (c >> 5), rr = r & 15, cc = c & 31, ob = rr * 64 + cc * 2; return st * 1024 + (ob ^ (((ob >> 9) & 1) << 5)); }
__device__ __forceinline__ void stage_rc(int b, int& R, int& C) { int st = b / 1024, sb = b % 1024, swz = sb ^ (((sb >> 9) & 1) << 5); R = (st >> 1) * 16 + swz / 64; C = (st & 1) * 32 + (swz % 64) / 2; }

struct TileOrder {
    int nM, nN, nwg, G, c;
    __device__ void init(int M, int N, int G_, int c_) { nM = M / BM; nN = N / BM; nwg = nM * nN; G = G_; c = c_; }
    __device__ bool next(int i, int& pm, int& pn) const {
        const long L = (long)i * G + c; if (L >= nwg) return false;
        int wgid = (int)L; { const int q = nwg / NXCD, r = nwg % NXCD, xcd = wgid % NXCD, off = wgid / NXCD; wgid = (xcd < r ? xcd * (q + 1) : r * (q + 1) + (xcd - r) * q) + off; }
        const int nig = WGM * nN, gid = wgid / nig, fm = gid * WGM, gsz = (nM - fm) < WGM ? (nM - fm) : WGM;
        pm = fm + ((wgid % nig) % gsz); pn = (wgid % nig) / gsz; return true;
    }
};

__device__ __forceinline__ void gemm_tile(const bf16_t* __restrict__ A, const bf16_t* __restrict__ Bt, const int K, const int brow, const int bcol, bf16_t* shm, f32x4 (&acc)[2][2][4][2]) {
#define SA(b, h) (shm + ((b) * 2 + (h)) * HT)
#define SB(b, h) (shm + (4 + (b) * 2 + (h)) * HT)
#define STAGE(P, BASE, br, kt) do { const char* _gb = (const char*)(BASE) + ((size_t)(br) * K + (size_t)(kt) * BK) * 2; \
    for (int _i = 0; _i < 2; ++_i) { int _b = gtx * 16 + _i * 8192; \
      __builtin_amdgcn_global_load_lds((const unsigned*)(_gb + soff[_i]), (__attribute__((address_space(3))) unsigned*)((char*)(P) + _b), 16, 0, 0); } } while (0)
#define LDA(dst, b, h) for (int m = 0; m < 4; ++m) for (int k = 0; k < 2; ++k) \
    dst[m][k] = *reinterpret_cast<const bf16x8*>((char*)SA(b, h) + lds_byte(wr * 64 + m * 16 + fr, k * 32 + fq * 8))
#define LDB(dst, b, h) for (int n = 0; n < 2; ++n) for (int k = 0; k < 2; ++k) \
    dst[n][k] = *reinterpret_cast<const bf16x8*>((char*)SB(b, h) + lds_byte(wc * 32 + n * 16 + fr, k * 32 + fq * 8))
#define MMA(ai, bj, At_, Bt_) do { __builtin_amdgcn_s_setprio(1); \
    for (int m = 0; m < 4; ++m) for (int n = 0; n < 2; ++n) for (int k = 0; k < 2; ++k) \
      acc[ai][bj][m][n] = __builtin_amdgcn_mfma_f32_16x16x32_bf16(Bt_[n][k], At_[m][k], acc[ai][bj][m][n], 0, 0, 0); \
    __builtin_amdgcn_s_setprio(0); } while (0)
#define WAIT_V(n) asm volatile("s_waitcnt vmcnt(" #n ")" ::: "memory")
#define WAIT_L(n) asm volatile("s_waitcnt lgkmcnt(" #n ")" ::: "memory")
#define BAR __builtin_amdgcn_s_barrier()
#define SCHED __builtin_amdgcn_sched_barrier(0)
    int gtx = threadIdx.x; asm volatile("" : "+v"(gtx));
    const int wid = gtx >> 6, lane = gtx & 63, wr = __builtin_amdgcn_readfirstlane(wid >> 2), wc = wid & 3, fr = lane & 15, fq = lane >> 4;
#pragma unroll
    for (int a = 0; a < 2; ++a)
#pragma unroll
        for (int b = 0; b < 2; ++b)
#pragma unroll
            for (int m = 0; m < 4; ++m)
#pragma unroll
                for (int n = 0; n < 2; ++n) acc[a][b][m][n] = (f32x4){0.f, 0.f, 0.f, 0.f};
    bf16x8 At[4][2], B0[2][2], B1[2][2];
    unsigned soff[2];
    for (int _i = 0; _i < 2; ++_i) { int _r, _c; stage_rc(gtx * 16 + _i * 8192, _r, _c); soff[_i] = (unsigned)(_r * K + _c) * 2u; }
    const int nt = K / BK;
    STAGE(SB(0, 0), Bt, bcol, 0); STAGE(SA(0, 0), A, brow, 0);
    STAGE(SB(0, 1), Bt, bcol + HALF, 0); STAGE(SA(0, 1), A, brow + HALF, 0);
    if (wr == 1) BAR;
    WAIT_V(4); BAR;
    STAGE(SB(1, 0), Bt, bcol, 1); STAGE(SA(1, 0), A, brow, 1); STAGE(SB(1, 1), Bt, bcol + HALF, 1);
    WAIT_V(6); BAR;
    for (int t = 0; t < nt - 2; t += 2) {
        LDB(B0, 0, 0); SCHED; LDA(At, 0, 0); STAGE(SA(1, 1), A, brow + HALF, t + 1);
        WAIT_L(8); BAR; WAIT_L(0); MMA(0, 0, At, B0); BAR; SCHED;
        LDB(B1, 0, 1); STAGE(SB(0, 0), Bt, bcol, t + 2);
        BAR; WAIT_L(0); MMA(0, 1, At, B1); BAR;
        LDA(At, 0, 1); STAGE(SA(0, 0), A, brow, t + 2);
        BAR; WAIT_L(0); MMA(1, 0, At, B0); BAR; SCHED;
        STAGE(SB(0, 1), Bt, bcol + HALF, t + 2);
        WAIT_V(6); BAR; MMA(1, 1, At, B1); BAR;
        LDB(B0, 1, 0); SCHED; LDA(At, 1, 0); STAGE(SA(0, 1), A, brow + HALF, t + 2);
        WAIT_L(8); BAR; WAIT_L(0); MMA(0, 0, At, B0); BAR; SCHED;
        LDB(B1, 1, 1); STAGE(SB(1, 0), Bt, bcol, t + 3);
        BAR; WAIT_L(0); MMA(0, 1, At, B1); BAR;
        LDA(At, 1, 1); STAGE(SA(1, 0), A, brow, t + 3);
        BAR; WAIT_L(0); MMA(1, 0, At, B0); BAR; SCHED;
        STAGE(SB(1, 1), Bt, bcol + HALF, t + 3);
        WAIT_V(6); BAR; MMA(1, 1, At, B1); BAR;
    }
    { LDB(B0, 0, 0); LDA(At, 0, 0); STAGE(SA(1, 1), A, brow + HALF, nt - 1);
      BAR; WAIT_L(0); MMA(0, 0, At, B0); BAR;
      LDB(B1, 0, 1); BAR; WAIT_L(0); MMA(0, 1, At, B1); BAR;
      LDA(At, 0, 1); WAIT_V(4); BAR; WAIT_L(0); MMA(1, 0, At, B0); MMA(1, 1, At, B1); BAR; }
    { LDB(B0, 1, 0); LDA(At, 1, 0); WAIT_V(2); BAR; WAIT_L(0); MMA(0, 0, At, B0); BAR;
      LDB(B1, 1, 1); WAIT_V(0); BAR; WAIT_L(0); MMA(0, 1, At, B1); BAR;
      LDA(At, 1, 1); BAR; WAIT_L(0); MMA(1, 0, At, B0); MMA(1, 1, At, B1); BAR; }
    if (wr == 0) BAR;
#undef SA
#undef SB
#undef STAGE
#undef LDA
#undef LDB
#undef MMA
}

__device__ void p_inproj(const Params& p, unsigned char* lds) {
    const bf16_t* hb = (const bf16_t*)(p.ws + OFF_HB); const bf16_t* winT = (const bf16_t*)(p.ws + OFF_WIN); bf16_t* proj = (bf16_t*)(p.ws + OFF_PROJ);
    TileOrder ord; ord.init(NTOK, NPROJ, gridDim.x, blockIdx.x);
    for (int i = 0;; ++i) {
        int pm, pn; if (!ord.next(i, pm, pn)) break;
        f32x4 acc[2][2][4][2];
        gemm_tile(hb, winT, D_MODEL, pm * BM, pn * BM, (bf16_t*)lds, acc);
        int tx = threadIdx.x; asm volatile("" : "+v"(tx));
        const int wid = tx >> 6, lane = tx & 63, wr = wid >> 2, wc = wid & 3, fr = lane & 15, fq = lane >> 4;
        const int seg = pn >> 1;
#pragma unroll
        for (int ai = 0; ai < 2; ++ai)
#pragma unroll
            for (int m = 0; m < 4; ++m) {
                const int row = pm * BM + ai * HALF + wr * 64 + m * 16 + fr;
                bf16_t* rowp = proj + (size_t)row * NPROJ + pn * BM + wc * 32 + fq * 4;
#pragma unroll
                for (int bj = 0; bj < 2; ++bj)
#pragma unroll
                    for (int n = 0; n < 2; ++n) {
                        f32x4 v = acc[ai][bj][m][n];
                        if (seg <= 1) { v[0] = geluf_(v[0]); v[1] = geluf_(v[1]); v[2] = geluf_(v[2]); v[3] = geluf_(v[3]); }
                        else if (seg == 2 || seg == 6) { v[0] = siluf_(v[0]); v[1] = siluf_(v[1]); v[2] = siluf_(v[2]); v[3] = siluf_(v[3]); }
                        else if (seg == 3) { v = v * QSCALE; }
                        u32x2 o; o[0] = cvt_pk_bf16(v[0], v[1]); o[1] = cvt_pk_bf16(v[2], v[3]);
                        *(u32x2*)(rowp + bj * HALF + n * 16) = o;
                    }
            }
        asm volatile("s_waitcnt vmcnt(0)" ::: "memory");
    }
}

constexpr size_t OFF_STATS = 256 * 1024;
__device__ void p_outproj(const Params& p, unsigned char* lds, const XcdBarrier& bar, const bool fused) {
    const bf16_t* yb = (const bf16_t*)(p.ws + OFF_Y); const bf16_t* woutT = (const bf16_t*)(p.ws + OFF_WOUT); const float* mod = (const float*)(p.ws + OFF_MOD);
    TileOrder ord; ord.init(NTOK, D_MODEL, gridDim.x, blockIdx.x);
    for (int i = 0;; ++i) {
        int pm, pn; if (!ord.next(i, pm, pn)) break;
        f32x4 acc[2][2][4][2];
        gemm_tile(yb, woutT, D_MODEL, pm * BM, pn * BM, (bf16_t*)lds, acc);
        int tx = threadIdx.x; asm volatile("" : "+v"(tx));
        const int wid = tx >> 6, lane = tx & 63, wr = wid >> 2, wc = wid & 3, fr = lane & 15, fq = lane >> 4;
        const int b = (pm * BM) / SEQ; const int col0 = pn * BM + wc * 32 + fq * 4;
        {   f32x4 gate[2][2];
#pragma unroll
            for (int bj = 0; bj < 2; ++bj)
#pragma unroll
                for (int n = 0; n < 2; ++n) gate[bj][n] = *(const f32x4*)(mod + b * 3072 + 2048 + col0 + bj * HALF + n * 16);
#pragma unroll
            for (int ai = 0; ai < 2; ++ai) {
                f32x4 xv[4][2][2];
#pragma unroll
                for (int m = 0; m < 4; ++m) { const size_t off = (size_t)(pm * BM + ai * HALF + wr * 64 + m * 16 + fr) * D_MODEL + col0;
#pragma unroll
                    for (int bj = 0; bj < 2; ++bj)
#pragma unroll
                        for (int n = 0; n < 2; ++n) xv[m][bj][n] = __builtin_nontemporal_load((const f32x4*)(p.x + off + bj * HALF + n * 16)); }
#pragma unroll
                for (int m = 0; m < 4; ++m)
#pragma unroll
                    for (int bj = 0; bj < 2; ++bj)
#pragma unroll
                        for (int n = 0; n < 2; ++n) acc[ai][bj][m][n] = xv[m][bj][n] * ALPHA + gate[bj][n] * acc[ai][bj][m][n];
            } }
        if (!fused) {
#pragma unroll
            for (int ai = 0; ai < 2; ++ai)
#pragma unroll
                for (int m = 0; m < 4; ++m) { const size_t off = (size_t)(pm * BM + ai * HALF + wr * 64 + m * 16 + fr) * D_MODEL + col0;
#pragma unroll
                    for (int bj = 0; bj < 2; ++bj)
#pragma unroll
                        for (int n = 0; n < 2; ++n) *(f32x4*)(p.out + off + bj * HALF + n * 16) = acc[ai][bj][m][n]; }
            asm volatile("s_waitcnt vmcnt(0)" ::: "memory");
            continue;
        }
        float* P = (float*)lds;
        float* S = (float*)(lds + 8192);
        float* gstats = (float*)(p.ws + OFF_STATS);
#pragma unroll
        for (int ai = 0; ai < 2; ++ai)
#pragma unroll
            for (int m = 0; m < 4; ++m) { float s1 = 0.f, s2 = 0.f;
#pragma unroll
                for (int bj = 0; bj < 2; ++bj)
#pragma unroll
                    for (int n = 0; n < 2; ++n) { const f32x4 v = acc[ai][bj][m][n]; s1 += (v[0] + v[1]) + (v[2] + v[3]); s2 += (v[0] * v[0] + v[1] * v[1]) + (v[2] * v[2] + v[3] * v[3]); }
                s1 += __shfl_xor(s1, 16); s2 += __shfl_xor(s2, 16); s1 += __shfl_xor(s1, 32); s2 += __shfl_xor(s2, 32);
                if (fq == 0) { const int rl = ai * HALF + wr * 64 + m * 16 + fr; P[(rl * 4 + wc) * 2] = s1; P[(rl * 4 + wc) * 2 + 1] = s2; } }
        __syncthreads();
        if (tx < 256) { const f32x4 a = *(const f32x4*)(P + tx * 8), c2 = *(const f32x4*)(P + tx * 8 + 4);
            float* gp = gstats + ((size_t)(pm * BM + tx) * 4 + pn) * 2; gp[0] = (a[0] + a[2]) + (c2[0] + c2[2]); gp[1] = (a[1] + a[3]) + (c2[1] + c2[3]); }
        xcd_barrier(bar);
        if (tx < 256) { const float* gp = gstats + (size_t)(pm * BM + tx) * 8; const f32x4 a = *(const f32x4*)gp, c2 = *(const f32x4*)(gp + 4);
            const float mean = ((a[0] + a[2]) + (c2[0] + c2[2])) * (1.0f / 1024.f); const float ex2 = ((a[1] + a[3]) + (c2[1] + c2[3])) * (1.0f / 1024.f);
            const float var = fmaxf(ex2 - mean * mean, 0.f); S[tx * 2] = mean; S[tx * 2 + 1] = 1.0f / sqrtf(var + LN_EPS); }
        __syncthreads();
        {   f32x4 gg[2][2], bb[2][2];
#pragma unroll
            for (int bj = 0; bj < 2; ++bj)
#pragma unroll
                for (int n = 0; n < 2; ++n) { gg[bj][n] = *(const f32x4*)(p.ln_g + col0 + bj * HALF + n * 16); bb[bj][n] = *(const f32x4*)(p.ln_b + col0 + bj * HALF + n * 16); }
#pragma unroll
            for (int ai = 0; ai < 2; ++ai)
#pragma unroll
                for (int m = 0; m < 4; ++m) { const int rl = ai * HALF + wr * 64 + m * 16 + fr; const float mean = S[rl * 2], rstd = S[rl * 2 + 1];
                    const size_t off = (size_t)(pm * BM + rl) * D_MODEL + col0;
#pragma unroll
                    for (int bj = 0; bj < 2; ++bj)
#pragma unroll
                        for (int n = 0; n < 2; ++n) __builtin_nontemporal_store((acc[ai][bj][m][n] - mean) * rstd * gg[bj][n] + bb[bj][n], (f32x4*)(p.out + off + bj * HALF + n * 16)); } }
    }
}

constexpr int KROW = 72;
__device__ __forceinline__ void attn_unit(const Params& p, unsigned char* lds, const int b, const int h, const int qb) {
    const bf16_t* proj = (const bf16_t*)(p.ws + OFF_PROJ); bf16_t* yb = (bf16_t*)(p.ws + OFF_Y);
    int tid = threadIdx.x; asm volatile("" : "+v"(tid)); const int lane = tid & 63, wave = __builtin_amdgcn_readfirstlane(tid >> 6), c = lane & 31, hh = lane >> 5;
    bf16_t* Ks = (bf16_t*)lds;
    bf16_t* Vt = (bf16_t*)(lds + 2 * 64 * KROW * 2);
    const size_t tokbase = (size_t)b * SEQ; const int q0 = qb * 256, tq0 = q0 + wave * 32;
    bf16x8 qf[4];
    { const bf16_t* qp = proj + (tokbase + tq0 + c) * NPROJ + C_Q + h * 64 + hh * 8;
#pragma unroll
      for (int ks = 0; ks < 4; ++ks) qf[ks] = *(const bf16x8*)(qp + ks * 16); }
    f16x8 uf[2];
#pragma unroll
    for (int ks2 = 0; ks2 < 2; ++ks2)
#pragma unroll
        for (int jj = 0; jj < 8; ++jj) { const int key = 16 * ks2 + 8 * (jj >> 2) + 4 * hh + (jj & 3); uf[ks2][jj] = (key >= c) ? (_Float16)1.0f : (_Float16)0.0f; }
    f32x16 o0, o1;
#pragma unroll
    for (int r = 0; r < 16; ++r) { o0[r] = 0.f; o1[r] = 0.f; }
    float R = 0.f;
    const int ntile = (q0 + 256) / 64;
    const int skey = tid >> 3, sch = tid & 7; const int spk = (skey & ~12) | ((skey & 4) << 1) | ((skey & 8) >> 1);
    u32x4 kreg, vreg;
    { const bf16_t* kp = proj + (tokbase + (ntile - 1) * 64 + skey) * NPROJ + h * 64 + sch * 8; kreg = *(const u32x4*)(kp + C_K); vreg = *(const u32x4*)(kp + C_VB); }
    int buf = 0;
    { *(u32x4*)(Ks + (buf * 64 + skey) * KROW + sch * 8) = kreg;
      bf16_t* vp = Vt + (buf * 64 + sch * 8) * KROW + spk;
#pragma unroll
      for (int e = 0; e < 4; ++e) { vp[(2 * e) * KROW] = (bf16_t)(vreg[e] & 0xffffu); vp[(2 * e + 1) * KROW] = (bf16_t)(vreg[e] >> 16); } }
    __syncthreads();
    for (int kt = ntile - 1; kt >= 0; --kt) {
        if (kt > 0) { const bf16_t* kp = proj + (tokbase + (kt - 1) * 64 + skey) * NPROJ + h * 64 + sch * 8; kreg = *(const u32x4*)(kp + C_K); vreg = *(const u32x4*)(kp + C_VB); }
        const bf16_t* Kb = Ks + buf * 64 * KROW; const bf16_t* Vb = Vt + buf * 64 * KROW;
#pragma unroll
        for (int sub = 1; sub >= 0; --sub) {
            const int ks0 = kt * 64 + sub * 32;
            if (ks0 <= tq0) {
                const bool diag = (ks0 == tq0);
                f32x16 z;
#pragma unroll
                for (int r = 0; r < 16; ++r) z[r] = 0.f;
#pragma unroll
                for (int ks = 0; ks < 4; ++ks) { const bf16x8 kf = *(const bf16x8*)(Kb + (sub * 32 + c) * KROW + ks * 16 + hh * 8); z = __builtin_amdgcn_mfma_f32_32x32x16_bf16(kf, qf[ks], z, 0, 0, 0); }
                float nsp[16];
#pragma unroll
                for (int r = 0; r < 16; ++r) {
                    const float zz = z[r];
                    const float l = __builtin_amdgcn_logf(1.0f + __builtin_amdgcn_exp2f(-fabsf(zz)));
                    float v = -(fmaxf(zz, 0.f) + l);
                    if (diag) { const int s = (r & 3) + 8 * (r >> 2) + 4 * hh; if (s >= c) v = 0.f; }
                    nsp[r] = v;
                }
                f16x8 lf[2];
                { unsigned w[8];
#pragma unroll
                  for (int i = 0; i < 8; ++i) w[i] = cvt_pk_f16(nsp[2 * i], nsp[2 * i + 1]);
                  u32x4 t0 = {w[0], w[1], w[2], w[3]}, t1 = {w[4], w[5], w[6], w[7]};
                  lf[0] = __builtin_bit_cast(f16x8, t0); lf[1] = __builtin_bit_cast(f16x8, t1); }
                f32x16 cum;
#pragma unroll
                for (int r = 0; r < 16; ++r) cum[r] = R;
                cum = __builtin_amdgcn_mfma_f32_32x32x16_f16(uf[0], lf[0], cum, 0, 0, 0);
                cum = __builtin_amdgcn_mfma_f32_32x32x16_f16(uf[1], lf[1], cum, 0, 0, 0);
                float a[16];
#pragma unroll
                for (int r = 0; r < 16; ++r) {
                    float v = __builtin_amdgcn_exp2f(z[r] + cum[r]);
                    if (diag) { const int s = (r & 3) + 8 * (r >> 2) + 4 * hh; if (s >= c) v = 0.f; }
                    a[r] = v;
                }
                R = __shfl(cum[0], c);
                bf16x8 pf[2];
                { unsigned w[8];
#pragma unroll
                  for (int i = 0; i < 8; ++i) w[i] = cvt_pk_bf16(a[2 * i], a[2 * i + 1]);
                  u32x4 t0 = {w[0], w[1], w[2], w[3]}, t1 = {w[4], w[5], w[6], w[7]};
                  pf[0] = __builtin_bit_cast(bf16x8, t0); pf[1] = __builtin_bit_cast(bf16x8, t1); }
#pragma unroll
                for (int ks2 = 0; ks2 < 2; ++ks2) {
                    const bf16x8 v0 = *(const bf16x8*)(Vb + (c) * KROW + sub * 32 + ks2 * 16 + hh * 8);
                    const bf16x8 v1 = *(const bf16x8*)(Vb + (32 + c) * KROW + sub * 32 + ks2 * 16 + hh * 8);
                    o0 = __builtin_amdgcn_mfma_f32_32x32x16_bf16(v0, pf[ks2], o0, 0, 0, 0);
                    o1 = __builtin_amdgcn_mfma_f32_32x32x16_bf16(v1, pf[ks2], o1, 0, 0, 0);
                }
            }
        }
        if (kt > 0) {
            const int nb = buf ^ 1;
            *(u32x4*)(Ks + (nb * 64 + skey) * KROW + sch * 8) = kreg;
            bf16_t* vp = Vt + (nb * 64 + sch * 8) * KROW + spk;
#pragma unroll
            for (int e = 0; e < 4; ++e) { vp[(2 * e) * KROW] = (bf16_t)(vreg[e] & 0xffffu); vp[(2 * e + 1) * KROW] = (bf16_t)(vreg[e] >> 16); }
        }
        __syncthreads();
        buf ^= 1;
    }
    { const size_t tok = tokbase + tq0 + c; const bf16_t* zp = proj + tok * NPROJ + C_ZB + h * 64; bf16_t* yp = yb + tok * D_MODEL + 512 + h * 64;
#pragma unroll
      for (int dt = 0; dt < 2; ++dt)
#pragma unroll
          for (int g = 0; g < 4; ++g) { const int d0 = dt * 32 + 8 * g + 4 * hh; const u32x2 zz = *(const u32x2*)(zp + d0);
              const float v0 = dt ? o1[4 * g + 0] : o0[4 * g + 0], v1 = dt ? o1[4 * g + 1] : o0[4 * g + 1], v2 = dt ? o1[4 * g + 2] : o0[4 * g + 2], v3 = dt ? o1[4 * g + 3] : o0[4 * g + 3];
              u32x2 o; o[0] = cvt_pk_bf16(bflo(zz[0]) * v0, bfhi(zz[0]) * v1); o[1] = cvt_pk_bf16(bflo(zz[1]) * v2, bfhi(zz[1]) * v3);
              *(u32x2*)(yp + d0) = o; } }
}

constexpr int VROW = 136;
__device__ __forceinline__ void sgu_item(const Params& p, unsigned char* lds, const int ch, const int hf) {
    const bf16_t* proj = (const bf16_t*)(p.ws + OFF_PROJ); bf16_t* yb = (bf16_t*)(p.ws + OFF_Y); const bf16_t* wsp = (const bf16_t*)(p.ws + OFF_WSP);
    int tid = threadIdx.x; asm volatile("" : "+v"(tid)); const int lane = tid & 63, wave = __builtin_amdgcn_readfirstlane(tid >> 6), c = lane & 31, hh = lane >> 5;
    float* stats = (float*)(lds + 65536);
    bf16_t* vnT = (bf16_t*)(lds + 65536 + 1024);
    const size_t tok0 = (size_t)ch * CHUNK;
    { const int token = tid >> 2, qd = tid & 3; const bf16_t* vp = proj + (tok0 + token) * NPROJ + C_V + qd * 128; float s = 0.f, ss = 0.f;
#pragma unroll 4
      for (int i = 0; i < 16; ++i) { const u32x4 w = *(const u32x4*)(vp + i * 8);
#pragma unroll
          for (int e = 0; e < 4; ++e) { const float a = bflo(w[e]), bb = bfhi(w[e]); s += a + bb; ss += a * a + bb * bb; } }
      s += __shfl_xor(s, 1); ss += __shfl_xor(ss, 1); s += __shfl_xor(s, 2); ss += __shfl_xor(ss, 2);
      const float mean = s * (1.0f / 512.f); const float var = fmaxf(ss * (1.0f / 512.f) - mean * mean, 0.f);
      if (qd == 0) { stats[token * 2] = mean; stats[token * 2 + 1] = 1.0f / sqrtf(var + LN_EPS); } }
    __syncthreads();
    for (int gi = 0; gi < 4; ++gi) {
        const int g = hf * 4 + gi;
        { const int s = tid & 127, cc = tid >> 7; const float mean = stats[s * 2], rstd = stats[s * 2 + 1];
          const bf16_t* vp = proj + (tok0 + s) * NPROJ + C_V + g * 64 + cc * 16;
#pragma unroll
          for (int i = 0; i < 2; ++i) { const u32x4 w = *(const u32x4*)(vp + i * 8);
#pragma unroll
              for (int e = 0; e < 4; ++e) { const int chn = g * 64 + cc * 16 + i * 8 + 2 * e;
                  const float a = (bflo(w[e]) - mean) * rstd * p.sgu_g[chn] + p.sgu_b[chn], bb = (bfhi(w[e]) - mean) * rstd * p.sgu_g[chn + 1] + p.sgu_b[chn + 1];
                  vnT[(cc * 16 + i * 8 + 2 * e) * VROW + s] = f2bf(a); vnT[(cc * 16 + i * 8 + 2 * e + 1) * VROW + s] = f2bf(bb); } } }
        __syncthreads();
        { const int tt = wave >> 1, ct = wave & 1; f32x16 acc;
#pragma unroll
          for (int r = 0; r < 16; ++r) acc[r] = 0.f;
          const bf16_t* wrow = wsp + ((size_t)g * CHUNK + tt * 32 + c) * CHUNK + hh * 8; const bf16_t* vrow = vnT + (ct * 32 + c) * VROW + hh * 8;
          const int nks = 2 * (tt + 1);
          for (int ks = 0; ks < nks; ++ks) { const bf16x8 af = *(const bf16x8*)(vrow + ks * 16); const bf16x8 bfr = *(const bf16x8*)(wrow + ks * 16);
              acc = __builtin_amdgcn_mfma_f32_32x32x16_bf16(af, bfr, acc, 0, 0, 0); }
          const int t = tt * 32 + c; const size_t tok = tok0 + t; const float bs = p.b_sp[g * CHUNK + t];
          const bf16_t* up = proj + tok * NPROJ + C_U + g * 64 + ct * 32; const bf16_t* zp = proj + tok * NPROJ + C_ZA + g * 64 + ct * 32; bf16_t* yp = yb + tok * D_MODEL + g * 64 + ct * 32;
#pragma unroll
          for (int g4 = 0; g4 < 4; ++g4) { const int c0 = 8 * g4 + 4 * hh; const u32x2 uu = *(const u32x2*)(up + c0), zz = *(const u32x2*)(zp + c0);
              u32x2 o; o[0] = cvt_pk_bf16(bflo(zz[0]) * bflo(uu[0]) * (acc[4 * g4 + 0] + bs), bfhi(zz[0]) * bfhi(uu[0]) * (acc[4 * g4 + 1] + bs));
              o[1] = cvt_pk_bf16(bflo(zz[1]) * bflo(uu[1]) * (acc[4 * g4 + 2] + bs), bfhi(zz[1]) * bfhi(uu[1]) * (acc[4 * g4 + 3] + bs));
              *(u32x2*)(yp + c0) = o; } }
        __syncthreads();
    }
}

__device__ void p_mixers(const Params& p, unsigned char* lds) {
    for (int it = blockIdx.x; it < 256; it += gridDim.x) {
        const int xcd = it & 7, slot = it >> 3; const int bh = xcd * 8 + (slot >> 2), pr = slot & 3;
        for (int u = 0; u < 2; ++u) attn_unit(p, lds, bh >> 3, bh & 7, u ? pr : 7 - pr);
    }
    for (int it = blockIdx.x; it < 256; it += gridDim.x) sgu_item(p, lds, it >> 1, it & 1);
}

__device__ void p_ln(const Params& p) {
    int tid = threadIdx.x; asm volatile("" : "+v"(tid)); const int lane = tid & 63, wave = tid >> 6;
    for (int row = blockIdx.x * 8 + wave; row < NTOK; row += gridDim.x * 8) {
        float* rp = p.out + (size_t)row * D_MODEL; f32x4 v[4]; float s = 0.f;
#pragma unroll
        for (int j = 0; j < 4; ++j) { v[j] = *(const f32x4*)(rp + lane * 4 + 256 * j); s += (v[j][0] + v[j][1]) + (v[j][2] + v[j][3]); }
#pragma unroll
        for (int o = 32; o; o >>= 1) s += __shfl_xor(s, o);
        const float mu = s * (1.0f / 1024.f); float q = 0.f;
#pragma unroll
        for (int j = 0; j < 4; ++j) { const f32x4 d = v[j] - mu; q += (d[0] * d[0] + d[1] * d[1]) + (d[2] * d[2] + d[3] * d[3]); }
#pragma unroll
        for (int o = 32; o; o >>= 1) q += __shfl_xor(q, o);
        const float rstd = 1.0f / sqrtf(q * (1.0f / 1024.f) + LN_EPS);
#pragma unroll
        for (int j = 0; j < 4; ++j) { const int col = lane * 4 + 256 * j; const f32x4 g = *(const f32x4*)(p.ln_g + col), bb = *(const f32x4*)(p.ln_b + col);
            *(f32x4*)(rp + col) = (v[j] - mu) * rstd * g + bb; }
    }
}

#if MODE == 0
__global__ void __launch_bounds__(NT, 2) mega(Params p) {
    extern __shared__ __attribute__((aligned(16))) unsigned char lds[];
    volatile LAS unsigned* st = (volatile LAS unsigned*)((LAS unsigned char*)lds + 131072);
    if (threadIdx.x == 0) { st[0] = 0u; st[1] = 0u; st[2] = 0u; st[3] = 0u; }
    __syncthreads();
    const XcdBarrier bar = xcd_barrier_post((unsigned*)(p.ws + OFF_BAR), st);
    p0_prologue(p, lds); xcd_barrier(bar);
    p_hconv(p); xcd_barrier(bar);
    p_inproj(p, lds); xcd_barrier(bar);
    p_mixers(p, lds); xcd_barrier(bar);
    const bool fused = (gridDim.x == 256);
    p_outproj(p, lds, bar, fused);
    if (!fused) { cg::this_grid().sync(); p_ln(p); }
}
#else
__global__ void __launch_bounds__(NT, 2) mega(Params p) { extern __shared__ __attribute__((aligned(16))) unsigned char lds[]; p0_prologue(p, lds); }
__global__ void __launch_bounds__(NT, 2) k_ph1(Params p) { p_hconv(p); }
__global__ void __launch_bounds__(NT, 2) k_ph2(Params p) { extern __shared__ __attribute__((aligned(16))) unsigned char lds[]; p_inproj(p, lds); }
__global__ void __launch_bounds__(NT, 2) k_ph3(Params p) { extern __shared__ __attribute__((aligned(16))) unsigned char lds[]; p_mixers(p, lds); }
__global__ void __launch_bounds__(NT, 2) k_ph4(Params p) { extern __shared__ __attribute__((aligned(16))) unsigned char lds[]; XcdBarrier bar{}; p_outproj(p, lds, bar, false); }
__global__ void __launch_bounds__(NT, 2) k_ph5(Params p) { p_ln(p); }
#endif

extern "C" void kernel_launch(void* const* d_in, const int* in_sizes, int n_in, void* d_out, int out_size, void* d_ws, size_t ws_size, hipStream_t stream) {
    static int grid_blocks = 0;
    if (!grid_blocks) {
        int dev = 0, cus = 0, per_cu = 0;
        (void)hipGetDevice(&dev);
        (void)hipDeviceGetAttribute(&cus, hipDeviceAttributeMultiprocessorCount, dev);
        if (hipFuncSetAttribute((const void*)mega, hipFuncAttributeMaxDynamicSharedMemorySize, LDS_BYTES) != hipSuccess) fprintf(stderr, "hipFuncSetAttribute failed\n");
        if (hipOccupancyMaxActiveBlocksPerMultiprocessor(&per_cu, (const void*)mega, NT, LDS_BYTES) != hipSuccess || per_cu < 1) { fprintf(stderr, "occupancy query: %d\n", per_cu); per_cu = 1; }
        (void)hipGetLastError();
        if (per_cu > 1) per_cu = 1;
        grid_blocks = cus * per_cu;
    }
    Params p{};
    p.x = (const float*)d_in[0]; p.c = (const float*)d_in[1]; p.w_ada = (const float*)d_in[2]; p.b_ada = (const float*)d_in[3]; p.w_in = (const float*)d_in[4];
    p.sgu_g = (const float*)d_in[5]; p.sgu_b = (const float*)d_in[6]; p.w_sp = (const float*)d_in[7]; p.b_sp = (const float*)d_in[8]; p.w_out = (const float*)d_in[9];
    p.ln_g = (const float*)d_in[10]; p.ln_b = (const float*)d_in[11]; p.out = (float*)d_out; p.ws = (unsigned char*)d_ws; p.phase = 0; p.pad = 0;
#if MODE == 0
    (void)hipMemsetAsync((char*)d_ws + OFF_BAR, 0, XCD_BAR_WORDS * 4, stream);
    void* args[] = {&p};
    hipError_t e = hipLaunchCooperativeKernel((const void*)mega, dim3(grid_blocks), dim3(NT), args, LDS_BYTES, stream);
    if (e != hipSuccess) fprintf(stderr, "cooperative launch failed: %s (grid %d)\n", hipGetErrorString(e), grid_blocks);
#else
    hipFuncSetAttribute((const void*)k_ph2, hipFuncAttributeMaxDynamicSharedMemorySize, LDS_BYTES);
    hipFuncSetAttribute((const void*)k_ph3, hipFuncAttributeMaxDynamicSharedMemorySize, LDS_BYTES);
    hipFuncSetAttribute((const void*)k_ph4, hipFuncAttributeMaxDynamicSharedMemorySize, LDS_BYTES);
    hipLaunchKernelGGL(mega, dim3(grid_blocks), dim3(NT), LDS_BYTES, stream, p);
    hipLaunchKernelGGL(k_ph1, dim3(grid_blocks), dim3(NT), 0, stream, p);
    hipLaunchKernelGGL(k_ph2, dim3(grid_blocks), dim3(NT), LDS_BYTES, stream, p);
    hipLaunchKernelGGL(k_ph3, dim3(grid_blocks), dim3(NT), LDS_BYTES, stream, p);
    hipLaunchKernelGGL(k_ph4, dim3(grid_blocks), dim3(NT), LDS_BYTES, stream, p);
    hipLaunchKernelGGL(k_ph5, dim3(grid_blocks), dim3(NT), 0, stream, p);
#endif
}
```

```cpp
#include <hip/hip_runtime.h>
#include <hip/hip_cooperative_groups.h>
#include <cstdint>
#include <cstdio>
namespace cg = cooperative_groups;

#ifndef MODE
#define MODE 0
#endif

typedef unsigned short bf16_t;
typedef short bf16x8 __attribute__((ext_vector_type(8)));
typedef _Float16 f16x8 __attribute__((ext_vector_type(8)));
typedef float f32x4 __attribute__((ext_vector_type(4)));
typedef float f32x16 __attribute__((ext_vector_type(16)));
typedef unsigned u32x2 __attribute__((ext_vector_type(2)));
typedef unsigned u32x4 __attribute__((ext_vector_type(4)));

constexpr int D_MODEL = 1024, BATCH = 8, SEQ = 2048, NTOK = BATCH * SEQ;
constexpr int NPROJ = 3584, CHUNK = 128, NGRP = 8, NHEAD = 8;
constexpr int C_U = 0, C_V = 512, C_ZA = 1024, C_Q = 1536, C_K = 2048, C_VB = 2560, C_ZB = 3072;
constexpr float LN_EPS = 1e-5f;
constexpr float ALPHA = 1.189207115002721f;
constexpr float LOG2E = 1.4426950408889634f;
constexpr float QSCALE = 0.125f * LOG2E;
constexpr int NT = 512;
constexpr int LDS_BYTES = 131072 + 16;

__device__ __forceinline__ bf16_t f2bf(float f) { unsigned u = __float_as_uint(f); u += 0x7fffu + ((u >> 16) & 1u); return (bf16_t)(u >> 16); }
__device__ __forceinline__ float bf2f(bf16_t b) { return __uint_as_float(((unsigned)b) << 16); }
__device__ __forceinline__ float bflo(unsigned w) { return __uint_as_float(w << 16); }
__device__ __forceinline__ float bfhi(unsigned w) { return __uint_as_float(w & 0xffff0000u); }
typedef float f32x2_ __attribute__((ext_vector_type(2)));
typedef __bf16 bf16x2_ __attribute__((ext_vector_type(2)));
typedef _Float16 f16x2_ __attribute__((ext_vector_type(2)));
__device__ __forceinline__ unsigned cvt_pk_bf16(float lo, float hi) { f32x2_ v = {lo, hi}; return __builtin_bit_cast(unsigned, __builtin_convertvector(v, bf16x2_)); }
__device__ __forceinline__ unsigned cvt_pk_f16(float lo, float hi) { f32x2_ v = {lo, hi}; return __builtin_bit_cast(unsigned, __builtin_convertvector(v, f16x2_)); }
__device__ __forceinline__ float sigmoidf_(float v) { return __builtin_amdgcn_rcpf(1.0f + __builtin_amdgcn_exp2f(-v * LOG2E)); }
__device__ __forceinline__ float siluf_(float v) { return v * sigmoidf_(v); }
__device__ __forceinline__ float geluf_(float v) { return v * sigmoidf_(1.5957691216057308f * (v + 0.044715f * v * v * v)); }

constexpr size_t OFF_MOD = 0;
constexpr size_t OFF_HB = 1 << 20;
constexpr size_t OFF_WIN = OFF_HB + (size_t)NTOK * D_MODEL * 2;
constexpr size_t OFF_WOUT = OFF_WIN + (size_t)NPROJ * D_MODEL * 2;
constexpr size_t OFF_WSP = OFF_WOUT + (size_t)D_MODEL * D_MODEL * 2;
constexpr size_t OFF_PROJ = OFF_WSP + (size_t)NGRP * CHUNK * CHUNK * 2;
constexpr size_t OFF_Y = OFF_PROJ + (size_t)NTOK * NPROJ * 2;

struct Params {
    const float* x; const float* c; const float* w_ada; const float* b_ada; const float* w_in; const float* sgu_g; const float* sgu_b;
    const float* w_sp; const float* b_sp; const float* w_out; const float* ln_g; const float* ln_b;
    float* out; unsigned char* ws; int phase; int pad;
};


#define XB_TMO      128
#define XB_XCNT(j)  (256  + 64 * (j))
#define XB_XSUB(j)  (1280 + 64 * (j))
#define XB_XGEN(j)  (2304 + 64 * (j))
#define XB_TOP      3328
#define XB_TOPGEN   3392
#define XCD_BAR_WORDS 3456
#define XB_SPIN_CAP (1u << 18)
#define LAS __attribute__((address_space(3)))
__device__ __forceinline__ unsigned xb_ld(unsigned* p)              { return __hip_atomic_load(p, __ATOMIC_RELAXED, __HIP_MEMORY_SCOPE_AGENT); }
__device__ __forceinline__ unsigned xb_add(unsigned* p, unsigned v) { return __hip_atomic_fetch_add(p, v, __ATOMIC_RELAXED, __HIP_MEMORY_SCOPE_AGENT); }
__device__ __forceinline__ unsigned xb_xcc_id() { return (unsigned)__builtin_amdgcn_s_getreg((3 << 11) | 20) & 0xFu; }
#define XB_SPIN(cond, bar) do { unsigned _sp = 0; while (cond) { __builtin_amdgcn_s_sleep(1); \
    if ((++_sp & 255u) == 0u) { if (xb_ld(&(bar)[XB_TMO])) break; if (_sp > XB_SPIN_CAP) { atomicAdd(&(bar)[XB_TMO], 1u); break; } } } } while (0)
struct XcdBarrier { unsigned* bar; unsigned x; volatile LAS unsigned* st; };
__device__ __forceinline__ XcdBarrier xcd_barrier_post(unsigned* bar, volatile LAS unsigned* st) {
    XcdBarrier b; b.bar = bar; b.x = xb_xcc_id(); b.st = st;
    if (threadIdx.x == 0) (void)xb_add(&bar[XB_XCNT(b.x)], 1u);
    return b;
}
__device__ __forceinline__ void xcd_barrier_complete(unsigned* bar, unsigned x, unsigned& nloc, unsigned& nx) {
    const unsigned G = gridDim.x * gridDim.y * gridDim.z;
    unsigned sum, cnt, mine, sp = 0u;
    for (;;) {
        sum = 0u; cnt = 0u; mine = 0u;
#pragma unroll
        for (unsigned j = 0; j < 16; ++j) { const unsigned c = xb_ld(&bar[XB_XCNT(j)]); sum += c; cnt += (c > 0u) ? 1u : 0u; mine = (j == x) ? c : mine; }
        if (sum == G) break;
        __builtin_amdgcn_s_sleep(1);
        if ((++sp & 255u) == 0u) { if (xb_ld(&bar[XB_TMO])) break; if (sp > XB_SPIN_CAP) { atomicAdd(&bar[XB_TMO], 1u); break; } }
    }
    nloc = mine > 0u ? mine : 1u; nx = cnt > 0u ? cnt : 1u;
}
__device__ __forceinline__ void xcd_barrier(const XcdBarrier& b) {
    asm volatile("s_waitcnt vmcnt(0)" ::: "memory");
    __syncthreads();
    if (threadIdx.x == 0) {
        unsigned* bar = b.bar;
        __builtin_amdgcn_s_waitcnt(0);
        unsigned nloc = b.st[0], nx = b.st[1];
        if (nloc == 0u) { xcd_barrier_complete(bar, b.x, nloc, nx); b.st[0] = nloc; b.st[1] = nx; }
        const unsigned old = xb_add(&bar[XB_XSUB(b.x)], 1u);
        const unsigned gen = old / nloc;
        if (old + 1u == (gen + 1u) * nloc) {
            __builtin_amdgcn_fence(__ATOMIC_RELEASE, "agent");
            asm volatile("s_waitcnt vmcnt(0)" ::: "memory");
            const unsigned og = xb_add(&bar[XB_TOP], 1u);
            const unsigned tg = og / nx;
            if (og + 1u == (tg + 1u) * nx) xb_add(&bar[XB_TOPGEN], 1u);
            else XB_SPIN(xb_ld(&bar[XB_TOPGEN]) == tg, bar);
            __builtin_amdgcn_fence(__ATOMIC_ACQUIRE, "agent");
            xb_add(&bar[XB_XGEN(b.x)], 1u);
            asm volatile("s_waitcnt vmcnt(0)" ::: "memory");
        } else {
            XB_SPIN(xb_ld(&bar[XB_XGEN(b.x)]) == gen, bar);
            __builtin_amdgcn_fence(__ATOMIC_ACQUIRE, "agent");
            asm volatile("s_waitcnt vmcnt(0)" ::: "memory");
        }
    }
    __syncthreads();
}
constexpr size_t OFF_BAR = 128 * 1024;

__device__ void p0_prologue(const Params& p, unsigned char* lds) {
    int tid = threadIdx.x; asm volatile("" : "+v"(tid)); const int lane = tid & 63, wave = tid >> 6;
    float* mod = (float*)(p.ws + OFF_MOD);
    float* sc = (float*)lds;
    float* red = (float*)(lds + 32768);
    for (int it = blockIdx.x; it < 96; it += gridDim.x) {
        for (int i = tid; i < 8 * 1024; i += NT) sc[i] = siluf_(p.c[i]);
        __syncthreads();
        const int q = tid & 7, r = tid >> 3; const int c0 = it * 32 + q * 4;
        float acc[8][4];
#pragma unroll
        for (int b = 0; b < 8; ++b) { acc[b][0] = 0.f; acc[b][1] = 0.f; acc[b][2] = 0.f; acc[b][3] = 0.f; }
#pragma unroll 4
        for (int i = 0; i < 16; ++i) { const int k = r + 64 * i; const f32x4 w = *(const f32x4*)(p.w_ada + (size_t)k * 3072 + c0);
#pragma unroll
            for (int b = 0; b < 8; ++b) { const float s = sc[b * 1024 + k]; acc[b][0] += s * w[0]; acc[b][1] += s * w[1]; acc[b][2] += s * w[2]; acc[b][3] += s * w[3]; } }
#pragma unroll
        for (int b = 0; b < 8; ++b)
#pragma unroll
            for (int j = 0; j < 4; ++j) { float v = acc[b][j]; v += __shfl_xor(v, 8); v += __shfl_xor(v, 16); v += __shfl_xor(v, 32); acc[b][j] = v; }
        if (lane < 8) {
#pragma unroll
            for (int b = 0; b < 8; ++b)
#pragma unroll
                for (int j = 0; j < 4; ++j) red[(wave * 8 + q) * 32 + b * 4 + j] = acc[b][j];
        }
        __syncthreads();
        if (tid < 256) { const int b = tid >> 5, col = tid & 31, qq = col >> 2, j = col & 3; float s = 0.f;
#pragma unroll
            for (int w = 0; w < 8; ++w) s += red[(w * 8 + qq) * 32 + b * 4 + j];
            mod[b * 3072 + it * 32 + col] = s + p.b_ada[it * 32 + col]; }
        __syncthreads();
    }
    float* tb = (float*)(lds + 49152);
    for (int tile = blockIdx.x; tile < 896 + 256; tile += gridDim.x) {
        const float* W; bf16_t* Wt; int N, tk, tn;
        if (tile < 896) { W = p.w_in; Wt = (bf16_t*)(p.ws + OFF_WIN); N = NPROJ; tk = tile / 56; tn = tile % 56; }
        else { const int t2 = tile - 896; W = p.w_out; Wt = (bf16_t*)(p.ws + OFF_WOUT); N = D_MODEL; tk = t2 / 16; tn = t2 % 16; }
        const int k0 = tk * 64, n0 = tn * 64;
        { const int n4 = tid & 15, kk = tid >> 4;
#pragma unroll
          for (int i = 0; i < 2; ++i) { const int k = kk + 32 * i; const f32x4 v = *(const f32x4*)(W + (size_t)(k0 + k) * N + n0 + n4 * 4);
              tb[k * 65 + n4 * 4 + 0] = v[0]; tb[k * 65 + n4 * 4 + 1] = v[1]; tb[k * 65 + n4 * 4 + 2] = v[2]; tb[k * 65 + n4 * 4 + 3] = v[3]; } }
        __syncthreads();
        { const int n = tid >> 3, ks = tid & 7; u32x4 o;
          o[0] = cvt_pk_bf16(tb[(ks * 8 + 0) * 65 + n], tb[(ks * 8 + 1) * 65 + n]); o[1] = cvt_pk_bf16(tb[(ks * 8 + 2) * 65 + n], tb[(ks * 8 + 3) * 65 + n]);
          o[2] = cvt_pk_bf16(tb[(ks * 8 + 4) * 65 + n], tb[(ks * 8 + 5) * 65 + n]); o[3] = cvt_pk_bf16(tb[(ks * 8 + 6) * 65 + n], tb[(ks * 8 + 7) * 65 + n]);
          *(u32x4*)(Wt + (size_t)(n0 + n) * D_MODEL + k0 + ks * 8) = o; }
        __syncthreads();
    }
    bf16_t* wsp = (bf16_t*)(p.ws + OFF_WSP);
    for (int i = blockIdx.x * NT + tid; i < NGRP * CHUNK * CHUNK / 8; i += gridDim.x * NT) {
        const int e = i * 8, t = (e >> 7) & 127, s0 = e & 127;
        const f32x4 a = *(const f32x4*)(p.w_sp + e), b = *(const f32x4*)(p.w_sp + e + 4);
        float v[8] = {a[0], a[1], a[2], a[3], b[0], b[1], b[2], b[3]};
#pragma unroll
        for (int j = 0; j < 8; ++j) v[j] = (s0 + j <= t) ? v[j] : 0.f;
        u32x4 o; o[0] = cvt_pk_bf16(v[0], v[1]); o[1] = cvt_pk_bf16(v[2], v[3]); o[2] = cvt_pk_bf16(v[4], v[5]); o[3] = cvt_pk_bf16(v[6], v[7]);
        *(u32x4*)(wsp + e) = o;
    }
}

__device__ void p_hconv(const Params& p) {
    const float* mod = (const float*)(p.ws + OFF_MOD); bf16_t* hb = (bf16_t*)(p.ws + OFF_HB);
    int tid = threadIdx.x; asm volatile("" : "+v"(tid));
    const size_t stride = (size_t)gridDim.x * NT, total = (size_t)NTOK * D_MODEL / 8;
    for (size_t i0 = (size_t)blockIdx.x * NT + tid; i0 < total; i0 += 4 * stride) {
        f32x4 x0[4], x1[4];
#pragma unroll
        for (int u = 0; u < 4; ++u) { const size_t i = i0 + u * stride; if (i < total) { x0[u] = __builtin_nontemporal_load((const f32x4*)(p.x + i * 8)); x1[u] = __builtin_nontemporal_load((const f32x4*)(p.x + i * 8 + 4)); } }
#pragma unroll
        for (int u = 0; u < 4; ++u) { const size_t i = i0 + u * stride; if (i < total) {
            const size_t e = i * 8; const int col = (int)(e & 1023); const int b = (int)(e >> 21);
            const f32x4 sh0 = *(const f32x4*)(mod + b * 3072 + col), sh1 = *(const f32x4*)(mod + b * 3072 + col + 4);
            const f32x4 sc0 = *(const f32x4*)(mod + b * 3072 + 1024 + col), sc1 = *(const f32x4*)(mod + b * 3072 + 1024 + col + 4);
            const f32x4 h0 = x0[u] * (1.0f + sc0) + sh0, h1 = x1[u] * (1.0f + sc1) + sh1;
            u32x4 o; o[0] = cvt_pk_bf16(h0[0], h0[1]); o[1] = cvt_pk_bf16(h0[2], h0[3]); o[2] = cvt_pk_bf16(h1[0], h1[1]); o[3] = cvt_pk_bf16(h1[2], h1[3]);
            *(u32x4*)(hb + e) = o; } }
    }
}

constexpr int BM = 256, BK = 64, HALF = 128, NXCD = 8, WGM = 8, HT = HALF * BK;
__device__ __forceinline__ int lds_byte(int r, int c) { int st = (r >> 4) * 2 + (c >> 5), rr = r & 15, cc = c & 31, ob = rr * 64 + cc * 2; return st * 1024 + (ob ^ (((ob >> 9) & 1) << 5)); }
__device__ __forceinline__ void stage_rc(int b, int& R, int& C) { int st = b / 1024, sb = b % 1024, swz = sb ^ (((sb >> 9) & 1) << 5); R = (st >> 1) * 16 + swz / 64; C = (st & 1) * 32 + (swz % 64) / 2; }

struct TileOrder {
    int nM, nN, nwg, G, c;
    __device__ void init(int M, int N, int G_, int c_) { nM = M / BM; nN = N / BM; nwg = nM * nN; G = G_; c = c_; }
    __device__ bool next(int i, int& pm, int& pn) const {
        const long L = (long)i * G + c; if (L >= nwg) return false;
        int wgid = (int)L; { const int q = nwg / NXCD, r = nwg % NXCD, xcd = wgid % NXCD, off = wgid / NXCD; wgid = (xcd < r ? xcd * (q + 1) : r * (q + 1) + (xcd - r) * q) + off; }
        const int nig = WGM * nN, gid = wgid / nig, fm = gid * WGM, gsz = (nM - fm) < WGM ? (nM - fm) : WGM;
        pm = fm + ((wgid % nig) % gsz); pn = (wgid % nig) / gsz; return true;
    }
};

__device__ __forceinline__ void gemm_tile(const bf16_t* __restrict__ A, const bf16_t* __restrict__ Bt, const int K, const int brow, const int bcol, bf16_t* shm, f32x4 (&acc)[2][2][4][2]) {
#define SA(b, h) (shm + ((b) * 2 + (h)) * HT)
#define SB(b, h) (shm + (4 + (b) * 2 + (h)) * HT)
#define STAGE(P, BASE, br, kt) do { const char* _gb = (const char*)(BASE) + ((size_t)(br) * K + (size_t)(kt) * BK) * 2; \
    for (int _i = 0; _i < 2; ++_i) { int _b = gtx * 16 + _i * 8192; \
      __builtin_amdgcn_global_load_lds((const unsigned*)(_gb + soff[_i]), (__attribute__((address_space(3))) unsigned*)((char*)(P) + _b), 16, 0, 0); } } while (0)
#define LDA(dst, b, h) for (int m = 0; m < 4; ++m) for (int k = 0; k < 2; ++k) \
    dst[m][k] = *reinterpret_cast<const bf16x8*>((char*)SA(b, h) + lds_byte(wr * 64 + m * 16 + fr, k * 32 + fq * 8))
#define LDB(dst, b, h) for (int n = 0; n < 2; ++n) for (int k = 0; k < 2; ++k) \
    dst[n][k] = *reinterpret_cast<const bf16x8*>((char*)SB(b, h) + lds_byte(wc * 32 + n * 16 + fr, k * 32 + fq * 8))
#define MMA(ai, bj, At_, Bt_) do { __builtin_amdgcn_s_setprio(1); \
    for (int m = 0; m < 4; ++m) for (int n = 0; n < 2; ++n) for (int k = 0; k < 2; ++k) \
      acc[ai][bj][m][n] = __builtin_amdgcn_mfma_f32_16x16x32_bf16(Bt_[n][k], At_[m][k], acc[ai][bj][m][n], 0, 0, 0); \
    __builtin_amdgcn_s_setprio(0); } while (0)
#define WAIT_V(n) asm volatile("s_waitcnt vmcnt(" #n ")" ::: "memory")
#define WAIT_L(n) asm volatile("s_waitcnt lgkmcnt(" #n ")" ::: "memory")
#define BAR __builtin_amdgcn_s_barrier()
#define SCHED __builtin_amdgcn_sched_barrier(0)
    int gtx = threadIdx.x; asm volatile("" : "+v"(gtx));
    const int wid = gtx >> 6, lane = gtx & 63, wr = __builtin_amdgcn_readfirstlane(wid >> 2), wc = wid & 3, fr = lane & 15, fq = lane >> 4;
#pragma unroll
    for (int a = 0; a < 2; ++a)
#pragma unroll
        for (int b = 0; b < 2; ++b)
#pragma unroll
            for (int m = 0; m < 4; ++m)
#pragma unroll
                for (int n = 0; n < 2; ++n) acc[a][b][m][n] = (f32x4){0.f, 0.f, 0.f, 0.f};
    bf16x8 At[4][2], B0[2][2], B1[2][2];
    unsigned soff[2];
    for (int _i = 0; _i < 2; ++_i) { int _r, _c; stage_rc(gtx * 16 + _i * 8192, _r, _c); soff[_i] = (unsigned)(_r * K + _c) * 2u; }
    const int nt = K / BK;
    STAGE(SB(0, 0), Bt, bcol, 0); STAGE(SA(0, 0), A, brow, 0);
    STAGE(SB(0, 1), Bt, bcol + HALF, 0); STAGE(SA(0, 1), A, brow + HALF, 0);
    if (wr == 1) BAR;
    WAIT_V(4); BAR;
    STAGE(SB(1, 0), Bt, bcol, 1); STAGE(SA(1, 0), A, brow, 1); STAGE(SB(1, 1), Bt, bcol + HALF, 1);
    WAIT_V(6); BAR;
    for (int t = 0; t < nt - 2; t += 2) {
        LDB(B0, 0, 0); SCHED; LDA(At, 0, 0); STAGE(SA(1, 1), A, brow + HALF, t + 1);
        WAIT_L(8); BAR; WAIT_L(0); MMA(0, 0, At, B0); BAR; SCHED;
        LDB(B1, 0, 1); STAGE(SB(0, 0), Bt, bcol, t + 2);
        BAR; WAIT_L(0); MMA(0, 1, At, B1); BAR;
        LDA(At, 0, 1); STAGE(SA(0, 0), A, brow, t + 2);
        BAR; WAIT_L(0); MMA(1, 0, At, B0); BAR; SCHED;
        STAGE(SB(0, 1), Bt, bcol + HALF, t + 2);
        WAIT_V(6); BAR; MMA(1, 1, At, B1); BAR;
        LDB(B0, 1, 0); SCHED; LDA(At, 1, 0); STAGE(SA(0, 1), A, brow + HALF, t + 2);
        WAIT_L(8); BAR; WAIT_L(0); MMA(0, 0, At, B0); BAR; SCHED;
        LDB(B1, 1, 1); STAGE(SB(1, 0), Bt, bcol, t + 3);
        BAR; WAIT_L(0); MMA(0, 1, At, B1); BAR;
        LDA(At, 1, 1); STAGE(SA(1, 0), A, brow, t + 3);
        BAR; WAIT_L(0); MMA(1, 0, At, B0); BAR; SCHED;
        STAGE(SB(1, 1), Bt, bcol + HALF, t + 3);
        WAIT_V(6); BAR; MMA(1, 1, At, B1); BAR;
    }
    { LDB(B0, 0, 0); LDA(At, 0, 0); STAGE(SA(1, 1), A, brow + HALF, nt - 1);
      BAR; WAIT_L(0); MMA(0, 0, At, B0); BAR;
      LDB(B1, 0, 1); BAR; WAIT_L(0); MMA(0, 1, At, B1); BAR;
      LDA(At, 0, 1); WAIT_V(4); BAR; WAIT_L(0); MMA(1, 0, At, B0); MMA(1, 1, At, B1); BAR; }
    { LDB(B0, 1, 0); LDA(At, 1, 0); WAIT_V(2); BAR; WAIT_L(0); MMA(0, 0, At, B0); BAR;
      LDB(B1, 1, 1); WAIT_V(0); BAR; WAIT_L(0); MMA(0, 1, At, B1); BAR;
      LDA(At, 1, 1); BAR; WAIT_L(0); MMA(1, 0, At, B0); MMA(1, 1, At, B1); BAR; }
    if (wr == 0) BAR;
#undef SA
#undef SB
#undef STAGE
#undef LDA
#undef LDB
#undef MMA
}

__device__ void p_inproj(const Params& p, unsigned char* lds) {
    const bf16_t* hb = (const bf16_t*)(p.ws + OFF_HB); const bf16_t* winT = (const bf16_t*)(p.ws + OFF_WIN); bf16_t* proj = (bf16_t*)(p.ws + OFF_PROJ);
    TileOrder ord; ord.init(NTOK, NPROJ, gridDim.x, blockIdx.x);
    for (int i = 0;; ++i) {
        int pm, pn; if (!ord.next(i, pm, pn)) break;
        f32x4 acc[2][2][4][2];
        gemm_tile(hb, winT, D_MODEL, pm * BM, pn * BM, (bf16_t*)lds, acc);
        int tx = threadIdx.x; asm volatile("" : "+v"(tx));
        const int wid = tx >> 6, lane = tx & 63, wr = wid >> 2, wc = wid & 3, fr = lane & 15, fq = lane >> 4;
        const int seg = pn >> 1;
#pragma unroll
        for (int ai = 0; ai < 2; ++ai)
#pragma unroll
            for (int m = 0; m < 4; ++m) {
                const int row = pm * BM + ai * HALF + wr * 64 + m * 16 + fr;
                bf16_t* rowp = proj + (size_t)row * NPROJ + pn * BM + wc * 32 + fq * 4;
#pragma unroll
                for (int bj = 0; bj < 2; ++bj)
#pragma unroll
                    for (int n = 0; n < 2; ++n) {
                        f32x4 v = acc[ai][bj][m][n];
                        if (seg <= 1) { v[0] = geluf_(v[0]); v[1] = geluf_(v[1]); v[2] = geluf_(v[2]); v[3] = geluf_(v[3]); }
                        else if (seg == 2 || seg == 6) { v[0] = siluf_(v[0]); v[1] = siluf_(v[1]); v[2] = siluf_(v[2]); v[3] = siluf_(v[3]); }
                        else if (seg == 3) { v = v * QSCALE; }
                        u32x2 o; o[0] = cvt_pk_bf16(v[0], v[1]); o[1] = cvt_pk_bf16(v[2], v[3]);
                        *(u32x2*)(rowp + bj * HALF + n * 16) = o;
                    }
            }
        asm volatile("s_waitcnt vmcnt(0)" ::: "memory");
    }
}

constexpr size_t OFF_STATS = 256 * 1024;
__device__ void p_outproj(const Params& p, unsigned char* lds, const XcdBarrier& bar, const bool fused) {
    const bf16_t* yb = (const bf16_t*)(p.ws + OFF_Y); const bf16_t* woutT = (const bf16_t*)(p.ws + OFF_WOUT); const float* mod = (const float*)(p.ws + OFF_MOD);
    TileOrder ord; ord.init(NTOK, D_MODEL, gridDim.x, blockIdx.x);
    for (int i = 0;; ++i) {
        int pm, pn; if (!ord.next(i, pm, pn)) break;
        f32x4 acc[2][2][4][2];
        gemm_tile(yb, woutT, D_MODEL, pm * BM, pn * BM, (bf16_t*)lds, acc);
        int tx = threadIdx.x; asm volatile("" : "+v"(tx));
        const int wid = tx >> 6, lane = tx & 63, wr = wid >> 2, wc = wid & 3, fr = lane & 15, fq = lane >> 4;
        const int b = (pm * BM) / SEQ; const int col0 = pn * BM + wc * 32 + fq * 4;
        {   f32x4 gate[2][2];
#pragma unroll
            for (int bj = 0; bj < 2; ++bj)
#pragma unroll
                for (int n = 0; n < 2; ++n) gate[bj][n] = *(const f32x4*)(mod + b * 3072 + 2048 + col0 + bj * HALF + n * 16);
#pragma unroll
            for (int ai = 0; ai < 2; ++ai) {
                f32x4 xv[4][2][2];
#pragma unroll
                for (int m = 0; m < 4; ++m) { const size_t off = (size_t)(pm * BM + ai * HALF + wr * 64 + m * 16 + fr) * D_MODEL + col0;
#pragma unroll
                    for (int bj = 0; bj < 2; ++bj)
#pragma unroll
                        for (int n = 0; n < 2; ++n) xv[m][bj][n] = __builtin_nontemporal_load((const f32x4*)(p.x + off + bj * HALF + n * 16)); }
#pragma unroll
                for (int m = 0; m < 4; ++m)
#pragma unroll
                    for (int bj = 0; bj < 2; ++bj)
#pragma unroll
                        for (int n = 0; n < 2; ++n) acc[ai][bj][m][n] = xv[m][bj][n] * ALPHA + gate[bj][n] * acc[ai][bj][m][n];
            } }
        if (!fused) {
#pragma unroll
            for (int ai = 0; ai < 2; ++ai)
#pragma unroll
                for (int m = 0; m < 4; ++m) { const size_t off = (size_t)(pm * BM + ai * HALF + wr * 64 + m * 16 + fr) * D_MODEL + col0;
#pragma unroll
                    for (int bj = 0; bj < 2; ++bj)
#pragma unroll
                        for (int n = 0; n < 2; ++n) *(f32x4*)(p.out + off + bj * HALF + n * 16) = acc[ai][bj][m][n]; }
            asm volatile("s_waitcnt vmcnt(0)" ::: "memory");
            continue;
        }
        float* P = (float*)lds;
        float* S = (float*)(lds + 8192);
        float* gstats = (float*)(p.ws + OFF_STATS);
#pragma unroll
        for (int ai = 0; ai < 2; ++ai)
#pragma unroll
            for (int m = 0; m < 4; ++m) { float s1 = 0.f, s2 = 0.f;
#pragma unroll
                for (int bj = 0; bj < 2; ++bj)
#pragma unroll
                    for (int n = 0; n < 2; ++n) { const f32x4 v = acc[ai][bj][m][n]; s1 += (v[0] + v[1]) + (v[2] + v[3]); s2 += (v[0] * v[0] + v[1] * v[1]) + (v[2] * v[2] + v[3] * v[3]); }
                s1 += __shfl_xor(s1, 16); s2 += __shfl_xor(s2, 16); s1 += __shfl_xor(s1, 32); s2 += __shfl_xor(s2, 32);
                if (fq == 0) { const int rl = ai * HALF + wr * 64 + m * 16 + fr; P[(rl * 4 + wc) * 2] = s1; P[(rl * 4 + wc) * 2 + 1] = s2; } }
        __syncthreads();
        if (tx < 256) { const f32x4 a = *(const f32x4*)(P + tx * 8), c2 = *(const f32x4*)(P + tx * 8 + 4);
            float* gp = gstats + ((size_t)(pm * BM + tx) * 4 + pn) * 2; gp[0] = (a[0] + a[2]) + (c2[0] + c2[2]); gp[1] = (a[1] + a[3]) + (c2[1] + c2[3]); }
        xcd_barrier(bar);
        if (tx < 256) { const float* gp = gstats + (size_t)(pm * BM + tx) * 8; const f32x4 a = *(const f32x4*)gp, c2 = *(const f32x4*)(gp + 4);
            const float mean = ((a[0] + a[2]) + (c2[0] + c2[2])) * (1.0f / 1024.f); const float ex2 = ((a[1] + a[3]) + (c2[1] + c2[3])) * (1.0f / 1024.f);
            const float var = fmaxf(ex2 - mean * mean, 0.f); S[tx * 2] = mean; S[tx * 2 + 1] = 1.0f / sqrtf(var + LN_EPS); }
        __syncthreads();
        {   f32x4 gg[2][2], bb[2][2];
#pragma unroll
            for (int bj = 0; bj < 2; ++bj)
#pragma unroll
                for (int n = 0; n < 2; ++n) { gg[bj][n] = *(const f32x4*)(p.ln_g + col0 + bj * HALF + n * 16); bb[bj][n] = *(const f32x4*)(p.ln_b + col0 + bj * HALF + n * 16); }
#pragma unroll
            for (int ai = 0; ai < 2; ++ai)
#pragma unroll
                for (int m = 0; m < 4; ++m) { const int rl = ai * HALF + wr * 64 + m * 16 + fr; const float mean = S[rl * 2], rstd = S[rl * 2 + 1];
                    const size_t off = (size_t)(pm * BM + rl) * D_MODEL + col0;
#pragma unroll
                    for (int bj = 0; bj < 2; ++bj)
#pragma unroll
                        for (int n = 0; n < 2; ++n) __builtin_nontemporal_store((acc[ai][bj][m][n] - mean) * rstd * gg[bj][n] + bb[bj][n], (f32x4*)(p.out + off + bj * HALF + n * 16)); } }
    }
}

constexpr int KROW = 72;
__device__ __forceinline__ float relu_(float x) { int i = __builtin_bit_cast(int, x); i = i > 0 ? i : 0; return __builtin_bit_cast(float, i); }
__device__ __forceinline__ void softplus_pack(const f32x16& z, f16x8 (&lf)[2]) {
    unsigned w[8];
#pragma unroll
    for (int i = 0; i < 8; ++i) {
        const float z0 = z[2 * i], z1 = z[2 * i + 1];
        const float l0 = __builtin_amdgcn_logf(1.0f + __builtin_amdgcn_exp2f(-__builtin_fabsf(z0))), l1 = __builtin_amdgcn_logf(1.0f + __builtin_amdgcn_exp2f(-__builtin_fabsf(z1)));
        w[i] = cvt_pk_f16(relu_(z0) + l0, relu_(z1) + l1);
    }
    u32x4 t0 = {w[0], w[1], w[2], w[3]}, t1 = {w[4], w[5], w[6], w[7]};
    lf[0] = __builtin_bit_cast(f16x8, t0); lf[1] = __builtin_bit_cast(f16x8, t1);
}
__device__ __forceinline__ void expo_pack(const f32x16& z, const f32x16& cum, bf16x8 (&pf)[2]) {
    unsigned w[8];
#pragma unroll
    for (int i = 0; i < 8; ++i) w[i] = cvt_pk_bf16(__builtin_amdgcn_exp2f(z[2 * i] + cum[2 * i]), __builtin_amdgcn_exp2f(z[2 * i + 1] + cum[2 * i + 1]));
    u32x4 t0 = {w[0], w[1], w[2], w[3]}, t1 = {w[4], w[5], w[6], w[7]};
    pf[0] = __builtin_bit_cast(bf16x8, t0); pf[1] = __builtin_bit_cast(bf16x8, t1);
}
__device__ __forceinline__ f32x16 bcast16(float v) { f32x16 r;
#pragma unroll
    for (int i = 0; i < 16; ++i) r[i] = v;
    return r; }

__device__ __forceinline__ void attn_unit(const Params& p, unsigned char* lds, const int b, const int h, const int qb) {
    const bf16_t* proj = (const bf16_t*)(p.ws + OFF_PROJ); bf16_t* yb = (bf16_t*)(p.ws + OFF_Y);
    int tid = threadIdx.x; asm volatile("" : "+v"(tid)); const int lane = tid & 63, wave = __builtin_amdgcn_readfirstlane(tid >> 6), c = lane & 31, hh = lane >> 5;
    bf16_t* Ks = (bf16_t*)lds;
    bf16_t* Vt = (bf16_t*)(lds + 2 * 64 * KROW * 2);
    const size_t tokbase = (size_t)b * SEQ; const int q0 = qb * 256, tq0 = q0 + wave * 32;
    bf16x8 qf[4];
    { const bf16_t* qp = proj + (tokbase + tq0 + c) * NPROJ + C_Q + h * 64 + hh * 8;
#pragma unroll
      for (int ks = 0; ks < 4; ++ks) qf[ks] = *(const bf16x8*)(qp + ks * 16);
#pragma unroll
      for (int ks = 0; ks < 4; ++ks) asm volatile("" : "+v"(qf[ks])); }
    f16x8 uf[2], nones;
#pragma unroll
    for (int ks2 = 0; ks2 < 2; ++ks2)
#pragma unroll
        for (int jj = 0; jj < 8; ++jj) { const int key = 16 * ks2 + 8 * (jj >> 2) + 4 * hh + (jj & 3); uf[ks2][jj] = (key >= c) ? (_Float16)-1.0f : (_Float16)0.0f; }
#pragma unroll
    for (int jj = 0; jj < 8; ++jj) nones[jj] = (_Float16)-1.0f;
    f32x16 o0 = bcast16(0.f), o1 = bcast16(0.f);
    float R = 0.f;
    const int ntile = (q0 + 256) / 64;
    const int skey = tid >> 3, sch = tid & 7; const int spk = (skey & ~12) | ((skey & 4) << 1) | ((skey & 8) >> 1);
    u32x4 kreg, vreg;
    { const bf16_t* kp = proj + (tokbase + (ntile - 1) * 64 + skey) * NPROJ + h * 64 + sch * 8; kreg = *(const u32x4*)(kp + C_K); vreg = *(const u32x4*)(kp + C_VB); }
    int buf = 0;
    { *(u32x4*)(Ks + (buf * 64 + skey) * KROW + sch * 8) = kreg;
      bf16_t* vp = Vt + (buf * 64 + sch * 8) * KROW + spk;
#pragma unroll
      for (int e = 0; e < 4; ++e) { vp[(2 * e) * KROW] = (bf16_t)(vreg[e] & 0xffffu); vp[(2 * e + 1) * KROW] = (bf16_t)(vreg[e] >> 16); } }
    __syncthreads();
    for (int kt = ntile - 1; kt >= 0; --kt) {
        if (kt > 0) { const bf16_t* kp = proj + (tokbase + (kt - 1) * 64 + skey) * NPROJ + h * 64 + sch * 8; kreg = *(const u32x4*)(kp + C_K); vreg = *(const u32x4*)(kp + C_VB); }
        const bf16_t* Kb = Ks + buf * 64 * KROW; const bf16_t* Vb = Vt + buf * 64 * KROW;
        if (kt * 64 + 64 <= tq0) {
            f32x16 z1 = bcast16(0.f), z0 = bcast16(0.f);
#pragma unroll
            for (int ks = 0; ks < 4; ++ks) { const bf16x8 kf = *(const bf16x8*)(Kb + (32 + c) * KROW + ks * 16 + hh * 8); z1 = __builtin_amdgcn_mfma_f32_32x32x16_bf16(kf, qf[ks], z1, 0, 0, 0); }
#pragma unroll
            for (int ks = 0; ks < 4; ++ks) { const bf16x8 kf = *(const bf16x8*)(Kb + (c) * KROW + ks * 16 + hh * 8); z0 = __builtin_amdgcn_mfma_f32_32x32x16_bf16(kf, qf[ks], z0, 0, 0, 0); }
            f16x8 lf1[2], lf0[2];
            softplus_pack(z1, lf1);
            f32x16 cum1 = bcast16(R), cum0 = bcast16(R);
            cum1 = __builtin_amdgcn_mfma_f32_32x32x16_f16(uf[0], lf1[0], cum1, 0, 0, 0);
            cum1 = __builtin_amdgcn_mfma_f32_32x32x16_f16(uf[1], lf1[1], cum1, 0, 0, 0);
            cum0 = __builtin_amdgcn_mfma_f32_32x32x16_f16(nones, lf1[0], cum0, 0, 0, 0);
            cum0 = __builtin_amdgcn_mfma_f32_32x32x16_f16(nones, lf1[1], cum0, 0, 0, 0);
            softplus_pack(z0, lf0);
            cum0 = __builtin_amdgcn_mfma_f32_32x32x16_f16(uf[0], lf0[0], cum0, 0, 0, 0);
            cum0 = __builtin_amdgcn_mfma_f32_32x32x16_f16(uf[1], lf0[1], cum0, 0, 0, 0);
            bf16x8 pf1[2], pf0[2];
            expo_pack(z1, cum1, pf1);
#pragma unroll
            for (int ks2 = 0; ks2 < 2; ++ks2) {
                const bf16x8 v0 = *(const bf16x8*)(Vb + (c) * KROW + 32 + ks2 * 16 + hh * 8), v1 = *(const bf16x8*)(Vb + (32 + c) * KROW + 32 + ks2 * 16 + hh * 8);
                o0 = __builtin_amdgcn_mfma_f32_32x32x16_bf16(v0, pf1[ks2], o0, 0, 0, 0); o1 = __builtin_amdgcn_mfma_f32_32x32x16_bf16(v1, pf1[ks2], o1, 0, 0, 0);
            }
            expo_pack(z0, cum0, pf0);
            R = __shfl(cum0[0], c);
#pragma unroll
            for (int ks2 = 0; ks2 < 2; ++ks2) {
                const bf16x8 v0 = *(const bf16x8*)(Vb + (c) * KROW + ks2 * 16 + hh * 8), v1 = *(const bf16x8*)(Vb + (32 + c) * KROW + ks2 * 16 + hh * 8);
                o0 = __builtin_amdgcn_mfma_f32_32x32x16_bf16(v0, pf0[ks2], o0, 0, 0, 0); o1 = __builtin_amdgcn_mfma_f32_32x32x16_bf16(v1, pf0[ks2], o1, 0, 0, 0);
            }
        } else {
#pragma unroll 1
            for (int sub = 1; sub >= 0; --sub) {
                const int ks0 = kt * 64 + sub * 32;
                if (ks0 <= tq0) {
                    f32x16 z = bcast16(0.f);
#pragma unroll
                    for (int ks = 0; ks < 4; ++ks) { const bf16x8 kf = *(const bf16x8*)(Kb + (sub * 32 + c) * KROW + ks * 16 + hh * 8); z = __builtin_amdgcn_mfma_f32_32x32x16_bf16(kf, qf[ks], z, 0, 0, 0); }
                    if (ks0 == tq0) {
#pragma unroll
                        for (int r = 0; r < 16; ++r) { const int s = (r & 3) + 8 * (r >> 2) + 4 * hh; z[r] = (s >= c) ? -__builtin_inff() : z[r]; }
                    }
                    f16x8 lf[2]; softplus_pack(z, lf);
                    f32x16 cum = bcast16(R);
                    cum = __builtin_amdgcn_mfma_f32_32x32x16_f16(uf[0], lf[0], cum, 0, 0, 0);
                    cum = __builtin_amdgcn_mfma_f32_32x32x16_f16(uf[1], lf[1], cum, 0, 0, 0);
                    bf16x8 pf[2]; expo_pack(z, cum, pf);
                    R = __shfl(cum[0], c);
#pragma unroll
                    for (int ks2 = 0; ks2 < 2; ++ks2) {
                        const bf16x8 v0 = *(const bf16x8*)(Vb + (c) * KROW + sub * 32 + ks2 * 16 + hh * 8), v1 = *(const bf16x8*)(Vb + (32 + c) * KROW + sub * 32 + ks2 * 16 + hh * 8);
                        o0 = __builtin_amdgcn_mfma_f32_32x32x16_bf16(v0, pf[ks2], o0, 0, 0, 0); o1 = __builtin_amdgcn_mfma_f32_32x32x16_bf16(v1, pf[ks2], o1, 0, 0, 0);
                    }
                }
            }
        }
        if (kt > 0) {
            const int nb = buf ^ 1;
            *(u32x4*)(Ks + (nb * 64 + skey) * KROW + sch * 8) = kreg;
            bf16_t* vp = Vt + (nb * 64 + sch * 8) * KROW + spk;
#pragma unroll
            for (int e = 0; e < 4; ++e) { vp[(2 * e) * KROW] = (bf16_t)(vreg[e] & 0xffffu); vp[(2 * e + 1) * KROW] = (bf16_t)(vreg[e] >> 16); }
        }
        __syncthreads();
        buf ^= 1;
    }
    { const size_t tok = tokbase + tq0 + c; const bf16_t* zp = proj + tok * NPROJ + C_ZB + h * 64; bf16_t* yp = yb + tok * D_MODEL + 512 + h * 64;
      u32x2 zz[8];
#pragma unroll
      for (int i = 0; i < 8; ++i) zz[i] = *(const u32x2*)(zp + (i >> 2) * 32 + 8 * (i & 3) + 4 * hh);
#pragma unroll
      for (int dt = 0; dt < 2; ++dt)
#pragma unroll
          for (int g = 0; g < 4; ++g) { const int d0 = dt * 32 + 8 * g + 4 * hh; const u32x2 z2 = zz[dt * 4 + g];
              const float v0 = dt ? o1[4 * g + 0] : o0[4 * g + 0], v1 = dt ? o1[4 * g + 1] : o0[4 * g + 1], v2 = dt ? o1[4 * g + 2] : o0[4 * g + 2], v3 = dt ? o1[4 * g + 3] : o0[4 * g + 3];
              u32x2 o; o[0] = cvt_pk_bf16(bflo(z2[0]) * v0, bfhi(z2[0]) * v1); o[1] = cvt_pk_bf16(bflo(z2[1]) * v2, bfhi(z2[1]) * v3);
              *(u32x2*)(yp + d0) = o; } }
}

constexpr int VROW = 136;
__device__ __forceinline__ void sgu_item(const Params& p, unsigned char* lds, const int ch, const int hf) {
    const bf16_t* proj = (const bf16_t*)(p.ws + OFF_PROJ); bf16_t* yb = (bf16_t*)(p.ws + OFF_Y); const bf16_t* wsp = (const bf16_t*)(p.ws + OFF_WSP);
    int tid = threadIdx.x; asm volatile("" : "+v"(tid)); const int lane = tid & 63, wave = __builtin_amdgcn_readfirstlane(tid >> 6), c = lane & 31, hh = lane >> 5;
    float* stats = (float*)(lds + 65536);
    bf16_t* vnT = (bf16_t*)(lds + 65536 + 1024);
    const size_t tok0 = (size_t)ch * CHUNK;
    { const int token = tid >> 2, qd = tid & 3; const bf16_t* vp = proj + (tok0 + token) * NPROJ + C_V + qd * 128; float s = 0.f, ss = 0.f;
#pragma unroll
      for (int i = 0; i < 16; ++i) { const u32x4 w = *(const u32x4*)(vp + i * 8);
#pragma unroll
          for (int e = 0; e < 4; ++e) { const float a = bflo(w[e]), bb = bfhi(w[e]); s += a + bb; ss += a * a + bb * bb; } }
      s += __shfl_xor(s, 1); ss += __shfl_xor(ss, 1); s += __shfl_xor(s, 2); ss += __shfl_xor(ss, 2);
      const float mean = s * (1.0f / 512.f); const float var = fmaxf(ss * (1.0f / 512.f) - mean * mean, 0.f);
      if (qd == 0) { stats[token * 2] = mean; stats[token * 2 + 1] = 1.0f / sqrtf(var + LN_EPS); } }
    __syncthreads();
    for (int gi = 0; gi < 4; ++gi) {
        const int g = hf * 4 + gi;
        { const int s = tid & 127, cc = tid >> 7; const float mean = stats[s * 2], rstd = stats[s * 2 + 1];
          const bf16_t* vp = proj + (tok0 + s) * NPROJ + C_V + g * 64 + cc * 16;
#pragma unroll
          for (int i = 0; i < 2; ++i) { const u32x4 w = *(const u32x4*)(vp + i * 8);
#pragma unroll
              for (int e = 0; e < 4; ++e) { const int chn = g * 64 + cc * 16 + i * 8 + 2 * e;
                  const float a = (bflo(w[e]) - mean) * rstd * p.sgu_g[chn] + p.sgu_b[chn], bb = (bfhi(w[e]) - mean) * rstd * p.sgu_g[chn + 1] + p.sgu_b[chn + 1];
                  vnT[(cc * 16 + i * 8 + 2 * e) * VROW + s] = f2bf(a); vnT[(cc * 16 + i * 8 + 2 * e + 1) * VROW + s] = f2bf(bb); } } }
        __syncthreads();
        { const int tt = wave >> 1, ct = wave & 1; f32x16 acc;
#pragma unroll
          for (int r = 0; r < 16; ++r) acc[r] = 0.f;
          const bf16_t* wrow = wsp + ((size_t)g * CHUNK + tt * 32 + c) * CHUNK + hh * 8; const bf16_t* vrow = vnT + (ct * 32 + c) * VROW + hh * 8;
          const int nks = 2 * (tt + 1);
          for (int ks = 0; ks < nks; ++ks) { const bf16x8 af = *(const bf16x8*)(vrow + ks * 16); const bf16x8 bfr = *(const bf16x8*)(wrow + ks * 16);
              acc = __builtin_amdgcn_mfma_f32_32x32x16_bf16(af, bfr, acc, 0, 0, 0); }
          const int t = tt * 32 + c; const size_t tok = tok0 + t; const float bs = p.b_sp[g * CHUNK + t];
          const bf16_t* up = proj + tok * NPROJ + C_U + g * 64 + ct * 32; const bf16_t* zp = proj + tok * NPROJ + C_ZA + g * 64 + ct * 32; bf16_t* yp = yb + tok * D_MODEL + g * 64 + ct * 32;
          u32x2 ua[4], za[4];
#pragma unroll
          for (int g4 = 0; g4 < 4; ++g4) { ua[g4] = *(const u32x2*)(up + 8 * g4 + 4 * hh); za[g4] = *(const u32x2*)(zp + 8 * g4 + 4 * hh); }
#pragma unroll
          for (int g4 = 0; g4 < 4; ++g4) { const int c0 = 8 * g4 + 4 * hh; const u32x2 uu = ua[g4], zz = za[g4];
              u32x2 o; o[0] = cvt_pk_bf16(bflo(zz[0]) * bflo(uu[0]) * (acc[4 * g4 + 0] + bs), bfhi(zz[0]) * bfhi(uu[0]) * (acc[4 * g4 + 1] + bs));
              o[1] = cvt_pk_bf16(bflo(zz[1]) * bflo(uu[1]) * (acc[4 * g4 + 2] + bs), bfhi(zz[1]) * bfhi(uu[1]) * (acc[4 * g4 + 3] + bs));
              *(u32x2*)(yp + c0) = o; } }
        __syncthreads();
    }
}

__device__ void p_mixers(const Params& p, unsigned char* lds) {
    for (int it = blockIdx.x; it < 256; it += gridDim.x) {
        const int xcd = it & 7, slot = it >> 3; const int bh = xcd * 8 + (slot >> 2), pr = slot & 3;
        for (int u = 0; u < 2; ++u) attn_unit(p, lds, bh >> 3, bh & 7, u ? pr : 7 - pr);
    }
    for (int it = blockIdx.x; it < 256; it += gridDim.x) sgu_item(p, lds, it >> 1, it & 1);
}

__device__ void p_ln(const Params& p) {
    int tid = threadIdx.x; asm volatile("" : "+v"(tid)); const int lane = tid & 63, wave = tid >> 6;
    for (int row = blockIdx.x * 8 + wave; row < NTOK; row += gridDim.x * 8) {
        float* rp = p.out + (size_t)row * D_MODEL; f32x4 v[4]; float s = 0.f;
#pragma unroll
        for (int j = 0; j < 4; ++j) { v[j] = *(const f32x4*)(rp + lane * 4 + 256 * j); s += (v[j][0] + v[j][1]) + (v[j][2] + v[j][3]); }
#pragma unroll
        for (int o = 32; o; o >>= 1) s += __shfl_xor(s, o);
        const float mu = s * (1.0f / 1024.f); float q = 0.f;
#pragma unroll
        for (int j = 0; j < 4; ++j) { const f32x4 d = v[j] - mu; q += (d[0] * d[0] + d[1] * d[1]) + (d[2] * d[2] + d[3] * d[3]); }
#pragma unroll
        for (int o = 32; o; o >>= 1) q += __shfl_xor(q, o);
        const float rstd = 1.0f / sqrtf(q * (1.0f / 1024.f) + LN_EPS);
#pragma unroll
        for (int j = 0; j < 4; ++j) { const int col = lane * 4 + 256 * j; const f32x4 g = *(const f32x4*)(p.ln_g + col), bb = *(const f32x4*)(p.ln_b + col);
            *(f32x4*)(rp + col) = (v[j] - mu) * rstd * g + bb; }
    }
}

#if MODE == 0
__global__ void __launch_bounds__(NT, 2) mega(Params p) {
    extern __shared__ __attribute__((aligned(16))) unsigned char lds[];
    volatile LAS unsigned* st = (volatile LAS unsigned*)((LAS unsigned char*)lds + 131072);
    if (threadIdx.x == 0) { st[0] = 0u; st[1] = 0u; st[2] = 0u; st[3] = 0u; }
    __syncthreads();
    const XcdBarrier bar = xcd_barrier_post((unsigned*)(p.ws + OFF_BAR), st);
    p0_prologue(p, lds); xcd_barrier(bar);
    p_hconv(p); xcd_barrier(bar);
    p_inproj(p, lds); xcd_barrier(bar);
    p_mixers(p, lds); xcd_barrier(bar);
    const bool fused = (gridDim.x == 256);
    p_outproj(p, lds, bar, fused);
    if (!fused) { cg::this_grid().sync(); p_ln(p); }
}
#else
__global__ void __launch_bounds__(NT, 2) mega(Params p) { extern __shared__ __attribute__((aligned(16))) unsigned char lds[]; p0_prologue(p, lds); }
__global__ void __launch_bounds__(NT, 2) k_ph1(Params p) { p_hconv(p); }
__global__ void __launch_bounds__(NT, 2) k_ph2(Params p) { extern __shared__ __attribute__((aligned(16))) unsigned char lds[]; p_inproj(p, lds); }
__global__ void __launch_bounds__(NT, 2) k_ph3(Params p) { extern __shared__ __attribute__((aligned(16))) unsigned char lds[]; p_mixers(p, lds); }
__global__ void __launch_bounds__(NT, 2) k_ph4(Params p) { extern __shared__ __attribute__((aligned(16))) unsigned char lds[]; XcdBarrier bar{}; p_outproj(p, lds, bar, false); }
__global__ void __launch_bounds__(NT, 2) k_ph5(Params p) { p_ln(p); }
#endif

extern "C" void kernel_launch(void* const* d_in, const int* in_sizes, int n_in, void* d_out, int out_size, void* d_ws, size_t ws_size, hipStream_t stream) {
    static int grid_blocks = 0;
    if (!grid_blocks) {
        int dev = 0, cus = 0, per_cu = 0;
        (void)hipGetDevice(&dev);
        (void)hipDeviceGetAttribute(&cus, hipDeviceAttributeMultiprocessorCount, dev);
        if (hipFuncSetAttribute((const void*)mega, hipFuncAttributeMaxDynamicSharedMemorySize, LDS_BYTES) != hipSuccess) fprintf(stderr, "hipFuncSetAttribute failed\n");
        if (hipOccupancyMaxActiveBlocksPerMultiprocessor(&per_cu, (const void*)mega, NT, LDS_BYTES) != hipSuccess || per_cu < 1) { fprintf(stderr, "occupancy query: %d\n", per_cu); per_cu = 1; }
        (void)hipGetLastError();
        if (per_cu > 1) per_cu = 1;
        grid_blocks = cus * per_cu;
    }
    Params p{};
    p.x = (const float*)d_in[0]; p.c = (const float*)d_in[1]; p.w_ada = (const float*)d_in[2]; p.b_ada = (const float*)d_in[3]; p.w_in = (const float*)d_in[4];
    p.sgu_g = (const float*)d_in[5]; p.sgu_b = (const float*)d_in[6]; p.w_sp = (const float*)d_in[7]; p.b_sp = (const float*)d_in[8]; p.w_out = (const float*)d_in[9];
    p.ln_g = (const float*)d_in[10]; p.ln_b = (const float*)d_in[11]; p.out = (float*)d_out; p.ws = (unsigned char*)d_ws; p.phase = 0; p.pad = 0;
#if MODE == 0
    (void)hipMemsetAsync((char*)d_ws + OFF_BAR, 0, XCD_BAR_WORDS * 4, stream);
    void* args[] = {&p};
    hipError_t e = hipLaunchCooperativeKernel((const void*)mega, dim3(grid_blocks), dim3(NT), args, LDS_BYTES, stream);
    if (e != hipSuccess) fprintf(stderr, "cooperative launch failed: %s (grid %d)\n", hipGetErrorString(e), grid_blocks);
#else
    hipFuncSetAttribute((const void*)k_ph2, hipFuncAttributeMaxDynamicSharedMemorySize, LDS_BYTES);
    hipFuncSetAttribute((const void*)k_ph3, hipFuncAttributeMaxDynamicSharedMemorySize, LDS_BYTES);
    hipFuncSetAttribute((const void*)k_ph4, hipFuncAttributeMaxDynamicSharedMemorySize, LDS_BYTES);
    hipLaunchKernelGGL(mega, dim3(grid_blocks), dim3(NT), LDS_BYTES, stream, p);
    hipLaunchKernelGGL(k_ph1, dim3(grid_blocks), dim3(NT), 0, stream, p);
    hipLaunchKernelGGL(k_ph2, dim3(grid_blocks), dim3(NT), LDS_BYTES, stream, p);
    hipLaunchKernelGGL(k_ph3, dim3(grid_blocks), dim3(NT), LDS_BYTES, stream, p);
    hipLaunchKernelGGL(k_ph4, dim3(grid_blocks), dim3(NT), LDS_BYTES, stream, p);
    hipLaunchKernelGGL(k_ph5, dim3(grid_blocks), dim3(NT), 0, stream, p);
#endif
}
```

```cpp
#include <hip/hip_runtime.h>
#include <hip/hip_cooperative_groups.h>
#include <cstdint>
#include <cstdio>
namespace cg = cooperative_groups;

#ifndef MODE
#define MODE 0
#endif

typedef unsigned short bf16_t;
typedef short bf16x8 __attribute__((ext_vector_type(8)));
typedef _Float16 f16x8 __attribute__((ext_vector_type(8)));
typedef float f32x4 __attribute__((ext_vector_type(4)));
typedef float f32x16 __attribute__((ext_vector_type(16)));
typedef unsigned u32x2 __attribute__((ext_vector_type(2)));
typedef unsigned u32x4 __attribute__((ext_vector_type(4)));

constexpr int D_MODEL = 1024, BATCH = 8, SEQ = 2048, NTOK = BATCH * SEQ;
constexpr int NPROJ = 3584, CHUNK = 128, NGRP = 8, NHEAD = 8;
constexpr int C_U = 0, C_V = 512, C_ZA = 1024, C_Q = 1536, C_K = 2048, C_VB = 2560, C_ZB = 3072;
constexpr float LN_EPS = 1e-5f;
constexpr float ALPHA = 1.189207115002721f;
constexpr float LOG2E = 1.4426950408889634f;
constexpr float QSCALE = 0.125f * LOG2E;
constexpr int NT = 512;
constexpr int LDS_BYTES = 131072 + 16;

__device__ __forceinline__ bf16_t f2bf(float f) { unsigned u = __float_as_uint(f); u += 0x7fffu + ((u >> 16) & 1u); return (bf16_t)(u >> 16); }
__device__ __forceinline__ float bf2f(bf16_t b) { return __uint_as_float(((unsigned)b) << 16); }
__device__ __forceinline__ float bflo(unsigned w) { return __uint_as_float(w << 16); }
__device__ __forceinline__ float bfhi(unsigned w) { return __uint_as_float(w & 0xffff0000u); }
typedef float f32x2_ __attribute__((ext_vector_type(2)));
typedef __bf16 bf16x2_ __attribute__((ext_vector_type(2)));
typedef _Float16 f16x2_ __attribute__((ext_vector_type(2)));
__device__ __forceinline__ unsigned cvt_pk_bf16(float lo, float hi) { f32x2_ v = {lo, hi}; return __builtin_bit_cast(unsigned, __builtin_convertvector(v, bf16x2_)); }
__device__ __forceinline__ unsigned cvt_pk_f16(float lo, float hi) { f32x2_ v = {lo, hi}; return __builtin_bit_cast(unsigned, __builtin_convertvector(v, f16x2_)); }
__device__ __forceinline__ float sigmoidf_(float v) { return __builtin_amdgcn_rcpf(1.0f + __builtin_amdgcn_exp2f(-v * LOG2E)); }
__device__ __forceinline__ float siluf_(float v) { return v * sigmoidf_(v); }
__device__ __forceinline__ float geluf_(float v) { return v * sigmoidf_(1.5957691216057308f * (v + 0.044715f * v * v * v)); }

constexpr size_t OFF_MOD = 0;
constexpr size_t OFF_HB = 1 << 20;
constexpr size_t OFF_WIN = OFF_HB + (size_t)NTOK * D_MODEL * 2;
constexpr size_t OFF_WOUT = OFF_WIN + (size_t)NPROJ * D_MODEL * 2;
constexpr size_t OFF_WSP = OFF_WOUT + (size_t)D_MODEL * D_MODEL * 2;
constexpr size_t OFF_PROJ = OFF_WSP + (size_t)NGRP * CHUNK * CHUNK * 2;
constexpr size_t OFF_Y = OFF_PROJ + (size_t)NTOK * NPROJ * 2;

struct Params {
    const float* x; const float* c; const float* w_ada; const float* b_ada; const float* w_in; const float* sgu_g; const float* sgu_b;
    const float* w_sp; const float* b_sp; const float* w_out; const float* ln_g; const float* ln_b;
    float* out; unsigned char* ws; int phase; int pad;
};


#define XB_TMO      128
#define XB_XCNT(j)  (256  + 64 * (j))
#define XB_XSUB(j)  (1280 + 64 * (j))
#define XB_XGEN(j)  (2304 + 64 * (j))
#define XB_TOP      3328
#define XB_TOPGEN   3392
#define XCD_BAR_WORDS 3456
#define XB_SPIN_CAP (1u << 18)
#define LAS __attribute__((address_space(3)))
__device__ __forceinline__ unsigned xb_ld(unsigned* p)              { return __hip_atomic_load(p, __ATOMIC_RELAXED, __HIP_MEMORY_SCOPE_AGENT); }
__device__ __forceinline__ unsigned xb_add(unsigned* p, unsigned v) { return __hip_atomic_fetch_add(p, v, __ATOMIC_RELAXED, __HIP_MEMORY_SCOPE_AGENT); }
__device__ __forceinline__ unsigned xb_xcc_id() { return (unsigned)__builtin_amdgcn_s_getreg((3 << 11) | 20) & 0xFu; }
#define XB_SPIN(cond, bar) do { unsigned _sp = 0; while (cond) { __builtin_amdgcn_s_sleep(1); \
    if ((++_sp & 255u) == 0u) { if (xb_ld(&(bar)[XB_TMO])) break; if (_sp > XB_SPIN_CAP) { atomicAdd(&(bar)[XB_TMO], 1u); break; } } } } while (0)
struct XcdBarrier { unsigned* bar; unsigned x; volatile LAS unsigned* st; };
__device__ __forceinline__ XcdBarrier xcd_barrier_post(unsigned* bar, volatile LAS unsigned* st) {
    XcdBarrier b; b.bar = bar; b.x = xb_xcc_id(); b.st = st;
    if (threadIdx.x == 0) (void)xb_add(&bar[XB_XCNT(b.x)], 1u);
    return b;
}
__device__ __forceinline__ void xcd_barrier_complete(unsigned* bar, unsigned x, unsigned& nloc, unsigned& nx) {
    const unsigned G = gridDim.x * gridDim.y * gridDim.z;
    unsigned sum, cnt, mine, sp = 0u;
    for (;;) {
        sum = 0u; cnt = 0u; mine = 0u;
#pragma unroll
        for (unsigned j = 0; j < 16; ++j) { const unsigned c = xb_ld(&bar[XB_XCNT(j)]); sum += c; cnt += (c > 0u) ? 1u : 0u; mine = (j == x) ? c : mine; }
        if (sum == G) break;
        __builtin_amdgcn_s_sleep(1);
        if ((++sp & 255u) == 0u) { if (xb_ld(&bar[XB_TMO])) break; if (sp > XB_SPIN_CAP) { atomicAdd(&bar[XB_TMO], 1u); break; } }
    }
    nloc = mine > 0u ? mine : 1u; nx = cnt > 0u ? cnt : 1u;
}
__device__ __forceinline__ void xcd_barrier(const XcdBarrier& b) {
    asm volatile("s_waitcnt vmcnt(0)" ::: "memory");
    __syncthreads();
    if (threadIdx.x == 0) {
        unsigned* bar = b.bar;
        __builtin_amdgcn_s_waitcnt(0);
        unsigned nloc = b.st[0], nx = b.st[1];
        if (nloc == 0u) { xcd_barrier_complete(bar, b.x, nloc, nx); b.st[0] = nloc; b.st[1] = nx; }
        const unsigned old = xb_add(&bar[XB_XSUB(b.x)], 1u);
        const unsigned gen = old / nloc;
        if (old + 1u == (gen + 1u) * nloc) {
            __builtin_amdgcn_fence(__ATOMIC_RELEASE, "agent");
            asm volatile("s_waitcnt vmcnt(0)" ::: "memory");
            const unsigned og = xb_add(&bar[XB_TOP], 1u);
            const unsigned tg = og / nx;
            if (og + 1u == (tg + 1u) * nx) xb_add(&bar[XB_TOPGEN], 1u);
            else XB_SPIN(xb_ld(&bar[XB_TOPGEN]) == tg, bar);
            __builtin_amdgcn_fence(__ATOMIC_ACQUIRE, "agent");
            xb_add(&bar[XB_XGEN(b.x)], 1u);
            asm volatile("s_waitcnt vmcnt(0)" ::: "memory");
        } else {
            XB_SPIN(xb_ld(&bar[XB_XGEN(b.x)]) == gen, bar);
            __builtin_amdgcn_fence(__ATOMIC_ACQUIRE, "agent");
            asm volatile("s_waitcnt vmcnt(0)" ::: "memory");
        }
    }
    __syncthreads();
}
constexpr size_t OFF_BAR = 128 * 1024;

__device__ void p0_prologue(const Params& p, unsigned char* lds) {
    int tid = threadIdx.x; asm volatile("" : "+v"(tid)); const int lane = tid & 63, wave = tid >> 6;
    float* mod = (float*)(p.ws + OFF_MOD);
    float* sc = (float*)lds;
    float* red = (float*)(lds + 32768);
    for (int it = blockIdx.x; it < 96; it += gridDim.x) {
        for (int i = tid; i < 8 * 1024; i += NT) sc[i] = siluf_(p.c[i]);
        __syncthreads();
        const int q = tid & 7, r = tid >> 3; const int c0 = it * 32 + q * 4;
        float acc[8][4];
#pragma unroll
        for (int b = 0; b < 8; ++b) { acc[b][0] = 0.f; acc[b][1] = 0.f; acc[b][2] = 0.f; acc[b][3] = 0.f; }
#pragma unroll 4
        for (int i = 0; i < 16; ++i) { const int k = r + 64 * i; const f32x4 w = *(const f32x4*)(p.w_ada + (size_t)k * 3072 + c0);
#pragma unroll
            for (int b = 0; b < 8; ++b) { const float s = sc[b * 1024 + k]; acc[b][0] += s * w[0]; acc[b][1] += s * w[1]; acc[b][2] += s * w[2]; acc[b][3] += s * w[3]; } }
#pragma unroll
        for (int b = 0; b < 8; ++b)
#pragma unroll
            for (int j = 0; j < 4; ++j) { float v = acc[b][j]; v += __shfl_xor(v, 8); v += __shfl_xor(v, 16); v += __shfl_xor(v, 32); acc[b][j] = v; }
        if (lane < 8) {
#pragma unroll
            for (int b = 0; b < 8; ++b)
#pragma unroll
                for (int j = 0; j < 4; ++j) red[(wave * 8 + q) * 32 + b * 4 + j] = acc[b][j];
        }
        __syncthreads();
        if (tid < 256) { const int b = tid >> 5, col = tid & 31, qq = col >> 2, j = col & 3; float s = 0.f;
#pragma unroll
            for (int w = 0; w < 8; ++w) s += red[(w * 8 + qq) * 32 + b * 4 + j];
            mod[b * 3072 + it * 32 + col] = s + p.b_ada[it * 32 + col]; }
        __syncthreads();
    }
    float* tb = (float*)(lds + 49152);
    for (int tile = blockIdx.x; tile < 896 + 256; tile += gridDim.x) {
        const float* W; bf16_t* Wt; int N, tk, tn;
        if (tile < 896) { W = p.w_in; Wt = (bf16_t*)(p.ws + OFF_WIN); N = NPROJ; tk = tile / 56; tn = tile % 56; }
        else { const int t2 = tile - 896; W = p.w_out; Wt = (bf16_t*)(p.ws + OFF_WOUT); N = D_MODEL; tk = t2 / 16; tn = t2 % 16; }
        const int k0 = tk * 64, n0 = tn * 64;
        { const int n4 = tid & 15, kk = tid >> 4;
#pragma unroll
          for (int i = 0; i < 2; ++i) { const int k = kk + 32 * i; const f32x4 v = *(const f32x4*)(W + (size_t)(k0 + k) * N + n0 + n4 * 4);
              tb[k * 65 + n4 * 4 + 0] = v[0]; tb[k * 65 + n4 * 4 + 1] = v[1]; tb[k * 65 + n4 * 4 + 2] = v[2]; tb[k * 65 + n4 * 4 + 3] = v[3]; } }
        __syncthreads();
        { const int n = tid >> 3, ks = tid & 7; u32x4 o;
          o[0] = cvt_pk_bf16(tb[(ks * 8 + 0) * 65 + n], tb[(ks * 8 + 1) * 65 + n]); o[1] = cvt_pk_bf16(tb[(ks * 8 + 2) * 65 + n], tb[(ks * 8 + 3) * 65 + n]);
          o[2] = cvt_pk_bf16(tb[(ks * 8 + 4) * 65 + n], tb[(ks * 8 + 5) * 65 + n]); o[3] = cvt_pk_bf16(tb[(ks * 8 + 6) * 65 + n], tb[(ks * 8 + 7) * 65 + n]);
          *(u32x4*)(Wt + (size_t)(n0 + n) * D_MODEL + k0 + ks * 8) = o; }
        __syncthreads();
    }
    bf16_t* wsp = (bf16_t*)(p.ws + OFF_WSP);
    for (int i = blockIdx.x * NT + tid; i < NGRP * CHUNK * CHUNK / 8; i += gridDim.x * NT) {
        const int e = i * 8, t = (e >> 7) & 127, s0 = e & 127;
        const f32x4 a = *(const f32x4*)(p.w_sp + e), b = *(const f32x4*)(p.w_sp + e + 4);
        float v[8] = {a[0], a[1], a[2], a[3], b[0], b[1], b[2], b[3]};
#pragma unroll
        for (int j = 0; j < 8; ++j) v[j] = (s0 + j <= t) ? v[j] : 0.f;
        u32x4 o; o[0] = cvt_pk_bf16(v[0], v[1]); o[1] = cvt_pk_bf16(v[2], v[3]); o[2] = cvt_pk_bf16(v[4], v[5]); o[3] = cvt_pk_bf16(v[6], v[7]);
        *(u32x4*)(wsp + e) = o;
    }
}

__device__ void p_hconv(const Params& p) {
    const float* mod = (const float*)(p.ws + OFF_MOD); bf16_t* hb = (bf16_t*)(p.ws + OFF_HB);
    int tid = threadIdx.x; asm volatile("" : "+v"(tid));
    const size_t stride = (size_t)gridDim.x * NT, total = (size_t)NTOK * D_MODEL / 8;
    for (size_t i0 = (size_t)blockIdx.x * NT + tid; i0 < total; i0 += 4 * stride) {
        f32x4 x0[4], x1[4];
#pragma unroll
        for (int u = 0; u < 4; ++u) { const size_t i = i0 + u * stride; if (i < total) { x0[u] = __builtin_nontemporal_load((const f32x4*)(p.x + i * 8)); x1[u] = __builtin_nontemporal_load((const f32x4*)(p.x + i * 8 + 4)); } }
#pragma unroll
        for (int u = 0; u < 4; ++u) { const size_t i = i0 + u * stride; if (i < total) {
            const size_t e = i * 8; const int col = (int)(e & 1023); const int b = (int)(e >> 21);
            const f32x4 sh0 = *(const f32x4*)(mod + b * 3072 + col), sh1 = *(const f32x4*)(mod + b * 3072 + col + 4);
            const f32x4 sc0 = *(const f32x4*)(mod + b * 3072 + 1024 + col), sc1 = *(const f32x4*)(mod + b * 3072 + 1024 + col + 4);
            const f32x4 h0 = x0[u] * (1.0f + sc0) + sh0, h1 = x1[u] * (1.0f + sc1) + sh1;
            u32x4 o; o[0] = cvt_pk_bf16(h0[0], h0[1]); o[1] = cvt_pk_bf16(h0[2], h0[3]); o[2] = cvt_pk_bf16(h1[0], h1[1]); o[3] = cvt_pk_bf16(h1[2], h1[3]);
            *(u32x4*)(hb + e) = o; } }
    }
}

constexpr int BM = 256, BK = 64, HALF = 128, NXCD = 8, WGM = 8, HT = HALF * BK;
__device__ __forceinline__ int lds_byte(int r, int c) { int st = (r >> 4) * 2 + (c >> 5), rr = r & 15, cc = c & 31, ob = rr * 64 + cc * 2; return st * 1024 + (ob ^ (((ob >> 9) & 1) << 5)); }
__device__ __forceinline__ void stage_rc(int b, int& R, int& C) { int st = b / 1024, sb = b % 1024, swz = sb ^ (((sb >> 9) & 1) << 5); R = (st >> 1) * 16 + swz / 64; C = (st & 1) * 32 + (swz % 64) / 2; }

struct TileOrder {
    int nM, nN, nwg, G, c;
    __device__ void init(int M, int N, int G_, int c_) { nM = M / BM; nN = N / BM; nwg = nM * nN; G = G_; c = c_; }
    __device__ bool next(int i, int& pm, int& pn) const {
        const long L = (long)i * G + c; if (L >= nwg) return false;
        int wgid = (int)L; { const int q = nwg / NXCD, r = nwg % NXCD, xcd = wgid % NXCD, off = wgid / NXCD; wgid = (xcd < r ? xcd * (q + 1) : r * (q + 1) + (xcd - r) * q) + off; }
        const int nig = WGM * nN, gid = wgid / nig, fm = gid * WGM, gsz = (nM - fm) < WGM ? (nM - fm) : WGM;
        pm = fm + ((wgid % nig) % gsz); pn = (wgid % nig) / gsz; return true;
    }
};

__device__ __forceinline__ void gemm_tile(const bf16_t* __restrict__ A, const bf16_t* __restrict__ Bt, const int K, const int brow, const int bcol, bf16_t* shm, f32x4 (&acc)[2][2][4][2]) {
#define SA(b, h) (shm + ((b) * 2 + (h)) * HT)
#define SB(b, h) (shm + (4 + (b) * 2 + (h)) * HT)
#define STAGE(P, BASE, br, kt) do { const char* _gb = (const char*)(BASE) + ((size_t)(br) * K + (size_t)(kt) * BK) * 2; \
    for (int _i = 0; _i < 2; ++_i) { int _b = gtx * 16 + _i * 8192; \
      __builtin_amdgcn_global_load_lds((const unsigned*)(_gb + soff[_i]), (__attribute__((address_space(3))) unsigned*)((char*)(P) + _b), 16, 0, 0); } } while (0)
#define LDA(dst, b, h) for (int m = 0; m < 4; ++m) for (int k = 0; k < 2; ++k) \
    dst[m][k] = *reinterpret_cast<const bf16x8*>((char*)SA(b, h) + lds_byte(wr * 64 + m * 16 + fr, k * 32 + fq * 8))
#define LDB(dst, b, h) for (int n = 0; n < 2; ++n) for (int k = 0; k < 2; ++k) \
    dst[n][k] = *reinterpret_cast<const bf16x8*>((char*)SB(b, h) + lds_byte(wc * 32 + n * 16 + fr, k * 32 + fq * 8))
#define MMA(ai, bj, At_, Bt_) do { __builtin_amdgcn_s_setprio(1); \
    for (int m = 0; m < 4; ++m) for (int n = 0; n < 2; ++n) for (int k = 0; k < 2; ++k) \
      acc[ai][bj][m][n] = __builtin_amdgcn_mfma_f32_16x16x32_bf16(Bt_[n][k], At_[m][k], acc[ai][bj][m][n], 0, 0, 0); \
    __builtin_amdgcn_s_setprio(0); } while (0)
#define WAIT_V(n) asm volatile("s_waitcnt vmcnt(" #n ")" ::: "memory")
#define WAIT_L(n) asm volatile("s_waitcnt lgkmcnt(" #n ")" ::: "memory")
#define BAR __builtin_amdgcn_s_barrier()
#define SCHED __builtin_amdgcn_sched_barrier(0)
    int gtx = threadIdx.x; asm volatile("" : "+v"(gtx));
    const int wid = gtx >> 6, lane = gtx & 63, wr = __builtin_amdgcn_readfirstlane(wid >> 2), wc = wid & 3, fr = lane & 15, fq = lane >> 4;
#pragma unroll
    for (int a = 0; a < 2; ++a)
#pragma unroll
        for (int b = 0; b < 2; ++b)
#pragma unroll
            for (int m = 0; m < 4; ++m)
#pragma unroll
                for (int n = 0; n < 2; ++n) acc[a][b][m][n] = (f32x4){0.f, 0.f, 0.f, 0.f};
    bf16x8 At[4][2], B0[2][2], B1[2][2];
    unsigned soff[2];
    for (int _i = 0; _i < 2; ++_i) { int _r, _c; stage_rc(gtx * 16 + _i * 8192, _r, _c); soff[_i] = (unsigned)(_r * K + _c) * 2u; }
    const int nt = K / BK;
    STAGE(SB(0, 0), Bt, bcol, 0); STAGE(SA(0, 0), A, brow, 0);
    STAGE(SB(0, 1), Bt, bcol + HALF, 0); STAGE(SA(0, 1), A, brow + HALF, 0);
    if (wr == 1) BAR;
    WAIT_V(4); BAR;
    STAGE(SB(1, 0), Bt, bcol, 1); STAGE(SA(1, 0), A, brow, 1); STAGE(SB(1, 1), Bt, bcol + HALF, 1);
    WAIT_V(6); BAR;
    for (int t = 0; t < nt - 2; t += 2) {
        LDB(B0, 0, 0); SCHED; LDA(At, 0, 0); STAGE(SA(1, 1), A, brow + HALF, t + 1);
        WAIT_L(8); BAR; WAIT_L(0); MMA(0, 0, At, B0); BAR; SCHED;
        LDB(B1, 0, 1); STAGE(SB(0, 0), Bt, bcol, t + 2);
        BAR; WAIT_L(0); MMA(0, 1, At, B1); BAR;
        LDA(At, 0, 1); STAGE(SA(0, 0), A, brow, t + 2);
        BAR; WAIT_L(0); MMA(1, 0, At, B0); BAR; SCHED;
        STAGE(SB(0, 1), Bt, bcol + HALF, t + 2);
        WAIT_V(6); BAR; MMA(1, 1, At, B1); BAR;
        LDB(B0, 1, 0); SCHED; LDA(At, 1, 0); STAGE(SA(0, 1), A, brow + HALF, t + 2);
        WAIT_L(8); BAR; WAIT_L(0); MMA(0, 0, At, B0); BAR; SCHED;
        LDB(B1, 1, 1); STAGE(SB(1, 0), Bt, bcol, t + 3);
        BAR; WAIT_L(0); MMA(0, 1, At, B1); BAR;
        LDA(At, 1, 1); STAGE(SA(1, 0), A, brow, t + 3);
        BAR; WAIT_L(0); MMA(1, 0, At, B0); BAR; SCHED;
        STAGE(SB(1, 1), Bt, bcol + HALF, t + 3);
        WAIT_V(6); BAR; MMA(1, 1, At, B1); BAR;
    }
    { LDB(B0, 0, 0); LDA(At, 0, 0); STAGE(SA(1, 1), A, brow + HALF, nt - 1);
      BAR; WAIT_L(0); MMA(0, 0, At, B0); BAR;
      LDB(B1, 0, 1); BAR; WAIT_L(0); MMA(0, 1, At, B1); BAR;
      LDA(At, 0, 1); WAIT_V(4); BAR; WAIT_L(0); MMA(1, 0, At, B0); MMA(1, 1, At, B1); BAR; }
    { LDB(B0, 1, 0); LDA(At, 1, 0); WAIT_V(2); BAR; WAIT_L(0); MMA(0, 0, At, B0); BAR;
      LDB(B1, 1, 1); WAIT_V(0); BAR; WAIT_L(0); MMA(0, 1, At, B1); BAR;
      LDA(At, 1, 1); BAR; WAIT_L(0); MMA(1, 0, At, B0); MMA(1, 1, At, B1); BAR; }
    if (wr == 0) BAR;
#undef SA
#undef SB
#undef STAGE
#undef LDA
#undef LDB
#undef MMA
}

__device__ void p_inproj(const Params& p, unsigned char* lds) {
    const bf16_t* hb = (const bf16_t*)(p.ws + OFF_HB); const bf16_t* winT = (const bf16_t*)(p.ws + OFF_WIN); bf16_t* proj = (bf16_t*)(p.ws + OFF_PROJ);
    TileOrder ord; ord.init(NTOK, NPROJ, gridDim.x, blockIdx.x);
    for (int i = 0;; ++i) {
        int pm, pn; if (!ord.next(i, pm, pn)) break;
        f32x4 acc[2][2][4][2];
        gemm_tile(hb, winT, D_MODEL, pm * BM, pn * BM, (bf16_t*)lds, acc);
        int tx = threadIdx.x; asm volatile("" : "+v"(tx));
        const int wid = tx >> 6, lane = tx & 63, wr = wid >> 2, wc = wid & 3, fr = lane & 15, fq = lane >> 4;
        const int seg = pn >> 1;
#pragma unroll
        for (int ai = 0; ai < 2; ++ai)
#pragma unroll
            for (int m = 0; m < 4; ++m) {
                const int row = pm * BM + ai * HALF + wr * 64 + m * 16 + fr;
                bf16_t* rowp = proj + (size_t)row * NPROJ + pn * BM + wc * 32 + fq * 4;
#pragma unroll
                for (int bj = 0; bj < 2; ++bj)
#pragma unroll
                    for (int n = 0; n < 2; ++n) {
                        f32x4 v = acc[ai][bj][m][n];
                        if (seg <= 1) { v[0] = geluf_(v[0]); v[1] = geluf_(v[1]); v[2] = geluf_(v[2]); v[3] = geluf_(v[3]); }
                        else if (seg == 2 || seg == 6) { v[0] = siluf_(v[0]); v[1] = siluf_(v[1]); v[2] = siluf_(v[2]); v[3] = siluf_(v[3]); }
                        else if (seg == 3) { v = v * QSCALE; }
                        u32x2 o; o[0] = cvt_pk_bf16(v[0], v[1]); o[1] = cvt_pk_bf16(v[2], v[3]);
                        *(u32x2*)(rowp + bj * HALF + n * 16) = o;
                    }
            }
        asm volatile("s_waitcnt vmcnt(0)" ::: "memory");
    }
}

constexpr size_t OFF_STATS = 256 * 1024;
__device__ void p_outproj(const Params& p, unsigned char* lds, const XcdBarrier& bar, const bool fused) {
    const bf16_t* yb = (const bf16_t*)(p.ws + OFF_Y); const bf16_t* woutT = (const bf16_t*)(p.ws + OFF_WOUT); const float* mod = (const float*)(p.ws + OFF_MOD);
    TileOrder ord; ord.init(NTOK, D_MODEL, gridDim.x, blockIdx.x);
    for (int i = 0;; ++i) {
        int pm, pn; if (!ord.next(i, pm, pn)) break;
        f32x4 acc[2][2][4][2];
        gemm_tile(yb, woutT, D_MODEL, pm * BM, pn * BM, (bf16_t*)lds, acc);
        int tx = threadIdx.x; asm volatile("" : "+v"(tx));
        const int wid = tx >> 6, lane = tx & 63, wr = wid >> 2, wc = wid & 3, fr = lane & 15, fq = lane >> 4;
        const int b = (pm * BM) / SEQ; const int col0 = pn * BM + wc * 32 + fq * 4;
        {   f32x4 gate[2][2];
#pragma unroll
            for (int bj = 0; bj < 2; ++bj)
#pragma unroll
                for (int n = 0; n < 2; ++n) gate[bj][n] = *(const f32x4*)(mod + b * 3072 + 2048 + col0 + bj * HALF + n * 16);
#pragma unroll
            for (int ai = 0; ai < 2; ++ai) {
                f32x4 xv[4][2][2];
#pragma unroll
                for (int m = 0; m < 4; ++m) { const size_t off = (size_t)(pm * BM + ai * HALF + wr * 64 + m * 16 + fr) * D_MODEL + col0;
#pragma unroll
                    for (int bj = 0; bj < 2; ++bj)
#pragma unroll
                        for (int n = 0; n < 2; ++n) xv[m][bj][n] = __builtin_nontemporal_load((const f32x4*)(p.x + off + bj * HALF + n * 16)); }
#pragma unroll
                for (int m = 0; m < 4; ++m)
#pragma unroll
                    for (int bj = 0; bj < 2; ++bj)
#pragma unroll
                        for (int n = 0; n < 2; ++n) acc[ai][bj][m][n] = xv[m][bj][n] * ALPHA + gate[bj][n] * acc[ai][bj][m][n];
            } }
        if (!fused) {
#pragma unroll
            for (int ai = 0; ai < 2; ++ai)
#pragma unroll
                for (int m = 0; m < 4; ++m) { const size_t off = (size_t)(pm * BM + ai * HALF + wr * 64 + m * 16 + fr) * D_MODEL + col0;
#pragma unroll
                    for (int bj = 0; bj < 2; ++bj)
#pragma unroll
                        for (int n = 0; n < 2; ++n) *(f32x4*)(p.out + off + bj * HALF + n * 16) = acc[ai][bj][m][n]; }
            asm volatile("s_waitcnt vmcnt(0)" ::: "memory");
            continue;
        }
        float* P = (float*)lds;
        float* S = (float*)(lds + 8192);
        float* gstats = (float*)(p.ws + OFF_STATS);
#pragma unroll
        for (int ai = 0; ai < 2; ++ai)
#pragma unroll
            for (int m = 0; m < 4; ++m) { float s1 = 0.f, s2 = 0.f;
#pragma unroll
                for (int bj = 0; bj < 2; ++bj)
#pragma unroll
                    for (int n = 0; n < 2; ++n) { const f32x4 v = acc[ai][bj][m][n]; s1 += (v[0] + v[1]) + (v[2] + v[3]); s2 += (v[0] * v[0] + v[1] * v[1]) + (v[2] * v[2] + v[3] * v[3]); }
                s1 += __shfl_xor(s1, 16); s2 += __shfl_xor(s2, 16); s1 += __shfl_xor(s1, 32); s2 += __shfl_xor(s2, 32);
                if (fq == 0) { const int rl = ai * HALF + wr * 64 + m * 16 + fr; P[(rl * 4 + wc) * 2] = s1; P[(rl * 4 + wc) * 2 + 1] = s2; } }
        __syncthreads();
        if (tx < 256) { const f32x4 a = *(const f32x4*)(P + tx * 8), c2 = *(const f32x4*)(P + tx * 8 + 4);
            float* gp = gstats + ((size_t)(pm * BM + tx) * 4 + pn) * 2; gp[0] = (a[0] + a[2]) + (c2[0] + c2[2]); gp[1] = (a[1] + a[3]) + (c2[1] + c2[3]); }
        xcd_barrier(bar);
        if (tx < 256) { const float* gp = gstats + (size_t)(pm * BM + tx) * 8; const f32x4 a = *(const f32x4*)gp, c2 = *(const f32x4*)(gp + 4);
            const float mean = ((a[0] + a[2]) + (c2[0] + c2[2])) * (1.0f / 1024.f); const float ex2 = ((a[1] + a[3]) + (c2[1] + c2[3])) * (1.0f / 1024.f);
            const float var = fmaxf(ex2 - mean * mean, 0.f); S[tx * 2] = mean; S[tx * 2 + 1] = 1.0f / sqrtf(var + LN_EPS); }
        __syncthreads();
        {   f32x4 gg[2][2], bb[2][2];
#pragma unroll
            for (int bj = 0; bj < 2; ++bj)
#pragma unroll
                for (int n = 0; n < 2; ++n) { gg[bj][n] = *(const f32x4*)(p.ln_g + col0 + bj * HALF + n * 16); bb[bj][n] = *(const f32x4*)(p.ln_b + col0 + bj * HALF + n * 16); }
#pragma unroll
            for (int ai = 0; ai < 2; ++ai)
#pragma unroll
                for (int m = 0; m < 4; ++m) { const int rl = ai * HALF + wr * 64 + m * 16 + fr; const float mean = S[rl * 2], rstd = S[rl * 2 + 1];
                    const size_t off = (size_t)(pm * BM + rl) * D_MODEL + col0;
#pragma unroll
                    for (int bj = 0; bj < 2; ++bj)
#pragma unroll
                        for (int n = 0; n < 2; ++n) __builtin_nontemporal_store((acc[ai][bj][m][n] - mean) * rstd * gg[bj][n] + bb[bj][n], (f32x4*)(p.out + off + bj * HALF + n * 16)); } }
    }
}

constexpr int KROW = 72;
__device__ __forceinline__ float relu_(float x) { int i = __builtin_bit_cast(int, x); i = i > 0 ? i : 0; return __builtin_bit_cast(float, i); }
__device__ __forceinline__ void softplus_pack(const f32x16& z, f16x8 (&lf)[2]) {
    unsigned w[8];
#pragma unroll
    for (int i = 0; i < 8; ++i) {
        const float z0 = z[2 * i], z1 = z[2 * i + 1];
        const float l0 = __builtin_amdgcn_logf(1.0f + __builtin_amdgcn_exp2f(-__builtin_fabsf(z0))), l1 = __builtin_amdgcn_logf(1.0f + __builtin_amdgcn_exp2f(-__builtin_fabsf(z1)));
        w[i] = cvt_pk_f16(relu_(z0) + l0, relu_(z1) + l1);
    }
    u32x4 t0 = {w[0], w[1], w[2], w[3]}, t1 = {w[4], w[5], w[6], w[7]};
    lf[0] = __builtin_bit_cast(f16x8, t0); lf[1] = __builtin_bit_cast(f16x8, t1);
}
__device__ __forceinline__ void expo_pack(const f32x16& z, const f32x16& cum, bf16x8 (&pf)[2]) {
    unsigned w[8];
#pragma unroll
    for (int i = 0; i < 8; ++i) w[i] = cvt_pk_bf16(__builtin_amdgcn_exp2f(z[2 * i] + cum[2 * i]), __builtin_amdgcn_exp2f(z[2 * i + 1] + cum[2 * i + 1]));
    u32x4 t0 = {w[0], w[1], w[2], w[3]}, t1 = {w[4], w[5], w[6], w[7]};
    pf[0] = __builtin_bit_cast(bf16x8, t0); pf[1] = __builtin_bit_cast(bf16x8, t1);
}
__device__ __forceinline__ void exp_pack(const f32x16& e, bf16x8 (&pf)[2]) {
    unsigned w[8];
#pragma unroll
    for (int i = 0; i < 8; ++i) w[i] = cvt_pk_bf16(__builtin_amdgcn_exp2f(e[2 * i]), __builtin_amdgcn_exp2f(e[2 * i + 1]));
    u32x4 t0 = {w[0], w[1], w[2], w[3]}, t1 = {w[4], w[5], w[6], w[7]};
    pf[0] = __builtin_bit_cast(bf16x8, t0); pf[1] = __builtin_bit_cast(bf16x8, t1);
}
__device__ __forceinline__ f32x16 bcast16(float v) { f32x16 r;
#pragma unroll
    for (int i = 0; i < 16; ++i) r[i] = v;
    return r; }

__device__ __forceinline__ void tile_transpose(float* reg, const f32x16& acc, const float add, const int c, const int hh, const int lane, f32x4 (&out)[4]) {
    asm volatile("" ::: "memory");
#pragma unroll
    for (int g4 = 0; g4 < 4; ++g4) { f32x4 v = {acc[4 * g4 + 0] + add, acc[4 * g4 + 1] + add, acc[4 * g4 + 2] + add, acc[4 * g4 + 3] + add}; *(f32x4*)(reg + c * 36 + 8 * g4 + 4 * hh) = v; }
    asm volatile("" ::: "memory");
    const int t = lane >> 1, half = lane & 1;
#pragma unroll
    for (int j = 0; j < 4; ++j) out[j] = *(const f32x4*)(reg + t * 36 + half * 16 + 4 * j);
    asm volatile("" ::: "memory");
}

__device__ __forceinline__ void attn_unit(const Params& p, unsigned char* lds, const int b, const int h, const int qb) {
    const bf16_t* proj = (const bf16_t*)(p.ws + OFF_PROJ); bf16_t* yb = (bf16_t*)(p.ws + OFF_Y);
    int tid = threadIdx.x; asm volatile("" : "+v"(tid)); const int lane = tid & 63, wave = __builtin_amdgcn_readfirstlane(tid >> 6), c = lane & 31, hh = lane >> 5;
    bf16_t* Ks = (bf16_t*)lds;
    bf16_t* Vt = (bf16_t*)(lds + 2 * 64 * KROW * 2);
    const size_t tokbase = (size_t)b * SEQ; const int q0 = qb * 256, tq0 = q0 + wave * 32;
    bf16x8 qf[4];
    { const bf16_t* qp = proj + (tokbase + tq0 + c) * NPROJ + C_Q + h * 64 + hh * 8;
#pragma unroll
      for (int ks = 0; ks < 4; ++ks) qf[ks] = *(const bf16x8*)(qp + ks * 16);
#pragma unroll
      for (int ks = 0; ks < 4; ++ks) asm volatile("" : "+v"(qf[ks])); }
    f16x8 uf[2], nones;
#pragma unroll
    for (int ks2 = 0; ks2 < 2; ++ks2)
#pragma unroll
        for (int jj = 0; jj < 8; ++jj) { const int key = 16 * ks2 + 8 * (jj >> 2) + 4 * hh + (jj & 3); uf[ks2][jj] = (key >= c) ? (_Float16)-1.0f : (_Float16)0.0f; }
#pragma unroll
    for (int jj = 0; jj < 8; ++jj) nones[jj] = (_Float16)-1.0f;
    f32x16 o0 = bcast16(0.f), o1 = bcast16(0.f);
    float R = 0.f;
    const int ntile = (q0 + 256) / 64;
    const int skey = tid >> 3, sch = tid & 7; const int spk = (skey & ~12) | ((skey & 4) << 1) | ((skey & 8) >> 1);
    u32x4 kreg, vreg;
    { const bf16_t* kp = proj + (tokbase + (ntile - 1) * 64 + skey) * NPROJ + h * 64 + sch * 8; kreg = *(const u32x4*)(kp + C_K); vreg = *(const u32x4*)(kp + C_VB); }
    volatile int* flags = (volatile int*)(lds + 73728);
    bool wdone = false;
    int buf = 0;
    { *(u32x4*)(Ks + (buf * 64 + skey) * KROW + sch * 8) = kreg;
      bf16_t* vp = Vt + (buf * 64 + sch * 8) * KROW + spk;
#pragma unroll
      for (int e = 0; e < 4; ++e) { vp[(2 * e) * KROW] = (bf16_t)(vreg[e] & 0xffffu); vp[(2 * e + 1) * KROW] = (bf16_t)(vreg[e] >> 16); } }
    __syncthreads();
    for (int kt = ntile - 1; kt >= 0; --kt) {
        if (kt > 0) { const bf16_t* kp = proj + (tokbase + (kt - 1) * 64 + skey) * NPROJ + h * 64 + sch * 8; kreg = *(const u32x4*)(kp + C_K); vreg = *(const u32x4*)(kp + C_VB); }
        const bf16_t* Kb = Ks + buf * 64 * KROW; const bf16_t* Vb = Vt + buf * 64 * KROW;
        if (wdone) {
        } else if (kt * 64 + 64 <= tq0) {
            f32x16 z1 = bcast16(0.f), z0 = bcast16(0.f);
#pragma unroll
            for (int ks = 0; ks < 4; ++ks) { const bf16x8 kf = *(const bf16x8*)(Kb + (32 + c) * KROW + ks * 16 + hh * 8); z1 = __builtin_amdgcn_mfma_f32_32x32x16_bf16(kf, qf[ks], z1, 0, 0, 0); }
#pragma unroll
            for (int ks = 0; ks < 4; ++ks) { const bf16x8 kf = *(const bf16x8*)(Kb + (c) * KROW + ks * 16 + hh * 8); z0 = __builtin_amdgcn_mfma_f32_32x32x16_bf16(kf, qf[ks], z0, 0, 0, 0); }
            f16x8 lf1[2], lf0[2];
            softplus_pack(z1, lf1);
            f32x16 e1 = z1 + R, e0 = z0 + R;
            e1 = __builtin_amdgcn_mfma_f32_32x32x16_f16(uf[0], lf1[0], e1, 0, 0, 0);
            e1 = __builtin_amdgcn_mfma_f32_32x32x16_f16(uf[1], lf1[1], e1, 0, 0, 0);
            e0 = __builtin_amdgcn_mfma_f32_32x32x16_f16(nones, lf1[0], e0, 0, 0, 0);
            e0 = __builtin_amdgcn_mfma_f32_32x32x16_f16(nones, lf1[1], e0, 0, 0, 0);
            softplus_pack(z0, lf0);
            e0 = __builtin_amdgcn_mfma_f32_32x32x16_f16(uf[0], lf0[0], e0, 0, 0, 0);
            e0 = __builtin_amdgcn_mfma_f32_32x32x16_f16(uf[1], lf0[1], e0, 0, 0, 0);
            bf16x8 pf1[2], pf0[2];
            exp_pack(e1, pf1);
#pragma unroll
            for (int ks2 = 0; ks2 < 2; ++ks2) {
                const bf16x8 v0 = *(const bf16x8*)(Vb + (c) * KROW + 32 + ks2 * 16 + hh * 8), v1 = *(const bf16x8*)(Vb + (32 + c) * KROW + 32 + ks2 * 16 + hh * 8);
                o0 = __builtin_amdgcn_mfma_f32_32x32x16_bf16(v0, pf1[ks2], o0, 0, 0, 0); o1 = __builtin_amdgcn_mfma_f32_32x32x16_bf16(v1, pf1[ks2], o1, 0, 0, 0);
            }
            exp_pack(e0, pf0);
            R = __shfl(e0[0] - z0[0], c);
#pragma unroll
            for (int ks2 = 0; ks2 < 2; ++ks2) {
                const bf16x8 v0 = *(const bf16x8*)(Vb + (c) * KROW + ks2 * 16 + hh * 8), v1 = *(const bf16x8*)(Vb + (32 + c) * KROW + ks2 * 16 + hh * 8);
                o0 = __builtin_amdgcn_mfma_f32_32x32x16_bf16(v0, pf0[ks2], o0, 0, 0, 0); o1 = __builtin_amdgcn_mfma_f32_32x32x16_bf16(v1, pf0[ks2], o1, 0, 0, 0);
            }
        } else {
#pragma unroll 1
            for (int sub = 1; sub >= 0; --sub) {
                const int ks0 = kt * 64 + sub * 32;
                if (ks0 <= tq0) {
                    f32x16 z = bcast16(0.f);
#pragma unroll
                    for (int ks = 0; ks < 4; ++ks) { const bf16x8 kf = *(const bf16x8*)(Kb + (sub * 32 + c) * KROW + ks * 16 + hh * 8); z = __builtin_amdgcn_mfma_f32_32x32x16_bf16(kf, qf[ks], z, 0, 0, 0); }
                    if (ks0 == tq0) {
#pragma unroll
                        for (int r = 0; r < 16; ++r) { const int s = (r & 3) + 8 * (r >> 2) + 4 * hh; z[r] = (s >= c) ? -__builtin_inff() : z[r]; }
                    }
                    f16x8 lf[2]; softplus_pack(z, lf);
                    f32x16 cum = bcast16(R);
                    cum = __builtin_amdgcn_mfma_f32_32x32x16_f16(uf[0], lf[0], cum, 0, 0, 0);
                    cum = __builtin_amdgcn_mfma_f32_32x32x16_f16(uf[1], lf[1], cum, 0, 0, 0);
                    bf16x8 pf[2]; expo_pack(z, cum, pf);
                    R = __shfl(cum[0], c);
#pragma unroll
                    for (int ks2 = 0; ks2 < 2; ++ks2) {
                        const bf16x8 v0 = *(const bf16x8*)(Vb + (c) * KROW + sub * 32 + ks2 * 16 + hh * 8), v1 = *(const bf16x8*)(Vb + (32 + c) * KROW + sub * 32 + ks2 * 16 + hh * 8);
                        o0 = __builtin_amdgcn_mfma_f32_32x32x16_bf16(v0, pf[ks2], o0, 0, 0, 0); o1 = __builtin_amdgcn_mfma_f32_32x32x16_bf16(v1, pf[ks2], o1, 0, 0, 0);
                    }
                }
            }
        }
        wdone = (__builtin_amdgcn_ballot_w64(R > -160.0f) == 0ull);
        if (lane == 0) flags[(kt & 1) * 8 + wave] = wdone ? 1 : 0;
        if (kt > 0) {
            const int nb = buf ^ 1;
            *(u32x4*)(Ks + (nb * 64 + skey) * KROW + sch * 8) = kreg;
            bf16_t* vp = Vt + (nb * 64 + sch * 8) * KROW + spk;
#pragma unroll
            for (int e = 0; e < 4; ++e) { vp[(2 * e) * KROW] = (bf16_t)(vreg[e] & 0xffffu); vp[(2 * e + 1) * KROW] = (bf16_t)(vreg[e] >> 16); }
        }
        __syncthreads();
        buf ^= 1;
        { int alld = 1;
#pragma unroll
          for (int w = 0; w < 8; ++w) alld &= flags[(kt & 1) * 8 + w];
          if (__builtin_amdgcn_readfirstlane(alld)) break; }
    }
    { float* reg = (float*)(lds + 36864 + wave * 4608);
      const int t = lane >> 1, half = lane & 1; const size_t tok = tokbase + tq0 + t;
      const bf16_t* zp = proj + tok * NPROJ + C_ZB + h * 64 + half * 16; bf16_t* yp = yb + tok * D_MODEL + 512 + h * 64 + half * 16;
      u32x4 zz[2][2];
#pragma unroll
      for (int dt = 0; dt < 2; ++dt) { zz[dt][0] = *(const u32x4*)(zp + dt * 32); zz[dt][1] = *(const u32x4*)(zp + dt * 32 + 8); }
#pragma unroll
      for (int dt = 0; dt < 2; ++dt) { f32x4 ov[4]; tile_transpose(reg, dt ? o1 : o0, 0.f, c, hh, lane, ov);
#pragma unroll
          for (int q = 0; q < 2; ++q) { const u32x4 z4 = zz[dt][q]; const f32x4 a = ov[2 * q], b2 = ov[2 * q + 1]; u32x4 o;
              o[0] = cvt_pk_bf16(bflo(z4[0]) * a[0], bfhi(z4[0]) * a[1]); o[1] = cvt_pk_bf16(bflo(z4[1]) * a[2], bfhi(z4[1]) * a[3]);
              o[2] = cvt_pk_bf16(bflo(z4[2]) * b2[0], bfhi(z4[2]) * b2[1]); o[3] = cvt_pk_bf16(bflo(z4[3]) * b2[2], bfhi(z4[3]) * b2[3]);
              *(u32x4*)(yp + dt * 32 + 8 * q) = o; } } }
}

constexpr int VROW = 136;
__device__ __forceinline__ void sgu_item(const Params& p, unsigned char* lds, const int ch, const int hf) {
    const bf16_t* proj = (const bf16_t*)(p.ws + OFF_PROJ); bf16_t* yb = (bf16_t*)(p.ws + OFF_Y); const bf16_t* wsp = (const bf16_t*)(p.ws + OFF_WSP);
    int tid = threadIdx.x; asm volatile("" : "+v"(tid)); const int lane = tid & 63, wave = __builtin_amdgcn_readfirstlane(tid >> 6), c = lane & 31, hh = lane >> 5;
    float* stats = (float*)(lds + 73728);
    bf16_t* vw = (bf16_t*)(lds + wave * 8704);
    const size_t tok0 = (size_t)ch * CHUNK;
    const int g = hf * 4 + (wave >> 1), ct = wave & 1, ch0 = g * 64 + ct * 32;
    u32x4 vv[2][4];
#pragma unroll
    for (int i = 0; i < 2; ++i) { const bf16_t* vp = proj + (tok0 + lane + 64 * i) * NPROJ + C_V + ch0;
#pragma unroll
        for (int j = 0; j < 4; ++j) vv[i][j] = *(const u32x4*)(vp + 8 * j); }
    bf16x8 wf[20];
#pragma unroll
    for (int tt = 0; tt < 4; ++tt) { const bf16_t* wrow = wsp + ((size_t)g * CHUNK + tt * 32 + c) * CHUNK + hh * 8;
#pragma unroll
        for (int ks = 0; ks < 2 * (tt + 1); ++ks) wf[tt * (tt + 1) + ks] = *(const bf16x8*)(wrow + ks * 16); }
    { const int l16 = lane & 15, tq = lane >> 4;
#pragma unroll
      for (int it4 = 0; it4 < 4; ++it4) { const int token = wave * 16 + it4 * 4 + tq; const bf16_t* vp = proj + (tok0 + token) * NPROJ + C_V + l16 * 8; float s1 = 0.f, s2 = 0.f;
          u32x4 w[4];
#pragma unroll
          for (int i = 0; i < 4; ++i) w[i] = *(const u32x4*)(vp + i * 128);
#pragma unroll
          for (int i = 0; i < 4; ++i)
#pragma unroll
              for (int e = 0; e < 4; ++e) { const float a = bflo(w[i][e]), bb = bfhi(w[i][e]); s1 += a + bb; s2 += a * a + bb * bb; }
#pragma unroll
          for (int o = 1; o < 16; o <<= 1) { s1 += __shfl_xor(s1, o); s2 += __shfl_xor(s2, o); }
          const float mean = s1 * (1.0f / 512.f); const float var = fmaxf(s2 * (1.0f / 512.f) - mean * mean, 0.f);
          if (l16 == 0) { stats[token * 2] = mean; stats[token * 2 + 1] = 1.0f / sqrtf(var + LN_EPS); } } }
    __syncthreads();
#pragma unroll
    for (int i = 0; i < 2; ++i) { const int sidx = lane + 64 * i; const float mean = stats[sidx * 2], rstd = stats[sidx * 2 + 1];
#pragma unroll
        for (int j = 0; j < 4; ++j)
#pragma unroll
            for (int e = 0; e < 4; ++e) { const int cl = 8 * j + 2 * e; const unsigned w = vv[i][j][e];
                const float a = (bflo(w) - mean) * rstd * p.sgu_g[ch0 + cl] + p.sgu_b[ch0 + cl], bb = (bfhi(w) - mean) * rstd * p.sgu_g[ch0 + cl + 1] + p.sgu_b[ch0 + cl + 1];
                vw[cl * VROW + sidx] = f2bf(a); vw[(cl + 1) * VROW + sidx] = f2bf(bb); } }
    asm volatile("" ::: "memory");
    const bf16_t* vrow = vw + c * VROW + hh * 8;
    float* reg = (float*)(lds + 74752 + wave * 4608);
#pragma unroll
    for (int tt = 0; tt < 4; ++tt) {
        const float bs = p.b_sp[g * CHUNK + tt * 32 + c];
        const int t2 = lane >> 1, half = lane & 1; const size_t tok = tok0 + tt * 32 + t2;
        const bf16_t* up = proj + tok * NPROJ + C_U + ch0 + half * 16; const bf16_t* zp = proj + tok * NPROJ + C_ZA + ch0 + half * 16; bf16_t* yp = yb + tok * D_MODEL + ch0 + half * 16;
        const u32x4 u0 = *(const u32x4*)(up), u1 = *(const u32x4*)(up + 8), z0 = *(const u32x4*)(zp), z1 = *(const u32x4*)(zp + 8);
        f32x16 acc = bcast16(0.f);
#pragma unroll
        for (int ks = 0; ks < 2 * (tt + 1); ++ks) { const bf16x8 af = *(const bf16x8*)(vrow + ks * 16); acc = __builtin_amdgcn_mfma_f32_32x32x16_bf16(af, wf[tt * (tt + 1) + ks], acc, 0, 0, 0); }
        f32x4 mv[4]; tile_transpose(reg, acc, bs, c, hh, lane, mv);
#pragma unroll
        for (int q = 0; q < 2; ++q) { const u32x4 uu = q ? u1 : u0, zz = q ? z1 : z0; const f32x4 a = mv[2 * q], b2 = mv[2 * q + 1]; u32x4 o;
            o[0] = cvt_pk_bf16(bflo(zz[0]) * bflo(uu[0]) * a[0], bfhi(zz[0]) * bfhi(uu[0]) * a[1]); o[1] = cvt_pk_bf16(bflo(zz[1]) * bflo(uu[1]) * a[2], bfhi(zz[1]) * bfhi(uu[1]) * a[3]);
            o[2] = cvt_pk_bf16(bflo(zz[2]) * bflo(uu[2]) * b2[0], bfhi(zz[2]) * bfhi(uu[2]) * b2[1]); o[3] = cvt_pk_bf16(bflo(zz[3]) * bflo(uu[3]) * b2[2], bfhi(zz[3]) * bfhi(uu[3]) * b2[3]);
            *(u32x4*)(yp + 8 * q) = o; }
    }
    __syncthreads();
}

__device__ void p_mixers(const Params& p, unsigned char* lds) {
    for (int it = blockIdx.x; it < 256; it += gridDim.x) {
        const int xcd = it & 7, slot = it >> 3; const int bh = xcd * 8 + (slot >> 2), pr = slot & 3;
        for (int u = 0; u < 2; ++u) attn_unit(p, lds, bh >> 3, bh & 7, u ? pr : 7 - pr);
    }
    for (int it = blockIdx.x; it < 256; it += gridDim.x) sgu_item(p, lds, it >> 1, it & 1);
}

__device__ void p_ln(const Params& p) {
    int tid = threadIdx.x; asm volatile("" : "+v"(tid)); const int lane = tid & 63, wave = tid >> 6;
    for (int row = blockIdx.x * 8 + wave; row < NTOK; row += gridDim.x * 8) {
        float* rp = p.out + (size_t)row * D_MODEL; f32x4 v[4]; float s = 0.f;
#pragma unroll
        for (int j = 0; j < 4; ++j) { v[j] = *(const f32x4*)(rp + lane * 4 + 256 * j); s += (v[j][0] + v[j][1]) + (v[j][2] + v[j][3]); }
#pragma unroll
        for (int o = 32; o; o >>= 1) s += __shfl_xor(s, o);
        const float mu = s * (1.0f / 1024.f); float q = 0.f;
#pragma unroll
        for (int j = 0; j < 4; ++j) { const f32x4 d = v[j] - mu; q += (d[0] * d[0] + d[1] * d[1]) + (d[2] * d[2] + d[3] * d[3]); }
#pragma unroll
        for (int o = 32; o; o >>= 1) q += __shfl_xor(q, o);
        const float rstd = 1.0f / sqrtf(q * (1.0f / 1024.f) + LN_EPS);
#pragma unroll
        for (int j = 0; j < 4; ++j) { const int col = lane * 4 + 256 * j; const f32x4 g = *(const f32x4*)(p.ln_g + col), bb = *(const f32x4*)(p.ln_b + col);
            *(f32x4*)(rp + col) = (v[j] - mu) * rstd * g + bb; }
    }
}

#if MODE == 0
__global__ void __launch_bounds__(NT, 2) mega(Params p) {
    extern __shared__ __attribute__((aligned(16))) unsigned char lds[];
    volatile LAS unsigned* st = (volatile LAS unsigned*)((LAS unsigned char*)lds + 131072);
    if (threadIdx.x == 0) { st[0] = 0u; st[1] = 0u; st[2] = 0u; st[3] = 0u; }
    __syncthreads();
    const XcdBarrier bar = xcd_barrier_post((unsigned*)(p.ws + OFF_BAR), st);
    p0_prologue(p, lds); xcd_barrier(bar);
    p_hconv(p); xcd_barrier(bar);
    p_inproj(p, lds); xcd_barrier(bar);
    p_mixers(p, lds); xcd_barrier(bar);
    const bool fused = (gridDim.x == 256);
    p_outproj(p, lds, bar, fused);
    if (!fused) { cg::this_grid().sync(); p_ln(p); }
}
#else
__global__ void __launch_bounds__(NT, 2) mega(Params p) { extern __shared__ __attribute__((aligned(16))) unsigned char lds[]; p0_prologue(p, lds); }
__global__ void __launch_bounds__(NT, 2) k_ph1(Params p) { p_hconv(p); }
__global__ void __launch_bounds__(NT, 2) k_ph2(Params p) { extern __shared__ __attribute__((aligned(16))) unsigned char lds[]; p_inproj(p, lds); }
__global__ void __launch_bounds__(NT, 2) k_ph3(Params p) { extern __shared__ __attribute__((aligned(16))) unsigned char lds[]; p_mixers(p, lds); }
__global__ void __launch_bounds__(NT, 2) k_ph4(Params p) { extern __shared__ __attribute__((aligned(16))) unsigned char lds[]; XcdBarrier bar{}; p_outproj(p, lds, bar, false); }
__global__ void __launch_bounds__(NT, 2) k_ph5(Params p) { p_ln(p); }
#endif

extern "C" void kernel_launch(void* const* d_in, const int* in_sizes, int n_in, void* d_out, int out_size, void* d_ws, size_t ws_size, hipStream_t stream) {
    static int grid_blocks = 0;
    if (!grid_blocks) {
        int dev = 0, cus = 0, per_cu = 0;
        (void)hipGetDevice(&dev);
        (void)hipDeviceGetAttribute(&cus, hipDeviceAttributeMultiprocessorCount, dev);
        if (hipFuncSetAttribute((const void*)mega, hipFuncAttributeMaxDynamicSharedMemorySize, LDS_BYTES) != hipSuccess) fprintf(stderr, "hipFuncSetAttribute failed\n");
        if (hipOccupancyMaxActiveBlocksPerMultiprocessor(&per_cu, (const void*)mega, NT, LDS_BYTES) != hipSuccess || per_cu < 1) { fprintf(stderr, "occupancy query: %d\n", per_cu); per_cu = 1; }
        (void)hipGetLastError();
        if (per_cu > 1) per_cu = 1;
        grid_blocks = cus * per_cu;
    }
    Params p{};
    p.x = (const float*)d_in[0]; p.c = (const float*)d_in[1]; p.w_ada = (const float*)d_in[2]; p.b_ada = (const float*)d_in[3]; p.w_in = (const float*)d_in[4];
    p.sgu_g = (const float*)d_in[5]; p.sgu_b = (const float*)d_in[6]; p.w_sp = (const float*)d_in[7]; p.b_sp = (const float*)d_in[8]; p.w_out = (const float*)d_in[9];
    p.ln_g = (const float*)d_in[10]; p.ln_b = (const float*)d_in[11]; p.out = (float*)d_out; p.ws = (unsigned char*)d_ws; p.phase = 0; p.pad = 0;
#if MODE == 0
    (void)hipMemsetAsync((char*)d_ws + OFF_BAR, 0, XCD_BAR_WORDS * 4, stream);
    void* args[] = {&p};
    hipError_t e = hipLaunchCooperativeKernel((const void*)mega, dim3(grid_blocks), dim3(NT), args, LDS_BYTES, stream);
    if (e != hipSuccess) fprintf(stderr, "cooperative launch failed: %s (grid %d)\n", hipGetErrorString(e), grid_blocks);
#else
    hipFuncSetAttribute((const void*)k_ph2, hipFuncAttributeMaxDynamicSharedMemorySize, LDS_BYTES);
    hipFuncSetAttribute((const void*)k_ph3, hipFuncAttributeMaxDynamicSharedMemorySize, LDS_BYTES);
    hipFuncSetAttribute((const void*)k_ph4, hipFuncAttributeMaxDynamicSharedMemorySize, LDS_BYTES);
    hipLaunchKernelGGL(mega, dim3(grid_blocks), dim3(NT), LDS_BYTES, stream, p);
    hipLaunchKernelGGL(k_ph1, dim3(grid_blocks), dim3(NT), 0, stream, p);
    hipLaunchKernelGGL(k_ph2, dim3(grid_blocks), dim3(NT), LDS_BYTES, stream, p);
    hipLaunchKernelGGL(k_ph3, dim3(grid_blocks), dim3(NT), LDS_BYTES, stream, p);
    hipLaunchKernelGGL(k_ph4, dim3(grid_blocks), dim3(NT), LDS_BYTES, stream, p);
    hipLaunchKernelGGL(k_ph5, dim3(grid_blocks), dim3(NT), 0, stream, p);
#endif
}
```

```cpp
#include <hip/hip_runtime.h>
#include <hip/hip_cooperative_groups.h>
#include <cstdint>
#include <cstdio>
namespace cg = cooperative_groups;

#ifndef MODE
#define MODE 0
#endif

typedef unsigned short bf16_t;
typedef short bf16x8 __attribute__((ext_vector_type(8)));
typedef _Float16 f16x8 __attribute__((ext_vector_type(8)));
typedef float f32x4 __attribute__((ext_vector_type(4)));
typedef float f32x16 __attribute__((ext_vector_type(16)));
typedef unsigned u32x2 __attribute__((ext_vector_type(2)));
typedef unsigned u32x4 __attribute__((ext_vector_type(4)));

constexpr int D_MODEL = 1024, BATCH = 8, SEQ = 2048, NTOK = BATCH * SEQ;
constexpr int NPROJ = 3584, CHUNK = 128, NGRP = 8, NHEAD = 8;
constexpr int C_U = 0, C_V = 512, C_ZA = 1024, C_Q = 1536, C_K = 2048, C_VB = 2560, C_ZB = 3072;
constexpr float LN_EPS = 1e-5f;
constexpr float ALPHA = 1.189207115002721f;
constexpr float LOG2E = 1.4426950408889634f;
constexpr float QSCALE = 0.125f * LOG2E;
constexpr int NT = 512;
constexpr int LDS_BYTES = 131072 + 16;

__device__ __forceinline__ bf16_t f2bf(float f) { unsigned u = __float_as_uint(f); u += 0x7fffu + ((u >> 16) & 1u); return (bf16_t)(u >> 16); }
__device__ __forceinline__ float bf2f(bf16_t b) { return __uint_as_float(((unsigned)b) << 16); }
__device__ __forceinline__ float bflo(unsigned w) { return __uint_as_float(w << 16); }
__device__ __forceinline__ float bfhi(unsigned w) { return __uint_as_float(w & 0xffff0000u); }
typedef float f32x2_ __attribute__((ext_vector_type(2)));
typedef __bf16 bf16x2_ __attribute__((ext_vector_type(2)));
typedef _Float16 f16x2_ __attribute__((ext_vector_type(2)));
__device__ __forceinline__ unsigned cvt_pk_bf16(float lo, float hi) { f32x2_ v = {lo, hi}; return __builtin_bit_cast(unsigned, __builtin_convertvector(v, bf16x2_)); }
__device__ __forceinline__ unsigned cvt_pk_f16(float lo, float hi) { f32x2_ v = {lo, hi}; return __builtin_bit_cast(unsigned, __builtin_convertvector(v, f16x2_)); }
__device__ __forceinline__ float sigmoidf_(float v) { return __builtin_amdgcn_rcpf(1.0f + __builtin_amdgcn_exp2f(-v * LOG2E)); }
__device__ __forceinline__ float siluf_(float v) { return v * sigmoidf_(v); }
__device__ __forceinline__ float geluf_(float v) { return v * sigmoidf_(1.5957691216057308f * (v + 0.044715f * v * v * v)); }

constexpr size_t OFF_MOD = 0;
constexpr size_t OFF_HB = 1 << 20;
constexpr size_t OFF_WIN = OFF_HB + (size_t)NTOK * D_MODEL * 2;
constexpr size_t OFF_WOUT = OFF_WIN + (size_t)NPROJ * D_MODEL * 2;
constexpr size_t OFF_WSP = OFF_WOUT + (size_t)D_MODEL * D_MODEL * 2;
constexpr size_t OFF_PROJ = OFF_WSP + (size_t)NGRP * CHUNK * CHUNK * 2;
constexpr size_t OFF_Y = OFF_PROJ + (size_t)NTOK * NPROJ * 2;

struct Params {
    const float* x; const float* c; const float* w_ada; const float* b_ada; const float* w_in; const float* sgu_g; const float* sgu_b;
    const float* w_sp; const float* b_sp; const float* w_out; const float* ln_g; const float* ln_b;
    float* out; unsigned char* ws; int phase; int pad;
};


#define XB_TMO      128
#define XB_XCNT(j)  (256  + 64 * (j))
#define XB_XSUB(j)  (1280 + 64 * (j))
#define XB_XGEN(j)  (2304 + 64 * (j))
#define XB_TOP      3328
#define XB_TOPGEN   3392
#define XCD_BAR_WORDS 3456
#define XB_SPIN_CAP (1u << 18)
#define LAS __attribute__((address_space(3)))
__device__ __forceinline__ unsigned xb_ld(unsigned* p)              { return __hip_atomic_load(p, __ATOMIC_RELAXED, __HIP_MEMORY_SCOPE_AGENT); }
__device__ __forceinline__ unsigned xb_add(unsigned* p, unsigned v) { return __hip_atomic_fetch_add(p, v, __ATOMIC_RELAXED, __HIP_MEMORY_SCOPE_AGENT); }
__device__ __forceinline__ unsigned xb_xcc_id() { return (unsigned)__builtin_amdgcn_s_getreg((3 << 11) | 20) & 0xFu; }
#define XB_SPIN(cond, bar) do { unsigned _sp = 0; while (cond) { __builtin_amdgcn_s_sleep(1); \
    if ((++_sp & 255u) == 0u) { if (xb_ld(&(bar)[XB_TMO])) break; if (_sp > XB_SPIN_CAP) { atomicAdd(&(bar)[XB_TMO], 1u); break; } } } } while (0)
struct XcdBarrier { unsigned* bar; unsigned x; volatile LAS unsigned* st; };
__device__ __forceinline__ XcdBarrier xcd_barrier_post(unsigned* bar, volatile LAS unsigned* st) {
    XcdBarrier b; b.bar = bar; b.x = xb_xcc_id(); b.st = st;
    if (threadIdx.x == 0) (void)xb_add(&bar[XB_XCNT(b.x)], 1u);
    return b;
}
__device__ __forceinline__ void xcd_barrier_complete(unsigned* bar, unsigned x, unsigned& nloc, unsigned& nx) {
    const unsigned G = gridDim.x * gridDim.y * gridDim.z;
    unsigned sum, cnt, mine, sp = 0u;
    for (;;) {
        sum = 0u; cnt = 0u; mine = 0u;
#pragma unroll
        for (unsigned j = 0; j < 16; ++j) { const unsigned c = xb_ld(&bar[XB_XCNT(j)]); sum += c; cnt += (c > 0u) ? 1u : 0u; mine = (j == x) ? c : mine; }
        if (sum == G) break;
        __builtin_amdgcn_s_sleep(1);
        if ((++sp & 255u) == 0u) { if (xb_ld(&bar[XB_TMO])) break; if (sp > XB_SPIN_CAP) { atomicAdd(&bar[XB_TMO], 1u); break; } }
    }
    nloc = mine > 0u ? mine : 1u; nx = cnt > 0u ? cnt : 1u;
}
__device__ __forceinline__ void xcd_barrier(const XcdBarrier& b) {
    asm volatile("s_waitcnt vmcnt(0)" ::: "memory");
    __syncthreads();
    if (threadIdx.x == 0) {
        unsigned* bar = b.bar;
        __builtin_amdgcn_s_waitcnt(0);
        unsigned nloc = b.st[0], nx = b.st[1];
        if (nloc == 0u) { xcd_barrier_complete(bar, b.x, nloc, nx); b.st[0] = nloc; b.st[1] = nx; }
        const unsigned old = xb_add(&bar[XB_XSUB(b.x)], 1u);
        const unsigned gen = old / nloc;
        if (old + 1u == (gen + 1u) * nloc) {
            __builtin_amdgcn_fence(__ATOMIC_RELEASE, "agent");
            asm volatile("s_waitcnt vmcnt(0)" ::: "memory");
            const unsigned og = xb_add(&bar[XB_TOP], 1u);
            const unsigned tg = og / nx;
            if (og + 1u == (tg + 1u) * nx) xb_add(&bar[XB_TOPGEN], 1u);
            else XB_SPIN(xb_ld(&bar[XB_TOPGEN]) == tg, bar);
            __builtin_amdgcn_fence(__ATOMIC_ACQUIRE, "agent");
            xb_add(&bar[XB_XGEN(b.x)], 1u);
            asm volatile("s_waitcnt vmcnt(0)" ::: "memory");
        } else {
            XB_SPIN(xb_ld(&bar[XB_XGEN(b.x)]) == gen, bar);
            __builtin_amdgcn_fence(__ATOMIC_ACQUIRE, "agent");
            asm volatile("s_waitcnt vmcnt(0)" ::: "memory");
        }
    }
    __syncthreads();
}
constexpr size_t OFF_BAR = 128 * 1024;

__device__ void p0_prologue(const Params& p, unsigned char* lds) {
    int tid = threadIdx.x; asm volatile("" : "+v"(tid)); const int lane = tid & 63, wave = tid >> 6;
    float* mod = (float*)(p.ws + OFF_MOD);
    float* sc = (float*)lds;
    float* red = (float*)(lds + 32768);
    for (int it = blockIdx.x; it < 96; it += gridDim.x) {
        for (int i = tid; i < 8 * 1024; i += NT) sc[i] = siluf_(p.c[i]);
        __syncthreads();
        const int q = tid & 7, r = tid >> 3; const int c0 = it * 32 + q * 4;
        float acc[8][4];
#pragma unroll
        for (int b = 0; b < 8; ++b) { acc[b][0] = 0.f; acc[b][1] = 0.f; acc[b][2] = 0.f; acc[b][3] = 0.f; }
        f32x4 wv[16];
#pragma unroll
        for (int i = 0; i < 16; ++i) wv[i] = __builtin_nontemporal_load((const f32x4*)(p.w_ada + (size_t)(r + 64 * i) * 3072 + c0));
#pragma unroll
        for (int i = 0; i < 16; ++i) { const int k = r + 64 * i; const f32x4 w = wv[i];
#pragma unroll
            for (int b = 0; b < 8; ++b) { const float s = sc[b * 1024 + k]; acc[b][0] += s * w[0]; acc[b][1] += s * w[1]; acc[b][2] += s * w[2]; acc[b][3] += s * w[3]; } }
#pragma unroll
        for (int b = 0; b < 8; ++b)
#pragma unroll
            for (int j = 0; j < 4; ++j) { float v = acc[b][j]; v += __shfl_xor(v, 8); v += __shfl_xor(v, 16); v += __shfl_xor(v, 32); acc[b][j] = v; }
        if (lane < 8) {
#pragma unroll
            for (int b = 0; b < 8; ++b)
#pragma unroll
                for (int j = 0; j < 4; ++j) red[(wave * 8 + q) * 32 + b * 4 + j] = acc[b][j];
        }
        __syncthreads();
        if (tid < 256) { const int b = tid >> 5, col = tid & 31, qq = col >> 2, j = col & 3; float s = 0.f;
#pragma unroll
            for (int w = 0; w < 8; ++w) s += red[(w * 8 + qq) * 32 + b * 4 + j];
            mod[b * 3072 + it * 32 + col] = s + p.b_ada[it * 32 + col]; }
        __syncthreads();
    }
    float* tb = (float*)(lds + 49152);
    {   const int n4 = tid & 15, kk = tid >> 4;
        f32x4 v0, v1; int tile = blockIdx.x;
        auto tile_src = [&](int tl, const float*& W, bf16_t*& Wt, int& N, int& k0, int& n0) {
            if (tl < 896) { W = p.w_in; Wt = (bf16_t*)(p.ws + OFF_WIN); N = NPROJ; k0 = (tl / 56) * 64; n0 = (tl % 56) * 64; }
            else { const int t2 = tl - 896; W = p.w_out; Wt = (bf16_t*)(p.ws + OFF_WOUT); N = D_MODEL; k0 = (t2 / 16) * 64; n0 = (t2 % 16) * 64; } };
        if (tile < 896 + 256) { const float* W; bf16_t* Wt; int N, k0, n0; tile_src(tile, W, Wt, N, k0, n0);
            v0 = __builtin_nontemporal_load((const f32x4*)(W + (size_t)(k0 + kk) * N + n0 + n4 * 4)); v1 = __builtin_nontemporal_load((const f32x4*)(W + (size_t)(k0 + kk + 32) * N + n0 + n4 * 4)); }
        for (; tile < 896 + 256; tile += gridDim.x) {
            const float* W; bf16_t* Wt; int N, k0, n0; tile_src(tile, W, Wt, N, k0, n0);
            tb[kk * 65 + n4 * 4 + 0] = v0[0]; tb[kk * 65 + n4 * 4 + 1] = v0[1]; tb[kk * 65 + n4 * 4 + 2] = v0[2]; tb[kk * 65 + n4 * 4 + 3] = v0[3];
            tb[(kk + 32) * 65 + n4 * 4 + 0] = v1[0]; tb[(kk + 32) * 65 + n4 * 4 + 1] = v1[1]; tb[(kk + 32) * 65 + n4 * 4 + 2] = v1[2]; tb[(kk + 32) * 65 + n4 * 4 + 3] = v1[3];
            __syncthreads();
            const int nt2 = tile + gridDim.x;
            if (nt2 < 896 + 256) { const float* W2; bf16_t* Wt2; int N2, k02, n02; tile_src(nt2, W2, Wt2, N2, k02, n02);
                v0 = __builtin_nontemporal_load((const f32x4*)(W2 + (size_t)(k02 + kk) * N2 + n02 + n4 * 4)); v1 = __builtin_nontemporal_load((const f32x4*)(W2 + (size_t)(k02 + kk + 32) * N2 + n02 + n4 * 4)); }
            { const int n = tid >> 3, ks = tid & 7; u32x4 o;
              o[0] = cvt_pk_bf16(tb[(ks * 8 + 0) * 65 + n], tb[(ks * 8 + 1) * 65 + n]); o[1] = cvt_pk_bf16(tb[(ks * 8 + 2) * 65 + n], tb[(ks * 8 + 3) * 65 + n]);
              o[2] = cvt_pk_bf16(tb[(ks * 8 + 4) * 65 + n], tb[(ks * 8 + 5) * 65 + n]); o[3] = cvt_pk_bf16(tb[(ks * 8 + 6) * 65 + n], tb[(ks * 8 + 7) * 65 + n]);
              *(u32x4*)(Wt + (size_t)(n0 + n) * D_MODEL + k0 + ks * 8) = o; }
            __syncthreads();
        }
    }
    bf16_t* wsp = (bf16_t*)(p.ws + OFF_WSP);
    for (int i = blockIdx.x * NT + tid; i < NGRP * CHUNK * CHUNK / 8; i += gridDim.x * NT) {
        const int e = i * 8, t = (e >> 7) & 127, s0 = e & 127;
        const f32x4 a = *(const f32x4*)(p.w_sp + e), b = *(const f32x4*)(p.w_sp + e + 4);
        float v[8] = {a[0], a[1], a[2], a[3], b[0], b[1], b[2], b[3]};
#pragma unroll
        for (int j = 0; j < 8; ++j) v[j] = (s0 + j <= t) ? v[j] : 0.f;
        u32x4 o; o[0] = cvt_pk_bf16(v[0], v[1]); o[1] = cvt_pk_bf16(v[2], v[3]); o[2] = cvt_pk_bf16(v[4], v[5]); o[3] = cvt_pk_bf16(v[6], v[7]);
        *(u32x4*)(wsp + e) = o;
    }
}

__device__ void p_hconv(const Params& p) {
    const float* mod = (const float*)(p.ws + OFF_MOD); bf16_t* hb = (bf16_t*)(p.ws + OFF_HB);
    int tid = threadIdx.x; asm volatile("" : "+v"(tid));
    const size_t stride = (size_t)gridDim.x * NT, total = (size_t)NTOK * D_MODEL / 8;
    for (size_t i0 = (size_t)blockIdx.x * NT + tid; i0 < total; i0 += 4 * stride) {
        f32x4 x0[4], x1[4];
#pragma unroll
        for (int u = 0; u < 4; ++u) { const size_t i = i0 + u * stride; if (i < total) { x0[u] = __builtin_nontemporal_load((const f32x4*)(p.x + i * 8)); x1[u] = __builtin_nontemporal_load((const f32x4*)(p.x + i * 8 + 4)); } }
#pragma unroll
        for (int u = 0; u < 4; ++u) { const size_t i = i0 + u * stride; if (i < total) {
            const size_t e = i * 8; const int col = (int)(e & 1023); const int b = (int)(e >> 21);
            const f32x4 sh0 = *(const f32x4*)(mod + b * 3072 + col), sh1 = *(const f32x4*)(mod + b * 3072 + col + 4);
            const f32x4 sc0 = *(const f32x4*)(mod + b * 3072 + 1024 + col), sc1 = *(const f32x4*)(mod + b * 3072 + 1024 + col + 4);
            const f32x4 h0 = x0[u] * (1.0f + sc0) + sh0, h1 = x1[u] * (1.0f + sc1) + sh1;
            u32x4 o; o[0] = cvt_pk_bf16(h0[0], h0[1]); o[1] = cvt_pk_bf16(h0[2], h0[3]); o[2] = cvt_pk_bf16(h1[0], h1[1]); o[3] = cvt_pk_bf16(h1[2], h1[3]);
            *(u32x4*)(hb + e) = o; } }
    }
}

constexpr int BM = 256, BK = 64, HALF = 128, NXCD = 8, WGM = 8, HT = HALF * BK;
__device__ __forceinline__ int lds_byte(int r, int c) { int st = (r >> 4) * 2 + (c >> 5), rr = r & 15, cc = c & 31, ob = rr * 64 + cc * 2; return st * 1024 + (ob ^ (((ob >> 9) & 1) << 5)); }
__device__ __forceinline__ void stage_rc(int b, int& R, int& C) { int st = b / 1024, sb = b % 1024, swz = sb ^ (((sb >> 9) & 1) << 5); R = (st >> 1) * 16 + swz / 64; C = (st & 1) * 32 + (swz % 64) / 2; }

struct TileOrder {
    int nM, nN, nwg, G, c;
    __device__ void init(int M, int N, int G_, int c_) { nM = M / BM; nN = N / BM; nwg = nM * nN; G = G_; c = c_; }
    __device__ bool next(int i, int& pm, int& pn) const { const long L = (long)i * G + c; if (L >= nwg) return false; map((int)L, pm, pn); return true; }
    __device__ void map(int L, int& pm, int& pn) const {
        int wgid = L; { const int q = nwg / NXCD, r = nwg % NXCD, xcd = wgid % NXCD, off = wgid / NXCD; wgid = (xcd < r ? xcd * (q + 1) : r * (q + 1) + (xcd - r) * q) + off; }
        const int nig = WGM * nN, gid = wgid / nig, fm = gid * WGM, gsz = (nM - fm) < WGM ? (nM - fm) : WGM;
        pm = fm + ((wgid % nig) % gsz); pn = (wgid % nig) / gsz;
    }
};

__device__ __forceinline__ void gemm_tile(const bf16_t* __restrict__ A, const bf16_t* __restrict__ Bt, const int K, const int brow, const int bcol, bf16_t* shm, f32x4 (&acc)[2][2][4][2], const bool half = false) {
#define SA(b, h) (shm + ((b) * 2 + (h)) * HT)
#define SB(b, h) (shm + (4 + (b) * 2 + (h)) * HT)
#define STAGE(P, BASE, br, kt) do { const char* _gb = (const char*)(BASE) + ((size_t)(br) * K + (size_t)(kt) * BK) * 2; \
    for (int _i = 0; _i < 2; ++_i) { int _b = gtx * 16 + _i * 8192; \
      __builtin_amdgcn_global_load_lds((const unsigned*)(_gb + soff[_i]), (__attribute__((address_space(3))) unsigned*)((char*)(P) + _b), 16, 0, 0); } } while (0)
#define LDA(dst, b, h) for (int m = 0; m < 4; ++m) for (int k = 0; k < 2; ++k) \
    dst[m][k] = *reinterpret_cast<const bf16x8*>((char*)SA(b, h) + lds_byte(wr * 64 + m * 16 + fr, k * 32 + fq * 8))
#define LDB(dst, b, h) for (int n = 0; n < 2; ++n) for (int k = 0; k < 2; ++k) \
    dst[n][k] = *reinterpret_cast<const bf16x8*>((char*)SB(b, h) + lds_byte(wc * 32 + n * 16 + fr, k * 32 + fq * 8))
#define MMA(ai, bj, At_, Bt_) do { __builtin_amdgcn_s_setprio(1); \
    for (int m = 0; m < 4; ++m) for (int n = 0; n < 2; ++n) for (int k = 0; k < 2; ++k) \
      acc[ai][bj][m][n] = __builtin_amdgcn_mfma_f32_16x16x32_bf16(Bt_[n][k], At_[m][k], acc[ai][bj][m][n], 0, 0, 0); \
    __builtin_amdgcn_s_setprio(0); } while (0)
#define WAIT_V(n) asm volatile("s_waitcnt vmcnt(" #n ")" ::: "memory")
#define WAIT_L(n) asm volatile("s_waitcnt lgkmcnt(" #n ")" ::: "memory")
#define BAR __builtin_amdgcn_s_barrier()
#define SCHED __builtin_amdgcn_sched_barrier(0)
    int gtx = threadIdx.x; asm volatile("" : "+v"(gtx));
    const int wid = gtx >> 6, lane = gtx & 63, wr = __builtin_amdgcn_readfirstlane(wid >> 2), wc = wid & 3, fr = lane & 15, fq = lane >> 4;
#pragma unroll
    for (int a = 0; a < 2; ++a)
#pragma unroll
        for (int b = 0; b < 2; ++b)
#pragma unroll
            for (int m = 0; m < 4; ++m)
#pragma unroll
                for (int n = 0; n < 2; ++n) acc[a][b][m][n] = (f32x4){0.f, 0.f, 0.f, 0.f};
    bf16x8 At[4][2], B0[2][2], B1[2][2];
    unsigned soff[2];
    for (int _i = 0; _i < 2; ++_i) { int _r, _c; stage_rc(gtx * 16 + _i * 8192, _r, _c); soff[_i] = (unsigned)(_r * K + _c) * 2u; }
    const int nt = K / BK;
    STAGE(SB(0, 0), Bt, bcol, 0); STAGE(SA(0, 0), A, brow, 0);
    STAGE(SB(0, 1), Bt, bcol + HALF, 0); STAGE(SA(0, 1), A, brow + HALF, 0);
    if (wr == 1) BAR;
    WAIT_V(4); BAR;
    STAGE(SB(1, 0), Bt, bcol, 1); STAGE(SA(1, 0), A, brow, 1); STAGE(SB(1, 1), Bt, bcol + HALF, 1);
    WAIT_V(6); BAR;
    for (int t = 0; t < nt - 2; t += 2) {
        LDB(B0, 0, 0); SCHED; LDA(At, 0, 0); STAGE(SA(1, 1), A, brow + HALF, t + 1);
        WAIT_L(8); BAR; WAIT_L(0); MMA(0, 0, At, B0); BAR; SCHED;
        LDB(B1, 0, 1); STAGE(SB(0, 0), Bt, bcol, t + 2);
        BAR; WAIT_L(0); MMA(0, 1, At, B1); BAR;
        if (!half) { LDA(At, 0, 1); } STAGE(SA(0, 0), A, brow, t + 2);
        BAR; WAIT_L(0); if (!half) { MMA(1, 0, At, B0); } BAR; SCHED;
        STAGE(SB(0, 1), Bt, bcol + HALF, t + 2);
        WAIT_V(6); BAR; if (!half) { MMA(1, 1, At, B1); } BAR;
        LDB(B0, 1, 0); SCHED; LDA(At, 1, 0); STAGE(SA(0, 1), A, brow + HALF, t + 2);
        WAIT_L(8); BAR; WAIT_L(0); MMA(0, 0, At, B0); BAR; SCHED;
        LDB(B1, 1, 1); STAGE(SB(1, 0), Bt, bcol, t + 3);
        BAR; WAIT_L(0); MMA(0, 1, At, B1); BAR;
        if (!half) { LDA(At, 1, 1); } STAGE(SA(1, 0), A, brow, t + 3);
        BAR; WAIT_L(0); if (!half) { MMA(1, 0, At, B0); } BAR; SCHED;
        STAGE(SB(1, 1), Bt, bcol + HALF, t + 3);
        WAIT_V(6); BAR; if (!half) { MMA(1, 1, At, B1); } BAR;
    }
    { LDB(B0, 0, 0); LDA(At, 0, 0); STAGE(SA(1, 1), A, brow + HALF, nt - 1);
      BAR; WAIT_L(0); MMA(0, 0, At, B0); BAR;
      LDB(B1, 0, 1); BAR; WAIT_L(0); MMA(0, 1, At, B1); BAR;
      if (!half) { LDA(At, 0, 1); } WAIT_V(4); BAR; WAIT_L(0); if (!half) { MMA(1, 0, At, B0); MMA(1, 1, At, B1); } BAR; }
    { LDB(B0, 1, 0); LDA(At, 1, 0); WAIT_V(2); BAR; WAIT_L(0); MMA(0, 0, At, B0); BAR;
      LDB(B1, 1, 1); WAIT_V(0); BAR; WAIT_L(0); MMA(0, 1, At, B1); BAR;
      if (!half) { LDA(At, 1, 1); } BAR; WAIT_L(0); if (!half) { MMA(1, 0, At, B0); MMA(1, 1, At, B1); } BAR; }
    if (wr == 0) BAR;
#undef SA
#undef SB
#undef STAGE
#undef LDA
#undef LDB
#undef MMA
}

__device__ void p_inproj(const Params& p, unsigned char* lds) {
    const bf16_t* hb = (const bf16_t*)(p.ws + OFF_HB); const bf16_t* winT = (const bf16_t*)(p.ws + OFF_WIN); bf16_t* proj = (bf16_t*)(p.ws + OFF_PROJ);
    TileOrder ord; ord.init(NTOK, NPROJ, gridDim.x, blockIdx.x);
    const int G = gridDim.x, rem = ord.nwg % G, nsplit = (rem > 0 && 2 * rem <= G) ? rem : 0, nfull = ord.nwg - nsplit, nunits = nfull + 2 * nsplit;
    for (int i = 0;; ++i) {
        const int u = i * G + (int)blockIdx.x; if (u >= nunits) break;
        int pm, pn; const bool half = (u >= nfull); const int hsel = half ? ((u - nfull) & 1) : 0;
        ord.map(half ? nfull + ((u - nfull) >> 1) : u, pm, pn);
        f32x4 acc[2][2][4][2];
        gemm_tile(hb, winT, D_MODEL, pm * BM + hsel * HALF, pn * BM, (bf16_t*)lds, acc, half);
        int tx = threadIdx.x; asm volatile("" : "+v"(tx));
        const int wid = tx >> 6, lane = tx & 63, wr = wid >> 2, wc = wid & 3, fr = lane & 15, fq = lane >> 4;
        const int seg = pn >> 1;
#pragma unroll
        for (int ai = 0; ai < 2; ++ai) {
            if (half && ai == 1) break;
#pragma unroll
            for (int m = 0; m < 4; ++m) {
                const int row = pm * BM + hsel * HALF + ai * HALF + wr * 64 + m * 16 + fr;
                bf16_t* rowp = proj + (size_t)row * NPROJ + pn * BM + wc * 32 + fq * 4;
#pragma unroll
                for (int bj = 0; bj < 2; ++bj)
#pragma unroll
                    for (int n = 0; n < 2; ++n) {
                        f32x4 v = acc[ai][bj][m][n];
                        if (seg <= 1) { v[0] = geluf_(v[0]); v[1] = geluf_(v[1]); v[2] = geluf_(v[2]); v[3] = geluf_(v[3]); }
                        else if (seg == 2 || seg == 6) { v[0] = siluf_(v[0]); v[1] = siluf_(v[1]); v[2] = siluf_(v[2]); v[3] = siluf_(v[3]); }
                        else if (seg == 3) { v = v * QSCALE; }
                        u32x2 o; o[0] = cvt_pk_bf16(v[0], v[1]); o[1] = cvt_pk_bf16(v[2], v[3]);
                        *(u32x2*)(rowp + bj * HALF + n * 16) = o;
                    }
            }
        }
        asm volatile("s_waitcnt vmcnt(0)" ::: "memory");
    }
}

constexpr size_t OFF_STATS = 256 * 1024;
__device__ void p_outproj(const Params& p, unsigned char* lds, const XcdBarrier& bar, const bool fused) {
    const bf16_t* yb = (const bf16_t*)(p.ws + OFF_Y); const bf16_t* woutT = (const bf16_t*)(p.ws + OFF_WOUT); const float* mod = (const float*)(p.ws + OFF_MOD);
    TileOrder ord; ord.init(NTOK, D_MODEL, gridDim.x, blockIdx.x);
    for (int i = 0;; ++i) {
        int pm, pn; if (!ord.next(i, pm, pn)) break;
        f32x4 acc[2][2][4][2];
        gemm_tile(yb, woutT, D_MODEL, pm * BM, pn * BM, (bf16_t*)lds, acc);
        int tx = threadIdx.x; asm volatile("" : "+v"(tx));
        const int wid = tx >> 6, lane = tx & 63, wr = wid >> 2, wc = wid & 3, fr = lane & 15, fq = lane >> 4;
        const int b = (pm * BM) / SEQ; const int col0 = pn * BM + wc * 32 + fq * 4;
        {   f32x4 gate[2][2];
#pragma unroll
            for (int bj = 0; bj < 2; ++bj)
#pragma unroll
                for (int n = 0; n < 2; ++n) gate[bj][n] = *(const f32x4*)(mod + b * 3072 + 2048 + col0 + bj * HALF + n * 16);
#pragma unroll
            for (int ai = 0; ai < 2; ++ai) {
                f32x4 xv[4][2][2];
#pragma unroll
                for (int m = 0; m < 4; ++m) { const size_t off = (size_t)(pm * BM + ai * HALF + wr * 64 + m * 16 + fr) * D_MODEL + col0;
#pragma unroll
                    for (int bj = 0; bj < 2; ++bj)
#pragma unroll
                        for (int n = 0; n < 2; ++n) xv[m][bj][n] = __builtin_nontemporal_load((const f32x4*)(p.x + off + bj * HALF + n * 16)); }
#pragma unroll
                for (int m = 0; m < 4; ++m)
#pragma unroll
                    for (int bj = 0; bj < 2; ++bj)
#pragma unroll
                        for (int n = 0; n < 2; ++n) acc[ai][bj][m][n] = xv[m][bj][n] * ALPHA + gate[bj][n] * acc[ai][bj][m][n];
            } }
        if (!fused) {
#pragma unroll
            for (int ai = 0; ai < 2; ++ai)
#pragma unroll
                for (int m = 0; m < 4; ++m) { const size_t off = (size_t)(pm * BM + ai * HALF + wr * 64 + m * 16 + fr) * D_MODEL + col0;
#pragma unroll
                    for (int bj = 0; bj < 2; ++bj)
#pragma unroll
                        for (int n = 0; n < 2; ++n) *(f32x4*)(p.out + off + bj * HALF + n * 16) = acc[ai][bj][m][n]; }
            asm volatile("s_waitcnt vmcnt(0)" ::: "memory");
            continue;
        }
        float* P = (float*)lds;
        float* S = (float*)(lds + 8192);
        float* gstats = (float*)(p.ws + OFF_STATS);
#pragma unroll
        for (int ai = 0; ai < 2; ++ai)
#pragma unroll
            for (int m = 0; m < 4; ++m) { float s1 = 0.f, s2 = 0.f;
#pragma unroll
                for (int bj = 0; bj < 2; ++bj)
#pragma unroll
                    for (int n = 0; n < 2; ++n) { const f32x4 v = acc[ai][bj][m][n]; s1 += (v[0] + v[1]) + (v[2] + v[3]); s2 += (v[0] * v[0] + v[1] * v[1]) + (v[2] * v[2] + v[3] * v[3]); }
                s1 += __shfl_xor(s1, 16); s2 += __shfl_xor(s2, 16); s1 += __shfl_xor(s1, 32); s2 += __shfl_xor(s2, 32);
                if (fq == 0) { const int rl = ai * HALF + wr * 64 + m * 16 + fr; P[(rl * 4 + wc) * 2] = s1; P[(rl * 4 + wc) * 2 + 1] = s2; } }
        __syncthreads();
        if (tx < 256) { const f32x4 a = *(const f32x4*)(P + tx * 8), c2 = *(const f32x4*)(P + tx * 8 + 4);
            float* gp = gstats + ((size_t)(pm * BM + tx) * 4 + pn) * 2; gp[0] = (a[0] + a[2]) + (c2[0] + c2[2]); gp[1] = (a[1] + a[3]) + (c2[1] + c2[3]); }
        xcd_barrier(bar);
        if (tx < 256) { const float* gp = gstats + (size_t)(pm * BM + tx) * 8; const f32x4 a = *(const f32x4*)gp, c2 = *(const f32x4*)(gp + 4);
            const float mean = ((a[0] + a[2]) + (c2[0] + c2[2])) * (1.0f / 1024.f); const float ex2 = ((a[1] + a[3]) + (c2[1] + c2[3])) * (1.0f / 1024.f);
            const float var = fmaxf(ex2 - mean * mean, 0.f); S[tx * 2] = mean; S[tx * 2 + 1] = 1.0f / sqrtf(var + LN_EPS); }
        __syncthreads();
        {   f32x4 gg[2][2], bb[2][2];
#pragma unroll
            for (int bj = 0; bj < 2; ++bj)
#pragma unroll
                for (int n = 0; n < 2; ++n) { gg[bj][n] = *(const f32x4*)(p.ln_g + col0 + bj * HALF + n * 16); bb[bj][n] = *(const f32x4*)(p.ln_b + col0 + bj * HALF + n * 16); }
#pragma unroll
            for (int ai = 0; ai < 2; ++ai)
#pragma unroll
                for (int m = 0; m < 4; ++m) { const int rl = ai * HALF + wr * 64 + m * 16 + fr; const float mean = S[rl * 2], rstd = S[rl * 2 + 1];
                    const size_t off = (size_t)(pm * BM + rl) * D_MODEL + col0;
#pragma unroll
                    for (int bj = 0; bj < 2; ++bj)
#pragma unroll
                        for (int n = 0; n < 2; ++n) __builtin_nontemporal_store((acc[ai][bj][m][n] - mean) * rstd * gg[bj][n] + bb[bj][n], (f32x4*)(p.out + off + bj * HALF + n * 16)); } }
    }
}

constexpr int KROW = 72;
__device__ __forceinline__ float relu_(float x) { int i = __builtin_bit_cast(int, x); i = i > 0 ? i : 0; return __builtin_bit_cast(float, i); }
__device__ __forceinline__ void softplus_pack(const f32x16& z, f16x8 (&lf)[2]) {
    unsigned w[8];
#pragma unroll
    for (int i = 0; i < 8; ++i) {
        const float z0 = z[2 * i], z1 = z[2 * i + 1];
        const float l0 = __builtin_amdgcn_logf(1.0f + __builtin_amdgcn_exp2f(-__builtin_fabsf(z0))), l1 = __builtin_amdgcn_logf(1.0f + __builtin_amdgcn_exp2f(-__builtin_fabsf(z1)));
        w[i] = cvt_pk_f16(relu_(z0) + l0, relu_(z1) + l1);
    }
    u32x4 t0 = {w[0], w[1], w[2], w[3]}, t1 = {w[4], w[5], w[6], w[7]};
    lf[0] = __builtin_bit_cast(f16x8, t0); lf[1] = __builtin_bit_cast(f16x8, t1);
}
__device__ __forceinline__ void expo_pack(const f32x16& z, const f32x16& cum, bf16x8 (&pf)[2]) {
    unsigned w[8];
#pragma unroll
    for (int i = 0; i < 8; ++i) w[i] = cvt_pk_bf16(__builtin_amdgcn_exp2f(z[2 * i] + cum[2 * i]), __builtin_amdgcn_exp2f(z[2 * i + 1] + cum[2 * i + 1]));
    u32x4 t0 = {w[0], w[1], w[2], w[3]}, t1 = {w[4], w[5], w[6], w[7]};
    pf[0] = __builtin_bit_cast(bf16x8, t0); pf[1] = __builtin_bit_cast(bf16x8, t1);
}
__device__ __forceinline__ void exp_pack(const f32x16& e, bf16x8 (&pf)[2]) {
    unsigned w[8];
#pragma unroll
    for (int i = 0; i < 8; ++i) w[i] = cvt_pk_bf16(__builtin_amdgcn_exp2f(e[2 * i]), __builtin_amdgcn_exp2f(e[2 * i + 1]));
    u32x4 t0 = {w[0], w[1], w[2], w[3]}, t1 = {w[4], w[5], w[6], w[7]};
    pf[0] = __builtin_bit_cast(bf16x8, t0); pf[1] = __builtin_bit_cast(bf16x8, t1);
}
__device__ __forceinline__ f32x16 bcast16(float v) { f32x16 r;
#pragma unroll
    for (int i = 0; i < 16; ++i) r[i] = v;
    return r; }

__device__ __forceinline__ void tile_transpose(float* reg, const f32x16& acc, const float add, const int c, const int hh, const int lane, f32x4 (&out)[4]) {
    asm volatile("" ::: "memory");
#pragma unroll
    for (int g4 = 0; g4 < 4; ++g4) { f32x4 v = {acc[4 * g4 + 0] + add, acc[4 * g4 + 1] + add, acc[4 * g4 + 2] + add, acc[4 * g4 + 3] + add}; *(f32x4*)(reg + c * 36 + 8 * g4 + 4 * hh) = v; }
    asm volatile("" ::: "memory");
    const int t = lane >> 1, half = lane & 1;
#pragma unroll
    for (int j = 0; j < 4; ++j) out[j] = *(const f32x4*)(reg + t * 36 + half * 16 + 4 * j);
    asm volatile("" ::: "memory");
}

__device__ __forceinline__ void attn_unit(const Params& p, unsigned char* lds, const int b, const int h, const int qb) {
    const bf16_t* proj = (const bf16_t*)(p.ws + OFF_PROJ); bf16_t* yb = (bf16_t*)(p.ws + OFF_Y);
    int tid = threadIdx.x; asm volatile("" : "+v"(tid)); const int lane = tid & 63, wave = __builtin_amdgcn_readfirstlane(tid >> 6), c = lane & 31, hh = lane >> 5;
    bf16_t* Ks = (bf16_t*)lds;
    bf16_t* Vt = (bf16_t*)(lds + 2 * 64 * KROW * 2);
    const size_t tokbase = (size_t)b * SEQ; const int q0 = qb * 256, tq0 = q0 + wave * 32;
    bf16x8 qf[4];
    { const bf16_t* qp = proj + (tokbase + tq0 + c) * NPROJ + C_Q + h * 64 + hh * 8;
#pragma unroll
      for (int ks = 0; ks < 4; ++ks) qf[ks] = *(const bf16x8*)(qp + ks * 16);
#pragma unroll
      for (int ks = 0; ks < 4; ++ks) asm volatile("" : "+v"(qf[ks])); }
    f16x8 uf[2], nones;
#pragma unroll
    for (int ks2 = 0; ks2 < 2; ++ks2)
#pragma unroll
        for (int jj = 0; jj < 8; ++jj) { const int key = 16 * ks2 + 8 * (jj >> 2) + 4 * hh + (jj & 3); uf[ks2][jj] = (key >= c) ? (_Float16)-1.0f : (_Float16)0.0f; }
#pragma unroll
    for (int jj = 0; jj < 8; ++jj) nones[jj] = (_Float16)-1.0f;
    f32x16 o0 = bcast16(0.f), o1 = bcast16(0.f);
    float R = 0.f;
    const int ntile = (q0 + 256) / 64;
    const int skey = tid >> 3, sch = tid & 7; const int spk = (skey & ~12) | ((skey & 4) << 1) | ((skey & 8) >> 1);
    u32x4 kreg, vreg;
    { const bf16_t* kp = proj + (tokbase + (ntile - 1) * 64 + skey) * NPROJ + h * 64 + sch * 8; kreg = *(const u32x4*)(kp + C_K); vreg = *(const u32x4*)(kp + C_VB); }
    volatile int* flags = (volatile int*)(lds + 73728);
    bool wdone = false;
    int buf = 0;
    { *(u32x4*)(Ks + (buf * 64 + skey) * KROW + sch * 8) = kreg;
      bf16_t* vp = Vt + (buf * 64 + sch * 8) * KROW + spk;
#pragma unroll
      for (int e = 0; e < 4; ++e) { vp[(2 * e) * KROW] = (bf16_t)(vreg[e] & 0xffffu); vp[(2 * e + 1) * KROW] = (bf16_t)(vreg[e] >> 16); } }
    __syncthreads();
    for (int kt = ntile - 1; kt >= 0; --kt) {
        if (kt > 0) { const bf16_t* kp = proj + (tokbase + (kt - 1) * 64 + skey) * NPROJ + h * 64 + sch * 8; kreg = *(const u32x4*)(kp + C_K); vreg = *(const u32x4*)(kp + C_VB); }
        const bf16_t* Kb = Ks + buf * 64 * KROW; const bf16_t* Vb = Vt + buf * 64 * KROW;
        if (wdone) {
        } else if (kt * 64 + 64 <= tq0) {
            f32x16 z1 = bcast16(0.f), z0 = bcast16(0.f);
#pragma unroll
            for (int ks = 0; ks < 4; ++ks) { const bf16x8 kf = *(const bf16x8*)(Kb + (32 + c) * KROW + ks * 16 + hh * 8); z1 = __builtin_amdgcn_mfma_f32_32x32x16_bf16(kf, qf[ks], z1, 0, 0, 0); }
#pragma unroll
            for (int ks = 0; ks < 4; ++ks) { const bf16x8 kf = *(const bf16x8*)(Kb + (c) * KROW + ks * 16 + hh * 8); z0 = __builtin_amdgcn_mfma_f32_32x32x16_bf16(kf, qf[ks], z0, 0, 0, 0); }
            f16x8 lf1[2], lf0[2];
            softplus_pack(z1, lf1);
            f32x16 e1 = z1 + R, e0 = z0 + R;
            e1 = __builtin_amdgcn_mfma_f32_32x32x16_f16(uf[0], lf1[0], e1, 0, 0, 0);
            e1 = __builtin_amdgcn_mfma_f32_32x32x16_f16(uf[1], lf1[1], e1, 0, 0, 0);
            e0 = __builtin_amdgcn_mfma_f32_32x32x16_f16(nones, lf1[0], e0, 0, 0, 0);
            e0 = __builtin_amdgcn_mfma_f32_32x32x16_f16(nones, lf1[1], e0, 0, 0, 0);
            softplus_pack(z0, lf0);
            e0 = __builtin_amdgcn_mfma_f32_32x32x16_f16(uf[0], lf0[0], e0, 0, 0, 0);
            e0 = __builtin_amdgcn_mfma_f32_32x32x16_f16(uf[1], lf0[1], e0, 0, 0, 0);
            bf16x8 pf1[2], pf0[2];
            exp_pack(e1, pf1);
#pragma unroll
            for (int ks2 = 0; ks2 < 2; ++ks2) {
                const bf16x8 v0 = *(const bf16x8*)(Vb + (c) * KROW + 32 + ks2 * 16 + hh * 8), v1 = *(const bf16x8*)(Vb + (32 + c) * KROW + 32 + ks2 * 16 + hh * 8);
                o0 = __builtin_amdgcn_mfma_f32_32x32x16_bf16(v0, pf1[ks2], o0, 0, 0, 0); o1 = __builtin_amdgcn_mfma_f32_32x32x16_bf16(v1, pf1[ks2], o1, 0, 0, 0);
            }
            exp_pack(e0, pf0);
            R = __shfl(e0[0] - z0[0], c);
#pragma unroll
            for (int ks2 = 0; ks2 < 2; ++ks2) {
                const bf16x8 v0 = *(const bf16x8*)(Vb + (c) * KROW + ks2 * 16 + hh * 8), v1 = *(const bf16x8*)(Vb + (32 + c) * KROW + ks2 * 16 + hh * 8);
                o0 = __builtin_amdgcn_mfma_f32_32x32x16_bf16(v0, pf0[ks2], o0, 0, 0, 0); o1 = __builtin_amdgcn_mfma_f32_32x32x16_bf16(v1, pf0[ks2], o1, 0, 0, 0);
            }
        } else {
#pragma unroll 1
            for (int sub = 1; sub >= 0; --sub) {
                const int ks0 = kt * 64 + sub * 32;
                if (ks0 <= tq0) {
                    f32x16 z = bcast16(0.f);
#pragma unroll
                    for (int ks = 0; ks < 4; ++ks) { const bf16x8 kf = *(const bf16x8*)(Kb + (sub * 32 + c) * KROW + ks * 16 + hh * 8); z = __builtin_amdgcn_mfma_f32_32x32x16_bf16(kf, qf[ks], z, 0, 0, 0); }
                    if (ks0 == tq0) {
#pragma unroll
                        for (int r = 0; r < 16; ++r) { const int s = (r & 3) + 8 * (r >> 2) + 4 * hh; z[r] = (s >= c) ? -__builtin_inff() : z[r]; }
                    }
                    f16x8 lf[2]; softplus_pack(z, lf);
                    f32x16 cum = bcast16(R);
                    cum = __builtin_amdgcn_mfma_f32_32x32x16_f16(uf[0], lf[0], cum, 0, 0, 0);
                    cum = __builtin_amdgcn_mfma_f32_32x32x16_f16(uf[1], lf[1], cum, 0, 0, 0);
                    bf16x8 pf[2]; expo_pack(z, cum, pf);
                    R = __shfl(cum[0], c);
#pragma unroll
                    for (int ks2 = 0; ks2 < 2; ++ks2) {
                        const bf16x8 v0 = *(const bf16x8*)(Vb + (c) * KROW + sub * 32 + ks2 * 16 + hh * 8), v1 = *(const bf16x8*)(Vb + (32 + c) * KROW + sub * 32 + ks2 * 16 + hh * 8);
                        o0 = __builtin_amdgcn_mfma_f32_32x32x16_bf16(v0, pf[ks2], o0, 0, 0, 0); o1 = __builtin_amdgcn_mfma_f32_32x32x16_bf16(v1, pf[ks2], o1, 0, 0, 0);
                    }
                }
            }
        }
        wdone = (__builtin_amdgcn_ballot_w64(R > -160.0f) == 0ull);
        if (lane == 0) flags[(kt & 1) * 8 + wave] = wdone ? 1 : 0;
        if (kt > 0) {
            const int nb = buf ^ 1;
            *(u32x4*)(Ks + (nb * 64 + skey) * KROW + sch * 8) = kreg;
            bf16_t* vp = Vt + (nb * 64 + sch * 8) * KROW + spk;
#pragma unroll
            for (int e = 0; e < 4; ++e) { vp[(2 * e) * KROW] = (bf16_t)(vreg[e] & 0xffffu); vp[(2 * e + 1) * KROW] = (bf16_t)(vreg[e] >> 16); }
        }
        __syncthreads();
        buf ^= 1;
        { int alld = 1;
#pragma unroll
          for (int w = 0; w < 8; ++w) alld &= flags[(kt & 1) * 8 + w];
          if (__builtin_amdgcn_readfirstlane(alld)) break; }
    }
    { float* reg = (float*)(lds + 36864 + wave * 4608);
      const int t = lane >> 1, half = lane & 1; const size_t tok = tokbase + tq0 + t;
      const bf16_t* zp = proj + tok * NPROJ + C_ZB + h * 64 + half * 16; bf16_t* yp = yb + tok * D_MODEL + 512 + h * 64 + half * 16;
      u32x4 zz[2][2];
#pragma unroll
      for (int dt = 0; dt < 2; ++dt) { zz[dt][0] = *(const u32x4*)(zp + dt * 32); zz[dt][1] = *(const u32x4*)(zp + dt * 32 + 8); }
#pragma unroll
      for (int dt = 0; dt < 2; ++dt) { f32x4 ov[4]; tile_transpose(reg, dt ? o1 : o0, 0.f, c, hh, lane, ov);
#pragma unroll
          for (int q = 0; q < 2; ++q) { const u32x4 z4 = zz[dt][q]; const f32x4 a = ov[2 * q], b2 = ov[2 * q + 1]; u32x4 o;
              o[0] = cvt_pk_bf16(bflo(z4[0]) * a[0], bfhi(z4[0]) * a[1]); o[1] = cvt_pk_bf16(bflo(z4[1]) * a[2], bfhi(z4[1]) * a[3]);
              o[2] = cvt_pk_bf16(bflo(z4[2]) * b2[0], bfhi(z4[2]) * b2[1]); o[3] = cvt_pk_bf16(bflo(z4[3]) * b2[2], bfhi(z4[3]) * b2[3]);
              *(u32x4*)(yp + dt * 32 + 8 * q) = o; } } }
}

constexpr int VROW = 136;
__device__ __forceinline__ void sgu_item(const Params& p, unsigned char* lds, const int ch, const int hf) {
    const bf16_t* proj = (const bf16_t*)(p.ws + OFF_PROJ); bf16_t* yb = (bf16_t*)(p.ws + OFF_Y); const bf16_t* wsp = (const bf16_t*)(p.ws + OFF_WSP);
    int tid = threadIdx.x; asm volatile("" : "+v"(tid)); const int lane = tid & 63, wave = __builtin_amdgcn_readfirstlane(tid >> 6), c = lane & 31, hh = lane >> 5;
    float* stats = (float*)(lds + 73728);
    bf16_t* vw = (bf16_t*)(lds + wave * 8704);
    const size_t tok0 = (size_t)ch * CHUNK;
    const int g = hf * 4 + (wave >> 1), ct = wave & 1, ch0 = g * 64 + ct * 32;
    u32x4 vv[2][4];
#pragma unroll
    for (int i = 0; i < 2; ++i) { const bf16_t* vp = proj + (tok0 + lane + 64 * i) * NPROJ + C_V + ch0;
#pragma unroll
        for (int j = 0; j < 4; ++j) vv[i][j] = *(const u32x4*)(vp + 8 * j); }
    bf16x8 wf[20];
#pragma unroll
    for (int tt = 0; tt < 4; ++tt) { const bf16_t* wrow = wsp + ((size_t)g * CHUNK + tt * 32 + c) * CHUNK + hh * 8;
#pragma unroll
        for (int ks = 0; ks < 2 * (tt + 1); ++ks) wf[tt * (tt + 1) + ks] = *(const bf16x8*)(wrow + ks * 16); }
    { const int l16 = lane & 15, tq = lane >> 4;
#pragma unroll
      for (int it4 = 0; it4 < 4; ++it4) { const int token = wave * 16 + it4 * 4 + tq; const bf16_t* vp = proj + (tok0 + token) * NPROJ + C_V + l16 * 8; float s1 = 0.f, s2 = 0.f;
          u32x4 w[4];
#pragma unroll
          for (int i = 0; i < 4; ++i) w[i] = *(const u32x4*)(vp + i * 128);
#pragma unroll
          for (int i = 0; i < 4; ++i)
#pragma unroll
              for (int e = 0; e < 4; ++e) { const float a = bflo(w[i][e]), bb = bfhi(w[i][e]); s1 += a + bb; s2 += a * a + bb * bb; }
#pragma unroll
          for (int o = 1; o < 16; o <<= 1) { s1 += __shfl_xor(s1, o); s2 += __shfl_xor(s2, o); }
          const float mean = s1 * (1.0f / 512.f); const float var = fmaxf(s2 * (1.0f / 512.f) - mean * mean, 0.f);
          if (l16 == 0) { stats[token * 2] = mean; stats[token * 2 + 1] = 1.0f / sqrtf(var + LN_EPS); } } }
    __syncthreads();
#pragma unroll
    for (int i = 0; i < 2; ++i) { const int sidx = lane + 64 * i; const float mean = stats[sidx * 2], rstd = stats[sidx * 2 + 1];
#pragma unroll
        for (int j = 0; j < 4; ++j)
#pragma unroll
            for (int e = 0; e < 4; ++e) { const int cl = 8 * j + 2 * e; const unsigned w = vv[i][j][e];
                const float a = (bflo(w) - mean) * rstd * p.sgu_g[ch0 + cl] + p.sgu_b[ch0 + cl], bb = (bfhi(w) - mean) * rstd * p.sgu_g[ch0 + cl + 1] + p.sgu_b[ch0 + cl + 1];
                vw[cl * VROW + sidx] = f2bf(a); vw[(cl + 1) * VROW + sidx] = f2bf(bb); } }
    asm volatile("" ::: "memory");
    const bf16_t* vrow = vw + c * VROW + hh * 8;
    float* reg = (float*)(lds + 74752 + wave * 4608);
#pragma unroll
    for (int tt = 0; tt < 4; ++tt) {
        const float bs = p.b_sp[g * CHUNK + tt * 32 + c];
        const int t2 = lane >> 1, half = lane & 1; const size_t tok = tok0 + tt * 32 + t2;
        const bf16_t* up = proj + tok * NPROJ + C_U + ch0 + half * 16; const bf16_t* zp = proj + tok * NPROJ + C_ZA + ch0 + half * 16; bf16_t* yp = yb + tok * D_MODEL + ch0 + half * 16;
        const u32x4 u0 = *(const u32x4*)(up), u1 = *(const u32x4*)(up + 8), z0 = *(const u32x4*)(zp), z1 = *(const u32x4*)(zp + 8);
        f32x16 acc = bcast16(0.f);
#pragma unroll
        for (int ks = 0; ks < 2 * (tt + 1); ++ks) { const bf16x8 af = *(const bf16x8*)(vrow + ks * 16); acc = __builtin_amdgcn_mfma_f32_32x32x16_bf16(af, wf[tt * (tt + 1) + ks], acc, 0, 0, 0); }
        f32x4 mv[4]; tile_transpose(reg, acc, bs, c, hh, lane, mv);
#pragma unroll
        for (int q = 0; q < 2; ++q) { const u32x4 uu = q ? u1 : u0, zz = q ? z1 : z0; const f32x4 a = mv[2 * q], b2 = mv[2 * q + 1]; u32x4 o;
            o[0] = cvt_pk_bf16(bflo(zz[0]) * bflo(uu[0]) * a[0], bfhi(zz[0]) * bfhi(uu[0]) * a[1]); o[1] = cvt_pk_bf16(bflo(zz[1]) * bflo(uu[1]) * a[2], bfhi(zz[1]) * bfhi(uu[1]) * a[3]);
            o[2] = cvt_pk_bf16(bflo(zz[2]) * bflo(uu[2]) * b2[0], bfhi(zz[2]) * bfhi(uu[2]) * b2[1]); o[3] = cvt_pk_bf16(bflo(zz[3]) * bflo(uu[3]) * b2[2], bfhi(zz[3]) * bfhi(uu[3]) * b2[3]);
            *(u32x4*)(yp + 8 * q) = o; }
    }
    __syncthreads();
}

__device__ void p_mixers(const Params& p, unsigned char* lds) {
    for (int it = blockIdx.x; it < 256; it += gridDim.x) {
        const int xcd = it & 7, slot = it >> 3; const int bh = xcd * 8 + (slot >> 2), pr = slot & 3;
        for (int u = 0; u < 2; ++u) attn_unit(p, lds, bh >> 3, bh & 7, u ? pr : 7 - pr);
    }
    for (int it = blockIdx.x; it < 256; it += gridDim.x) sgu_item(p, lds, it >> 1, it & 1);
}

__device__ void p_ln(const Params& p) {
    int tid = threadIdx.x; asm volatile("" : "+v"(tid)); const int lane = tid & 63, wave = tid >> 6;
    for (int row = blockIdx.x * 8 + wave; row < NTOK; row += gridDim.x * 8) {
        float* rp = p.out + (size_t)row * D_MODEL; f32x4 v[4]; float s = 0.f;
#pragma unroll
        for (int j = 0; j < 4; ++j) { v[j] = *(const f32x4*)(rp + lane * 4 + 256 * j); s += (v[j][0] + v[j][1]) + (v[j][2] + v[j][3]); }
#pragma unroll
        for (int o = 32; o; o >>= 1) s += __shfl_xor(s, o);
        const float mu = s * (1.0f / 1024.f); float q = 0.f;
#pragma unroll
        for (int j = 0; j < 4; ++j) { const f32x4 d = v[j] - mu; q += (d[0] * d[0] + d[1] * d[1]) + (d[2] * d[2] + d[3] * d[3]); }
#pragma unroll
        for (int o = 32; o; o >>= 1) q += __shfl_xor(q, o);
        const float rstd = 1.0f / sqrtf(q * (1.0f / 1024.f) + LN_EPS);
#pragma unroll
        for (int j = 0; j < 4; ++j) { const int col = lane * 4 + 256 * j; const f32x4 g = *(const f32x4*)(p.ln_g + col), bb = *(const f32x4*)(p.ln_b + col);
            *(f32x4*)(rp + col) = (v[j] - mu) * rstd * g + bb; }
    }
}

#if MODE == 0
__global__ void __launch_bounds__(NT, 2) mega(Params p) {
    extern __shared__ __attribute__((aligned(16))) unsigned char lds[];
    volatile LAS unsigned* st = (volatile LAS unsigned*)((LAS unsigned char*)lds + 131072);
    if (threadIdx.x == 0) { st[0] = 0u; st[1] = 0u; st[2] = 0u; st[3] = 0u; }
    __syncthreads();
    const XcdBarrier bar = xcd_barrier_post((unsigned*)(p.ws + OFF_BAR), st);
    p0_prologue(p, lds); xcd_barrier(bar);
    p_hconv(p); xcd_barrier(bar);
    p_inproj(p, lds); xcd_barrier(bar);
    p_mixers(p, lds); xcd_barrier(bar);
    const bool fused = (gridDim.x == 256);
    p_outproj(p, lds, bar, fused);
    if (!fused) { cg::this_grid().sync(); p_ln(p); }
}
#else
__global__ void __launch_bounds__(NT, 2) mega(Params p) { extern __shared__ __attribute__((aligned(16))) unsigned char lds[]; p0_prologue(p, lds); }
__global__ void __launch_bounds__(NT, 2) k_ph1(Params p) { p_hconv(p); }
__global__ void __launch_bounds__(NT, 2) k_ph2(Params p) { extern __shared__ __attribute__((aligned(16))) unsigned char lds[]; p_inproj(p, lds); }
__global__ void __launch_bounds__(NT, 2) k_ph3(Params p) { extern __shared__ __attribute__((aligned(16))) unsigned char lds[]; p_mixers(p, lds); }
__global__ void __launch_bounds__(NT, 2) k_ph4(Params p) { extern __shared__ __attribute__((aligned(16))) unsigned char lds[]; XcdBarrier bar{}; p_outproj(p, lds, bar, false); }
__global__ void __launch_bounds__(NT, 2) k_ph5(Params p) { p_ln(p); }
#endif

extern "C" void kernel_launch(void* const* d_in, const int* in_sizes, int n_in, void* d_out, int out_size, void* d_ws, size_t ws_size, hipStream_t stream) {
    static int grid_blocks = 0;
    if (!grid_blocks) {
        int dev = 0, cus = 0, per_cu = 0;
        (void)hipGetDevice(&dev);
        (void)hipDeviceGetAttribute(&cus, hipDeviceAttributeMultiprocessorCount, dev);
        if (hipFuncSetAttribute((const void*)mega, hipFuncAttributeMaxDynamicSharedMemorySize, LDS_BYTES) != hipSuccess) fprintf(stderr, "hipFuncSetAttribute failed\n");
        if (hipOccupancyMaxActiveBlocksPerMultiprocessor(&per_cu, (const void*)mega, NT, LDS_BYTES) != hipSuccess || per_cu < 1) { fprintf(stderr, "occupancy query: %d\n", per_cu); per_cu = 1; }
        (void)hipGetLastError();
        if (per_cu > 1) per_cu = 1;
        grid_blocks = cus * per_cu;
    }
    Params p{};
    p.x = (const float*)d_in[0]; p.c = (const float*)d_in[1]; p.w_ada = (const float*)d_in[2]; p.b_ada = (const float*)d_in[3]; p.w_in = (const float*)d_in[4];
    p.sgu_g = (const float*)d_in[5]; p.sgu_b = (const float*)d_in[6]; p.w_sp = (const float*)d_in[7]; p.b_sp = (const float*)d_in[8]; p.w_out = (const float*)d_in[9];
    p.ln_g = (const float*)d_in[10]; p.ln_b = (const float*)d_in[11]; p.out = (float*)d_out; p.ws = (unsigned char*)d_ws; p.phase = 0; p.pad = 0;
#if MODE == 0
    (void)hipMemsetAsync((char*)d_ws + OFF_BAR, 0, XCD_BAR_WORDS * 4, stream);
    void* args[] = {&p};
    hipError_t e = hipLaunchCooperativeKernel((const void*)mega, dim3(grid_blocks), dim3(NT), args, LDS_BYTES, stream);
    if (e != hipSuccess) fprintf(stderr, "cooperative launch failed: %s (grid %d)\n", hipGetErrorString(e), grid_blocks);
#else
    hipFuncSetAttribute((const void*)k_ph2, hipFuncAttributeMaxDynamicSharedMemorySize, LDS_BYTES);
    hipFuncSetAttribute((const void*)k_ph3, hipFuncAttributeMaxDynamicSharedMemorySize, LDS_BYTES);
    hipFuncSetAttribute((const void*)k_ph4, hipFuncAttributeMaxDynamicSharedMemorySize, LDS_BYTES);
    hipLaunchKernelGGL(mega, dim3(grid_blocks), dim3(NT), LDS_BYTES, stream, p);
    hipLaunchKernelGGL(k_ph1, dim3(grid_blocks), dim3(NT), 0, stream, p);
    hipLaunchKernelGGL(k_ph2, dim3(grid_blocks), dim3(NT), LDS_BYTES, stream, p);
    hipLaunchKernelGGL(k_ph3, dim3(grid_blocks), dim3(NT), LDS_BYTES, stream, p);
    hipLaunchKernelGGL(k_ph4, dim3(grid_blocks), dim3(NT), LDS_BYTES, stream, p);
    hipLaunchKernelGGL(k_ph5, dim3(grid_blocks), dim3(NT), 0, stream, p);
#endif
}
```

```cpp
#include <hip/hip_runtime.h>
#include <hip/hip_cooperative_groups.h>
#include <cstdint>
#include <cstdio>
namespace cg = cooperative_groups;

#ifndef MODE
#define MODE 0
#endif

typedef unsigned short bf16_t;
typedef short bf16x8 __attribute__((ext_vector_type(8)));
typedef _Float16 f16x8 __attribute__((ext_vector_type(8)));
typedef float f32x4 __attribute__((ext_vector_type(4)));
typedef float f32x16 __attribute__((ext_vector_type(16)));
typedef unsigned u32x2 __attribute__((ext_vector_type(2)));
typedef unsigned u32x4 __attribute__((ext_vector_type(4)));

constexpr int D_MODEL = 1024, BATCH = 8, SEQ = 2048, NTOK = BATCH * SEQ;
constexpr int NPROJ = 3584, CHUNK = 128, NGRP = 8, NHEAD = 8;
constexpr int C_U = 0, C_V = 512, C_ZA = 1024, C_Q = 1536, C_K = 2048, C_VB = 2560, C_ZB = 3072;
constexpr float LN_EPS = 1e-5f;
constexpr float ALPHA = 1.189207115002721f;
constexpr float LOG2E = 1.4426950408889634f;
constexpr float QSCALE = 0.125f * LOG2E;
constexpr int NT = 512;
constexpr int LDS_BYTES = 131072 + 16;

__device__ __forceinline__ bf16_t f2bf(float f) { unsigned u = __float_as_uint(f); u += 0x7fffu + ((u >> 16) & 1u); return (bf16_t)(u >> 16); }
__device__ __forceinline__ float bf2f(bf16_t b) { return __uint_as_float(((unsigned)b) << 16); }
__device__ __forceinline__ float bflo(unsigned w) { return __uint_as_float(w << 16); }
__device__ __forceinline__ float bfhi(unsigned w) { return __uint_as_float(w & 0xffff0000u); }
typedef float f32x2_ __attribute__((ext_vector_type(2)));
typedef __bf16 bf16x2_ __attribute__((ext_vector_type(2)));
typedef _Float16 f16x2_ __attribute__((ext_vector_type(2)));
__device__ __forceinline__ unsigned cvt_pk_bf16(float lo, float hi) { f32x2_ v = {lo, hi}; return __builtin_bit_cast(unsigned, __builtin_convertvector(v, bf16x2_)); }
__device__ __forceinline__ unsigned cvt_pk_f16(float lo, float hi) { f32x2_ v = {lo, hi}; return __builtin_bit_cast(unsigned, __builtin_convertvector(v, f16x2_)); }
__device__ __forceinline__ float sigmoidf_(float v) { return __builtin_amdgcn_rcpf(1.0f + __builtin_amdgcn_exp2f(-v * LOG2E)); }
__device__ __forceinline__ float siluf_(float v) { return v * sigmoidf_(v); }
__device__ __forceinline__ float geluf_(float v) { return v * sigmoidf_(1.5957691216057308f * (v + 0.044715f * v * v * v)); }

constexpr size_t OFF_MOD = 0;
constexpr size_t OFF_HB = 1 << 20;
constexpr size_t OFF_WIN = OFF_HB + (size_t)NTOK * D_MODEL * 2;
constexpr size_t OFF_WOUT = OFF_WIN + (size_t)NPROJ * D_MODEL * 2;
constexpr size_t OFF_WSP = OFF_WOUT + (size_t)D_MODEL * D_MODEL * 2;
constexpr size_t OFF_PROJ = OFF_WSP + (size_t)NGRP * CHUNK * CHUNK * 2;
constexpr size_t OFF_Y = OFF_PROJ + (size_t)NTOK * NPROJ * 2;

struct Params {
    const float* x; const float* c; const float* w_ada; const float* b_ada; const float* w_in; const float* sgu_g; const float* sgu_b;
    const float* w_sp; const float* b_sp; const float* w_out; const float* ln_g; const float* ln_b;
    float* out; unsigned char* ws; int phase; int pad;
};


#define XB_TMO      128
#define XB_XCNT(j)  (256  + 64 * (j))
#define XB_XSUB(j)  (1280 + 64 * (j))
#define XB_XGEN(j)  (2304 + 64 * (j))
#define XB_TOP      3328
#define XB_TOPGEN   3392
#define XCD_BAR_WORDS 3456
#define XB_SPIN_CAP (1u << 18)
#define LAS __attribute__((address_space(3)))
__device__ __forceinline__ unsigned xb_ld(unsigned* p)              { return __hip_atomic_load(p, __ATOMIC_RELAXED, __HIP_MEMORY_SCOPE_AGENT); }
__device__ __forceinline__ unsigned xb_add(unsigned* p, unsigned v) { return __hip_atomic_fetch_add(p, v, __ATOMIC_RELAXED, __HIP_MEMORY_SCOPE_AGENT); }
__device__ __forceinline__ unsigned xb_xcc_id() { return (unsigned)__builtin_amdgcn_s_getreg((3 << 11) | 20) & 0xFu; }
#define XB_SPIN(cond, bar) do { unsigned _sp = 0; while (cond) { __builtin_amdgcn_s_sleep(1); \
    if ((++_sp & 255u) == 0u) { if (xb_ld(&(bar)[XB_TMO])) break; if (_sp > XB_SPIN_CAP) { atomicAdd(&(bar)[XB_TMO], 1u); break; } } } } while (0)
struct XcdBarrier { unsigned* bar; unsigned x; volatile LAS unsigned* st; };
__device__ __forceinline__ XcdBarrier xcd_barrier_post(unsigned* bar, volatile LAS unsigned* st) {
    XcdBarrier b; b.bar = bar; b.x = xb_xcc_id(); b.st = st;
    if (threadIdx.x == 0) (void)xb_add(&bar[XB_XCNT(b.x)], 1u);
    return b;
}
__device__ __forceinline__ void xcd_barrier_complete(unsigned* bar, unsigned x, unsigned& nloc, unsigned& nx) {
    const unsigned G = gridDim.x * gridDim.y * gridDim.z;
    unsigned sum, cnt, mine, sp = 0u;
    for (;;) {
        sum = 0u; cnt = 0u; mine = 0u;
#pragma unroll
        for (unsigned j = 0; j < 16; ++j) { const unsigned c = xb_ld(&bar[XB_XCNT(j)]); sum += c; cnt += (c > 0u) ? 1u : 0u; mine = (j == x) ? c : mine; }
        if (sum == G) break;
        __builtin_amdgcn_s_sleep(1);
        if ((++sp & 255u) == 0u) { if (xb_ld(&bar[XB_TMO])) break; if (sp > XB_SPIN_CAP) { atomicAdd(&bar[XB_TMO], 1u); break; } }
    }
    nloc = mine > 0u ? mine : 1u; nx = cnt > 0u ? cnt : 1u;
}
__device__ __forceinline__ void xcd_barrier(const XcdBarrier& b) {
    asm volatile("s_waitcnt vmcnt(0)" ::: "memory");
    __syncthreads();
    if (threadIdx.x == 0) {
        unsigned* bar = b.bar;
        __builtin_amdgcn_s_waitcnt(0);
        unsigned nloc = b.st[0], nx = b.st[1];
        if (nloc == 0u) { xcd_barrier_complete(bar, b.x, nloc, nx); b.st[0] = nloc; b.st[1] = nx; }
        const unsigned old = xb_add(&bar[XB_XSUB(b.x)], 1u);
        const unsigned gen = old / nloc;
        if (old + 1u == (gen + 1u) * nloc) {
            __builtin_amdgcn_fence(__ATOMIC_RELEASE, "agent");
            asm volatile("s_waitcnt vmcnt(0)" ::: "memory");
            const unsigned og = xb_add(&bar[XB_TOP], 1u);
            const unsigned tg = og / nx;
            if (og + 1u == (tg + 1u) * nx) xb_add(&bar[XB_TOPGEN], 1u);
            else XB_SPIN(xb_ld(&bar[XB_TOPGEN]) == tg, bar);
            __builtin_amdgcn_fence(__ATOMIC_ACQUIRE, "agent");
            xb_add(&bar[XB_XGEN(b.x)], 1u);
            asm volatile("s_waitcnt vmcnt(0)" ::: "memory");
        } else {
            XB_SPIN(xb_ld(&bar[XB_XGEN(b.x)]) == gen, bar);
            __builtin_amdgcn_fence(__ATOMIC_ACQUIRE, "agent");
            asm volatile("s_waitcnt vmcnt(0)" ::: "memory");
        }
    }
    __syncthreads();
}
constexpr size_t OFF_BAR = 128 * 1024;

__device__ void p0_prologue(const Params& p, unsigned char* lds) {
    int tid = threadIdx.x; asm volatile("" : "+v"(tid)); const int lane = tid & 63, wave = tid >> 6;
    float* mod = (float*)(p.ws + OFF_MOD);
    float* sc = (float*)lds;
    float* red = (float*)(lds + 32768);
    for (int it = blockIdx.x; it < 96; it += gridDim.x) {
        for (int i = tid; i < 8 * 1024; i += NT) sc[i] = siluf_(p.c[i]);
        __syncthreads();
        const int q = tid & 7, r = tid >> 3; const int c0 = it * 32 + q * 4;
        float acc[8][4];
#pragma unroll
        for (int b = 0; b < 8; ++b) { acc[b][0] = 0.f; acc[b][1] = 0.f; acc[b][2] = 0.f; acc[b][3] = 0.f; }
        f32x4 wv[16];
#pragma unroll
        for (int i = 0; i < 16; ++i) wv[i] = __builtin_nontemporal_load((const f32x4*)(p.w_ada + (size_t)(r + 64 * i) * 3072 + c0));
#pragma unroll
        for (int i = 0; i < 16; ++i) { const int k = r + 64 * i; const f32x4 w = wv[i];
#pragma unroll
            for (int b = 0; b < 8; ++b) { const float s = sc[b * 1024 + k]; acc[b][0] += s * w[0]; acc[b][1] += s * w[1]; acc[b][2] += s * w[2]; acc[b][3] += s * w[3]; } }
#pragma unroll
        for (int b = 0; b < 8; ++b)
#pragma unroll
            for (int j = 0; j < 4; ++j) { float v = acc[b][j]; v += __shfl_xor(v, 8); v += __shfl_xor(v, 16); v += __shfl_xor(v, 32); acc[b][j] = v; }
        if (lane < 8) {
#pragma unroll
            for (int b = 0; b < 8; ++b)
#pragma unroll
                for (int j = 0; j < 4; ++j) red[(wave * 8 + q) * 32 + b * 4 + j] = acc[b][j];
        }
        __syncthreads();
        if (tid < 256) { const int b = tid >> 5, col = tid & 31, qq = col >> 2, j = col & 3; float s = 0.f;
#pragma unroll
            for (int w = 0; w < 8; ++w) s += red[(w * 8 + qq) * 32 + b * 4 + j];
            mod[b * 3072 + it * 32 + col] = s + p.b_ada[it * 32 + col]; }
        __syncthreads();
    }
    float* tb = (float*)(lds + 49152);
    {   const int n4 = tid & 15, kk = tid >> 4;
        f32x4 v0, v1; int tile = blockIdx.x;
        auto tile_src = [&](int tl, const float*& W, bf16_t*& Wt, int& N, int& k0, int& n0) {
            if (tl < 896) { W = p.w_in; Wt = (bf16_t*)(p.ws + OFF_WIN); N = NPROJ; k0 = (tl / 56) * 64; n0 = (tl % 56) * 64; }
            else { const int t2 = tl - 896; W = p.w_out; Wt = (bf16_t*)(p.ws + OFF_WOUT); N = D_MODEL; k0 = (t2 / 16) * 64; n0 = (t2 % 16) * 64; } };
        if (tile < 896 + 256) { const float* W; bf16_t* Wt; int N, k0, n0; tile_src(tile, W, Wt, N, k0, n0);
            v0 = __builtin_nontemporal_load((const f32x4*)(W + (size_t)(k0 + kk) * N + n0 + n4 * 4)); v1 = __builtin_nontemporal_load((const f32x4*)(W + (size_t)(k0 + kk + 32) * N + n0 + n4 * 4)); }
        for (; tile < 896 + 256; tile += gridDim.x) {
            const float* W; bf16_t* Wt; int N, k0, n0; tile_src(tile, W, Wt, N, k0, n0);
            tb[kk * 65 + n4 * 4 + 0] = v0[0]; tb[kk * 65 + n4 * 4 + 1] = v0[1]; tb[kk * 65 + n4 * 4 + 2] = v0[2]; tb[kk * 65 + n4 * 4 + 3] = v0[3];
            tb[(kk + 32) * 65 + n4 * 4 + 0] = v1[0]; tb[(kk + 32) * 65 + n4 * 4 + 1] = v1[1]; tb[(kk + 32) * 65 + n4 * 4 + 2] = v1[2]; tb[(kk + 32) * 65 + n4 * 4 + 3] = v1[3];
            __syncthreads();
            const int nt2 = tile + gridDim.x;
            if (nt2 < 896 + 256) { const float* W2; bf16_t* Wt2; int N2, k02, n02; tile_src(nt2, W2, Wt2, N2, k02, n02);
                v0 = __builtin_nontemporal_load((const f32x4*)(W2 + (size_t)(k02 + kk) * N2 + n02 + n4 * 4)); v1 = __builtin_nontemporal_load((const f32x4*)(W2 + (size_t)(k02 + kk + 32) * N2 + n02 + n4 * 4)); }
            { const int n = tid >> 3, ks = tid & 7; u32x4 o;
              o[0] = cvt_pk_bf16(tb[(ks * 8 + 0) * 65 + n], tb[(ks * 8 + 1) * 65 + n]); o[1] = cvt_pk_bf16(tb[(ks * 8 + 2) * 65 + n], tb[(ks * 8 + 3) * 65 + n]);
              o[2] = cvt_pk_bf16(tb[(ks * 8 + 4) * 65 + n], tb[(ks * 8 + 5) * 65 + n]); o[3] = cvt_pk_bf16(tb[(ks * 8 + 6) * 65 + n], tb[(ks * 8 + 7) * 65 + n]);
              *(u32x4*)(Wt + (size_t)(n0 + n) * D_MODEL + k0 + ks * 8) = o; }
            __syncthreads();
        }
    }
    bf16_t* wsp = (bf16_t*)(p.ws + OFF_WSP);
    for (int i = blockIdx.x * NT + tid; i < NGRP * CHUNK * CHUNK / 8; i += gridDim.x * NT) {
        const int e = i * 8, t = (e >> 7) & 127, s0 = e & 127;
        const f32x4 a = *(const f32x4*)(p.w_sp + e), b = *(const f32x4*)(p.w_sp + e + 4);
        float v[8] = {a[0], a[1], a[2], a[3], b[0], b[1], b[2], b[3]};
#pragma unroll
        for (int j = 0; j < 8; ++j) v[j] = (s0 + j <= t) ? v[j] : 0.f;
        u32x4 o; o[0] = cvt_pk_bf16(v[0], v[1]); o[1] = cvt_pk_bf16(v[2], v[3]); o[2] = cvt_pk_bf16(v[4], v[5]); o[3] = cvt_pk_bf16(v[6], v[7]);
        *(u32x4*)(wsp + e) = o;
    }
}

__device__ void p_hconv(const Params& p) {
    const float* mod = (const float*)(p.ws + OFF_MOD); bf16_t* hb = (bf16_t*)(p.ws + OFF_HB);
    int tid = threadIdx.x; asm volatile("" : "+v"(tid));
    const size_t stride = (size_t)gridDim.x * NT, total = (size_t)NTOK * D_MODEL / 8;
    for (size_t i0 = (size_t)blockIdx.x * NT + tid; i0 < total; i0 += 4 * stride) {
        f32x4 x0[4], x1[4];
#pragma unroll
        for (int u = 0; u < 4; ++u) { const size_t i = i0 + u * stride; if (i < total) { x0[u] = __builtin_nontemporal_load((const f32x4*)(p.x + i * 8)); x1[u] = __builtin_nontemporal_load((const f32x4*)(p.x + i * 8 + 4)); } }
#pragma unroll
        for (int u = 0; u < 4; ++u) { const size_t i = i0 + u * stride; if (i < total) {
            const size_t e = i * 8; const int col = (int)(e & 1023); const int b = (int)(e >> 21);
            const f32x4 sh0 = *(const f32x4*)(mod + b * 3072 + col), sh1 = *(const f32x4*)(mod + b * 3072 + col + 4);
            const f32x4 sc0 = *(const f32x4*)(mod + b * 3072 + 1024 + col), sc1 = *(const f32x4*)(mod + b * 3072 + 1024 + col + 4);
            const f32x4 h0 = x0[u] * (1.0f + sc0) + sh0, h1 = x1[u] * (1.0f + sc1) + sh1;
            u32x4 o; o[0] = cvt_pk_bf16(h0[0], h0[1]); o[1] = cvt_pk_bf16(h0[2], h0[3]); o[2] = cvt_pk_bf16(h1[0], h1[1]); o[3] = cvt_pk_bf16(h1[2], h1[3]);
            *(u32x4*)(hb + e) = o; } }
    }
}

constexpr int BM = 256, BK = 64, HALF = 128, NXCD = 8, WGM = 8, HT = HALF * BK;
__device__ __forceinline__ int lds_byte(int r, int c) { int st = (r >> 4) * 2 + (c >> 5), rr = r & 15, cc = c & 31, ob = rr * 64 + cc * 2; return st * 1024 + (ob ^ (((ob >> 9) & 1) << 5)); }
__device__ __forceinline__ void stage_rc(int b, int& R, int& C) { int st = b / 1024, sb = b % 1024, swz = sb ^ (((sb >> 9) & 1) << 5); R = (st >> 1) * 16 + swz / 64; C = (st & 1) * 32 + (swz % 64) / 2; }

struct TileOrder {
    int nM, nN, nwg, G, c;
    __device__ void init(int M, int N, int G_, int c_) { nM = M / BM; nN = N / BM; nwg = nM * nN; G = G_; c = c_; }
    __device__ bool next(int i, int& pm, int& pn) const { const long L = (long)i * G + c; if (L >= nwg) return false; map((int)L, pm, pn); return true; }
    __device__ void map(int L, int& pm, int& pn) const {
        int wgid = L; { const int q = nwg / NXCD, r = nwg % NXCD, xcd = wgid % NXCD, off = wgid / NXCD; wgid = (xcd < r ? xcd * (q + 1) : r * (q + 1) + (xcd - r) * q) + off; }
        const int nig = WGM * nN, gid = wgid / nig, fm = gid * WGM, gsz = (nM - fm) < WGM ? (nM - fm) : WGM;
        pm = fm + ((wgid % nig) % gsz); pn = (wgid % nig) / gsz;
    }
};

__device__ __forceinline__ void gemm_tile(const bf16_t* __restrict__ A, const bf16_t* __restrict__ Bt, const int K, const int brow, const int bcol, bf16_t* shm, f32x4 (&acc)[2][2][4][2], const bool half = false) {
#define SA(b, h) (shm + ((b) * 2 + (h)) * HT)
#define SB(b, h) (shm + (4 + (b) * 2 + (h)) * HT)
#define STAGE(P, BASE, br, kt) do { const char* _gb = (const char*)(BASE) + ((size_t)(br) * K + (size_t)(kt) * BK) * 2; \
    for (int _i = 0; _i < 2; ++_i) { int _b = gtx * 16 + _i * 8192; \
      __builtin_amdgcn_global_load_lds((const unsigned*)(_gb + soff[_i]), (__attribute__((address_space(3))) unsigned*)((char*)(P) + _b), 16, 0, 0); } } while (0)
#define LDA(dst, b, h) for (int m = 0; m < 4; ++m) for (int k = 0; k < 2; ++k) \
    dst[m][k] = *reinterpret_cast<const bf16x8*>((char*)SA(b, h) + lds_byte(wr * 64 + m * 16 + fr, k * 32 + fq * 8))
#define LDB(dst, b, h) for (int n = 0; n < 2; ++n) for (int k = 0; k < 2; ++k) \
    dst[n][k] = *reinterpret_cast<const bf16x8*>((char*)SB(b, h) + lds_byte(wc * 32 + n * 16 + fr, k * 32 + fq * 8))
#define MMA(ai, bj, At_, Bt_) do { __builtin_amdgcn_s_setprio(1); \
    for (int m = 0; m < 4; ++m) for (int n = 0; n < 2; ++n) for (int k = 0; k < 2; ++k) \
      acc[ai][bj][m][n] = __builtin_amdgcn_mfma_f32_16x16x32_bf16(Bt_[n][k], At_[m][k], acc[ai][bj][m][n], 0, 0, 0); \
    __builtin_amdgcn_s_setprio(0); } while (0)
#define WAIT_V(n) asm volatile("s_waitcnt vmcnt(" #n ")" ::: "memory")
#define WAIT_L(n) asm volatile("s_waitcnt lgkmcnt(" #n ")" ::: "memory")
#define BAR __builtin_amdgcn_s_barrier()
#define SCHED __builtin_amdgcn_sched_barrier(0)
    int gtx = threadIdx.x; asm volatile("" : "+v"(gtx));
    const int wid = gtx >> 6, lane = gtx & 63, wr = __builtin_amdgcn_readfirstlane(wid >> 2), wc = wid & 3, fr = lane & 15, fq = lane >> 4;
#pragma unroll
    for (int a = 0; a < 2; ++a)
#pragma unroll
        for (int b = 0; b < 2; ++b)
#pragma unroll
            for (int m = 0; m < 4; ++m)
#pragma unroll
                for (int n = 0; n < 2; ++n) acc[a][b][m][n] = (f32x4){0.f, 0.f, 0.f, 0.f};
    bf16x8 At[4][2], B0[2][2], B1[2][2];
    unsigned soff[2];
    for (int _i = 0; _i < 2; ++_i) { int _r, _c; stage_rc(gtx * 16 + _i * 8192, _r, _c); soff[_i] = (unsigned)(_r * K + _c) * 2u; }
    const int nt = K / BK;
    STAGE(SB(0, 0), Bt, bcol, 0); STAGE(SA(0, 0), A, brow, 0);
    STAGE(SB(0, 1), Bt, bcol + HALF, 0); STAGE(SA(0, 1), A, brow + HALF, 0);
    if (wr == 1) BAR;
    WAIT_V(4); BAR;
    STAGE(SB(1, 0), Bt, bcol, 1); STAGE(SA(1, 0), A, brow, 1); STAGE(SB(1, 1), Bt, bcol + HALF, 1);
    WAIT_V(6); BAR;
    for (int t = 0; t < nt - 2; t += 2) {
        LDB(B0, 0, 0); SCHED; LDA(At, 0, 0); STAGE(SA(1, 1), A, brow + HALF, t + 1);
        WAIT_L(8); BAR; WAIT_L(0); MMA(0, 0, At, B0); BAR; SCHED;
        LDB(B1, 0, 1); STAGE(SB(0, 0), Bt, bcol, t + 2);
        BAR; WAIT_L(0); MMA(0, 1, At, B1); BAR;
        if (!half) { LDA(At, 0, 1); } STAGE(SA(0, 0), A, brow, t + 2);
        BAR; WAIT_L(0); if (!half) { MMA(1, 0, At, B0); } BAR; SCHED;
        STAGE(SB(0, 1), Bt, bcol + HALF, t + 2);
        WAIT_V(6); BAR; if (!half) { MMA(1, 1, At, B1); } BAR;
        LDB(B0, 1, 0); SCHED; LDA(At, 1, 0); STAGE(SA(0, 1), A, brow + HALF, t + 2);
        WAIT_L(8); BAR; WAIT_L(0); MMA(0, 0, At, B0); BAR; SCHED;
        LDB(B1, 1, 1); STAGE(SB(1, 0), Bt, bcol, t + 3);
        BAR; WAIT_L(0); MMA(0, 1, At, B1); BAR;
        if (!half) { LDA(At, 1, 1); } STAGE(SA(1, 0), A, brow, t + 3);
        BAR; WAIT_L(0); if (!half) { MMA(1, 0, At, B0); } BAR; SCHED;
        STAGE(SB(1, 1), Bt, bcol + HALF, t + 3);
        WAIT_V(6); BAR; if (!half) { MMA(1, 1, At, B1); } BAR;
    }
    { LDB(B0, 0, 0); LDA(At, 0, 0); STAGE(SA(1, 1), A, brow + HALF, nt - 1);
      BAR; WAIT_L(0); MMA(0, 0, At, B0); BAR;
      LDB(B1, 0, 1); BAR; WAIT_L(0); MMA(0, 1, At, B1); BAR;
      if (!half) { LDA(At, 0, 1); } WAIT_V(4); BAR; WAIT_L(0); if (!half) { MMA(1, 0, At, B0); MMA(1, 1, At, B1); } BAR; }
    { LDB(B0, 1, 0); LDA(At, 1, 0); WAIT_V(2); BAR; WAIT_L(0); MMA(0, 0, At, B0); BAR;
      LDB(B1, 1, 1); WAIT_V(0); BAR; WAIT_L(0); MMA(0, 1, At, B1); BAR;
      if (!half) { LDA(At, 1, 1); } BAR; WAIT_L(0); if (!half) { MMA(1, 0, At, B0); MMA(1, 1, At, B1); } BAR; }
    if (wr == 0) BAR;
#undef SA
#undef SB
#undef STAGE
#undef LDA
#undef LDB
#undef MMA
}

__device__ void p_inproj(const Params& p, unsigned char* lds) {
    const bf16_t* hb = (const bf16_t*)(p.ws + OFF_HB); const bf16_t* winT = (const bf16_t*)(p.ws + OFF_WIN); bf16_t* proj = (bf16_t*)(p.ws + OFF_PROJ);
    TileOrder ord; ord.init(NTOK, NPROJ, gridDim.x, blockIdx.x);
    const int G = gridDim.x, rem = ord.nwg % G, nsplit = (rem > 0 && 2 * rem <= G) ? rem : 0, nfull = ord.nwg - nsplit, nunits = nfull + 2 * nsplit;
    for (int i = 0;; ++i) {
        const int u = i * G + (int)blockIdx.x; if (u >= nunits) break;
        int pm, pn; const bool half = (u >= nfull); const int hsel = half ? ((u - nfull) & 1) : 0;
        ord.map(half ? nfull + ((u - nfull) >> 1) : u, pm, pn);
        f32x4 acc[2][2][4][2];
        gemm_tile(hb, winT, D_MODEL, pm * BM + hsel * HALF, pn * BM, (bf16_t*)lds, acc, half);
        int tx = threadIdx.x; asm volatile("" : "+v"(tx));
        const int wid = tx >> 6, lane = tx & 63, wr = wid >> 2, wc = wid & 3, fr = lane & 15, fq = lane >> 4;
        const int seg = pn >> 1;
#pragma unroll
        for (int ai = 0; ai < 2; ++ai) {
            if (half && ai == 1) break;
#pragma unroll
            for (int m = 0; m < 4; ++m) {
                const int row = pm * BM + hsel * HALF + ai * HALF + wr * 64 + m * 16 + fr;
                bf16_t* rowp = proj + (size_t)row * NPROJ + pn * BM + wc * 32 + fq * 4;
#pragma unroll
                for (int bj = 0; bj < 2; ++bj)
#pragma unroll
                    for (int n = 0; n < 2; ++n) {
                        f32x4 v = acc[ai][bj][m][n];
                        if (seg <= 1) { v[0] = geluf_(v[0]); v[1] = geluf_(v[1]); v[2] = geluf_(v[2]); v[3] = geluf_(v[3]); }
                        else if (seg == 2 || seg == 6) { v[0] = siluf_(v[0]); v[1] = siluf_(v[1]); v[2] = siluf_(v[2]); v[3] = siluf_(v[3]); }
                        else if (seg == 3) { v = v * QSCALE; }
                        u32x2 o; o[0] = cvt_pk_bf16(v[0], v[1]); o[1] = cvt_pk_bf16(v[2], v[3]);
                        *(u32x2*)(rowp + bj * HALF + n * 16) = o;
                    }
            }
        }
        asm volatile("s_waitcnt vmcnt(0)" ::: "memory");
    }
}

constexpr size_t OFF_STATS = 256 * 1024;
__device__ void p_outproj(const Params& p, unsigned char* lds, const XcdBarrier& bar, const bool fused) {
    const bf16_t* yb = (const bf16_t*)(p.ws + OFF_Y); const bf16_t* woutT = (const bf16_t*)(p.ws + OFF_WOUT); const float* mod = (const float*)(p.ws + OFF_MOD);
    TileOrder ord; ord.init(NTOK, D_MODEL, gridDim.x, blockIdx.x);
    for (int i = 0;; ++i) {
        int pm, pn; if (!ord.next(i, pm, pn)) break;
        f32x4 acc[2][2][4][2];
        gemm_tile(yb, woutT, D_MODEL, pm * BM, pn * BM, (bf16_t*)lds, acc);
        int tx = threadIdx.x; asm volatile("" : "+v"(tx));
        const int wid = tx >> 6, lane = tx & 63, wr = wid >> 2, wc = wid & 3, fr = lane & 15, fq = lane >> 4;
        const int b = (pm * BM) / SEQ; const int col0 = pn * BM + wc * 32 + fq * 4;
        {   f32x4 gate[2][2];
#pragma unroll
            for (int bj = 0; bj < 2; ++bj)
#pragma unroll
                for (int n = 0; n < 2; ++n) gate[bj][n] = *(const f32x4*)(mod + b * 3072 + 2048 + col0 + bj * HALF + n * 16);
#pragma unroll
            for (int ai = 0; ai < 2; ++ai) {
                f32x4 xv[4][2][2];
#pragma unroll
                for (int m = 0; m < 4; ++m) { const size_t off = (size_t)(pm * BM + ai * HALF + wr * 64 + m * 16 + fr) * D_MODEL + col0;
#pragma unroll
                    for (int bj = 0; bj < 2; ++bj)
#pragma unroll
                        for (int n = 0; n < 2; ++n) xv[m][bj][n] = __builtin_nontemporal_load((const f32x4*)(p.x + off + bj * HALF + n * 16)); }
#pragma unroll
                for (int m = 0; m < 4; ++m)
#pragma unroll
                    for (int bj = 0; bj < 2; ++bj)
#pragma unroll
                        for (int n = 0; n < 2; ++n) acc[ai][bj][m][n] = xv[m][bj][n] * ALPHA + gate[bj][n] * acc[ai][bj][m][n];
            } }
        if (!fused) {
#pragma unroll
            for (int ai = 0; ai < 2; ++ai)
#pragma unroll
                for (int m = 0; m < 4; ++m) { const size_t off = (size_t)(pm * BM + ai * HALF + wr * 64 + m * 16 + fr) * D_MODEL + col0;
#pragma unroll
                    for (int bj = 0; bj < 2; ++bj)
#pragma unroll
                        for (int n = 0; n < 2; ++n) *(f32x4*)(p.out + off + bj * HALF + n * 16) = acc[ai][bj][m][n]; }
            asm volatile("s_waitcnt vmcnt(0)" ::: "memory");
            continue;
        }
        float* P = (float*)lds;
        float* S = (float*)(lds + 8192);
        float* gstats = (float*)(p.ws + OFF_STATS);
#pragma unroll
        for (int ai = 0; ai < 2; ++ai)
#pragma unroll
            for (int m = 0; m < 4; ++m) { float s1 = 0.f, s2 = 0.f;
#pragma unroll
                for (int bj = 0; bj < 2; ++bj)
#pragma unroll
                    for (int n = 0; n < 2; ++n) { const f32x4 v = acc[ai][bj][m][n]; s1 += (v[0] + v[1]) + (v[2] + v[3]); s2 += (v[0] * v[0] + v[1] * v[1]) + (v[2] * v[2] + v[3] * v[3]); }
                s1 += __shfl_xor(s1, 16); s2 += __shfl_xor(s2, 16); s1 += __shfl_xor(s1, 32); s2 += __shfl_xor(s2, 32);
                if (fq == 0) { const int rl = ai * HALF + wr * 64 + m * 16 + fr; P[(rl * 4 + wc) * 2] = s1; P[(rl * 4 + wc) * 2 + 1] = s2; } }
        __syncthreads();
        if (tx < 256) { const f32x4 a = *(const f32x4*)(P + tx * 8), c2 = *(const f32x4*)(P + tx * 8 + 4);
            float* gp = gstats + ((size_t)(pm * BM + tx) * 4 + pn) * 2; gp[0] = (a[0] + a[2]) + (c2[0] + c2[2]); gp[1] = (a[1] + a[3]) + (c2[1] + c2[3]); }
        xcd_barrier(bar);
        if (tx < 256) { const float* gp = gstats + (size_t)(pm * BM + tx) * 8; const f32x4 a = *(const f32x4*)gp, c2 = *(const f32x4*)(gp + 4);
            const float mean = ((a[0] + a[2]) + (c2[0] + c2[2])) * (1.0f / 1024.f); const float ex2 = ((a[1] + a[3]) + (c2[1] + c2[3])) * (1.0f / 1024.f);
            const float var = fmaxf(ex2 - mean * mean, 0.f); S[tx * 2] = mean; S[tx * 2 + 1] = 1.0f / sqrtf(var + LN_EPS); }
        __syncthreads();
        {   f32x4 gg[2][2], bb[2][2];
#pragma unroll
            for (int bj = 0; bj < 2; ++bj)
#pragma unroll
                for (int n = 0; n < 2; ++n) { gg[bj][n] = *(const f32x4*)(p.ln_g + col0 + bj * HALF + n * 16); bb[bj][n] = *(const f32x4*)(p.ln_b + col0 + bj * HALF + n * 16); }
#pragma unroll
            for (int ai = 0; ai < 2; ++ai)
#pragma unroll
                for (int m = 0; m < 4; ++m) { const int rl = ai * HALF + wr * 64 + m * 16 + fr; const float mean = S[rl * 2], rstd = S[rl * 2 + 1];
                    const size_t off = (size_t)(pm * BM + rl) * D_MODEL + col0;
#pragma unroll
                    for (int bj = 0; bj < 2; ++bj)
#pragma unroll
                        for (int n = 0; n < 2; ++n) __builtin_nontemporal_store((acc[ai][bj][m][n] - mean) * rstd * gg[bj][n] + bb[bj][n], (f32x4*)(p.out + off + bj * HALF + n * 16)); } }
    }
}

constexpr int KROW = 72;
__device__ __forceinline__ float relu_(float x) { int i = __builtin_bit_cast(int, x); i = i > 0 ? i : 0; return __builtin_bit_cast(float, i); }
__device__ __forceinline__ void softplus_pack(const f32x16& z, f16x8 (&lf)[2]) {
    unsigned w[8];
#pragma unroll
    for (int i = 0; i < 8; ++i) {
        const float z0 = z[2 * i], z1 = z[2 * i + 1];
        const float l0 = __builtin_amdgcn_logf(1.0f + __builtin_amdgcn_exp2f(-__builtin_fabsf(z0))), l1 = __builtin_amdgcn_logf(1.0f + __builtin_amdgcn_exp2f(-__builtin_fabsf(z1)));
        w[i] = cvt_pk_f16(relu_(z0) + l0, relu_(z1) + l1);
    }
    u32x4 t0 = {w[0], w[1], w[2], w[3]}, t1 = {w[4], w[5], w[6], w[7]};
    lf[0] = __builtin_bit_cast(f16x8, t0); lf[1] = __builtin_bit_cast(f16x8, t1);
}
__device__ __forceinline__ void expo_pack(const f32x16& z, const f32x16& cum, bf16x8 (&pf)[2]) {
    unsigned w[8];
#pragma unroll
    for (int i = 0; i < 8; ++i) w[i] = cvt_pk_bf16(__builtin_amdgcn_exp2f(z[2 * i] + cum[2 * i]), __builtin_amdgcn_exp2f(z[2 * i + 1] + cum[2 * i + 1]));
    u32x4 t0 = {w[0], w[1], w[2], w[3]}, t1 = {w[4], w[5], w[6], w[7]};
    pf[0] = __builtin_bit_cast(bf16x8, t0); pf[1] = __builtin_bit_cast(bf16x8, t1);
}
__device__ __forceinline__ void exp_pack(const f32x16& e, bf16x8 (&pf)[2]) {
    unsigned w[8];
#pragma unroll
    for (int i = 0; i < 8; ++i) w[i] = cvt_pk_bf16(__builtin_amdgcn_exp2f(e[2 * i]), __builtin_amdgcn_exp2f(e[2 * i + 1]));
    u32x4 t0 = {w[0], w[1], w[2], w[3]}, t1 = {w[4], w[5], w[6], w[7]};
    pf[0] = __builtin_bit_cast(bf16x8, t0); pf[1] = __builtin_bit_cast(bf16x8, t1);
}
__device__ __forceinline__ f32x16 bcast16(float v) { f32x16 r;
#pragma unroll
    for (int i = 0; i < 16; ++i) r[i] = v;
    return r; }

__device__ __forceinline__ void tile_transpose(float* reg, const f32x16& acc, const float add, const int c, const int hh, const int lane, f32x4 (&out)[4]) {
    asm volatile("" ::: "memory");
#pragma unroll
    for (int g4 = 0; g4 < 4; ++g4) { f32x4 v = {acc[4 * g4 + 0] + add, acc[4 * g4 + 1] + add, acc[4 * g4 + 2] + add, acc[4 * g4 + 3] + add}; *(f32x4*)(reg + c * 36 + 8 * g4 + 4 * hh) = v; }
    asm volatile("" ::: "memory");
    const int t = lane >> 1, half = lane & 1;
#pragma unroll
    for (int j = 0; j < 4; ++j) out[j] = *(const f32x4*)(reg + t * 36 + half * 16 + 4 * j);
    asm volatile("" ::: "memory");
}

constexpr int VTROW = 40;
__device__ __forceinline__ void attn_wave_item(const Params& p, unsigned char* lds, const int b, const int h, const int qblk) {
    const bf16_t* proj = (const bf16_t*)(p.ws + OFF_PROJ); bf16_t* yb = (bf16_t*)(p.ws + OFF_Y);
    int tid = threadIdx.x; asm volatile("" : "+v"(tid)); const int lane = tid & 63, wave = __builtin_amdgcn_readfirstlane(tid >> 6), c = lane & 31, hh = lane >> 5;
    bf16_t* Kw = (bf16_t*)(lds + wave * 9728);
    bf16_t* Vt = (bf16_t*)(lds + wave * 9728 + 4608);
    const size_t tokbase = (size_t)b * SEQ; const int tq0 = qblk * 32;
    bf16x8 qf[4];
    { const bf16_t* qp = proj + (tokbase + tq0 + c) * NPROJ + C_Q + h * 64 + hh * 8;
#pragma unroll
      for (int ks = 0; ks < 4; ++ks) qf[ks] = *(const bf16x8*)(qp + ks * 16); }
    f16x8 uf[2];
#pragma unroll
    for (int ks2 = 0; ks2 < 2; ++ks2)
#pragma unroll
        for (int jj = 0; jj < 8; ++jj) { const int key = 16 * ks2 + 8 * (jj >> 2) + 4 * hh + (jj & 3); uf[ks2][jj] = (key >= c) ? (_Float16)-1.0f : (_Float16)0.0f; }
    f32x16 o0 = bcast16(0.f), o1 = bcast16(0.f);
    float R = 0.f;
    const int swr = ((c >> 3) & 3) << 3;
    const int lkey = lane >> 3, lch = lane & 7;
    const bf16_t* kvbase = proj + (tokbase + lkey) * NPROJ + h * 64 + lch * 8;
    u32x4 kreg[4], vreg[4];
#pragma unroll
    for (int j = 0; j < 4; ++j) { const bf16_t* rp = kvbase + (size_t)(tq0 + 8 * j) * NPROJ; kreg[j] = *(const u32x4*)(rp + C_K); vreg[j] = *(const u32x4*)(rp + C_VB); }
#pragma unroll
    for (int ks = 0; ks < 4; ++ks) asm volatile("" : "+v"(qf[ks]));
    for (int ks0 = tq0; ks0 >= 0; ks0 -= 32) {
        asm volatile("" ::: "memory");
#pragma unroll
        for (int j = 0; j < 4; ++j) { const int key = lkey + 8 * j; const int spk = ((key & ~12) | ((key & 4) << 1) | ((key & 8) >> 1)) ^ ((lch & 3) << 3);
            *(u32x4*)(Kw + key * KROW + lch * 8) = kreg[j];
            bf16_t* vp = Vt + (lch * 8) * VTROW + spk;
#pragma unroll
            for (int e = 0; e < 4; ++e) { vp[(2 * e) * VTROW] = (bf16_t)(vreg[j][e] & 0xffffu); vp[(2 * e + 1) * VTROW] = (bf16_t)(vreg[j][e] >> 16); } }
        asm volatile("" ::: "memory");
        if (ks0 >= 32) {
#pragma unroll
            for (int j = 0; j < 4; ++j) { const bf16_t* rp = kvbase + (size_t)(ks0 - 32 + 8 * j) * NPROJ; kreg[j] = *(const u32x4*)(rp + C_K); vreg[j] = *(const u32x4*)(rp + C_VB); }
        }
        f32x16 z = bcast16(0.f);
#pragma unroll
        for (int ks = 0; ks < 4; ++ks) { const bf16x8 kf = *(const bf16x8*)(Kw + c * KROW + ks * 16 + hh * 8); z = __builtin_amdgcn_mfma_f32_32x32x16_bf16(kf, qf[ks], z, 0, 0, 0); }
        if (ks0 == tq0) {
#pragma unroll
            for (int r = 0; r < 16; ++r) { const int sl = (r & 3) + 8 * (r >> 2) + 4 * hh; z[r] = (sl >= c) ? -__builtin_inff() : z[r]; }
        }
        f16x8 lf[2]; softplus_pack(z, lf);
        f32x16 e = z + R;
        e = __builtin_amdgcn_mfma_f32_32x32x16_f16(uf[0], lf[0], e, 0, 0, 0);
        e = __builtin_amdgcn_mfma_f32_32x32x16_f16(uf[1], lf[1], e, 0, 0, 0);
        bf16x8 pf[2]; exp_pack(e, pf);
        { const float z0 = z[0]; const float cum0 = (z0 == -__builtin_inff()) ? R : (e[0] - z0); R = __shfl(cum0, c); }
#pragma unroll
        for (int ks2 = 0; ks2 < 2; ++ks2) {
            const bf16x8 v0 = *(const bf16x8*)(Vt + (c) * VTROW + ((ks2 * 16 + hh * 8) ^ swr)), v1 = *(const bf16x8*)(Vt + (32 + c) * VTROW + ((ks2 * 16 + hh * 8) ^ swr));
            o0 = __builtin_amdgcn_mfma_f32_32x32x16_bf16(v0, pf[ks2], o0, 0, 0, 0); o1 = __builtin_amdgcn_mfma_f32_32x32x16_bf16(v1, pf[ks2], o1, 0, 0, 0);
        }
        if (__builtin_amdgcn_ballot_w64(R > -140.0f) == 0ull) break;
    }
    { float* reg = (float*)(lds + 77824 + wave * 4608);
      const int t = lane >> 1, half = lane & 1; const size_t tok = tokbase + tq0 + t;
      const bf16_t* zp = proj + tok * NPROJ + C_ZB + h * 64 + half * 16; bf16_t* yp = yb + tok * D_MODEL + 512 + h * 64 + half * 16;
      u32x4 zz[2][2];
#pragma unroll
      for (int dt = 0; dt < 2; ++dt) { zz[dt][0] = *(const u32x4*)(zp + dt * 32); zz[dt][1] = *(const u32x4*)(zp + dt * 32 + 8); }
#pragma unroll
      for (int dt = 0; dt < 2; ++dt) { f32x4 ov[4]; tile_transpose(reg, dt ? o1 : o0, 0.f, c, hh, lane, ov);
#pragma unroll
          for (int q = 0; q < 2; ++q) { const u32x4 z4 = zz[dt][q]; const f32x4 a = ov[2 * q], b2 = ov[2 * q + 1]; u32x4 o;
              o[0] = cvt_pk_bf16(bflo(z4[0]) * a[0], bfhi(z4[0]) * a[1]); o[1] = cvt_pk_bf16(bflo(z4[1]) * a[2], bfhi(z4[1]) * a[3]);
              o[2] = cvt_pk_bf16(bflo(z4[2]) * b2[0], bfhi(z4[2]) * b2[1]); o[3] = cvt_pk_bf16(bflo(z4[3]) * b2[2], bfhi(z4[3]) * b2[3]);
              *(u32x4*)(yp + dt * 32 + 8 * q) = o; } } }
}

constexpr int VROW = 136;
__device__ __forceinline__ void sgu_item(const Params& p, unsigned char* lds, const int ch, const int hf) {
    const bf16_t* proj = (const bf16_t*)(p.ws + OFF_PROJ); bf16_t* yb = (bf16_t*)(p.ws + OFF_Y); const bf16_t* wsp = (const bf16_t*)(p.ws + OFF_WSP);
    int tid = threadIdx.x; asm volatile("" : "+v"(tid)); const int lane = tid & 63, wave = __builtin_amdgcn_readfirstlane(tid >> 6), c = lane & 31, hh = lane >> 5;
    float* stats = (float*)(lds + 73728);
    bf16_t* vw = (bf16_t*)(lds + wave * 8704);
    const size_t tok0 = (size_t)ch * CHUNK;
    const int g = hf * 4 + (wave >> 1), ct = wave & 1, ch0 = g * 64 + ct * 32;
    u32x4 vv[2][4];
#pragma unroll
    for (int i = 0; i < 2; ++i) { const bf16_t* vp = proj + (tok0 + lane + 64 * i) * NPROJ + C_V + ch0;
#pragma unroll
        for (int j = 0; j < 4; ++j) vv[i][j] = *(const u32x4*)(vp + 8 * j); }
    bf16x8 wf[20];
#pragma unroll
    for (int tt = 0; tt < 4; ++tt) { const bf16_t* wrow = wsp + ((size_t)g * CHUNK + tt * 32 + c) * CHUNK + hh * 8;
#pragma unroll
        for (int ks = 0; ks < 2 * (tt + 1); ++ks) wf[tt * (tt + 1) + ks] = *(const bf16x8*)(wrow + ks * 16); }
    { const int l16 = lane & 15, tq = lane >> 4;
#pragma unroll
      for (int it4 = 0; it4 < 4; ++it4) { const int token = wave * 16 + it4 * 4 + tq; const bf16_t* vp = proj + (tok0 + token) * NPROJ + C_V + l16 * 8; float s1 = 0.f, s2 = 0.f;
          u32x4 w[4];
#pragma unroll
          for (int i = 0; i < 4; ++i) w[i] = *(const u32x4*)(vp + i * 128);
#pragma unroll
          for (int i = 0; i < 4; ++i)
#pragma unroll
              for (int e = 0; e < 4; ++e) { const float a = bflo(w[i][e]), bb = bfhi(w[i][e]); s1 += a + bb; s2 += a * a + bb * bb; }
#pragma unroll
          for (int o = 1; o < 16; o <<= 1) { s1 += __shfl_xor(s1, o); s2 += __shfl_xor(s2, o); }
          const float mean = s1 * (1.0f / 512.f); const float var = fmaxf(s2 * (1.0f / 512.f) - mean * mean, 0.f);
          if (l16 == 0) { stats[token * 2] = mean; stats[token * 2 + 1] = 1.0f / sqrtf(var + LN_EPS); } } }
    __syncthreads();
#pragma unroll
    for (int i = 0; i < 2; ++i) { const int sidx = lane + 64 * i; const float mean = stats[sidx * 2], rstd = stats[sidx * 2 + 1];
#pragma unroll
        for (int j = 0; j < 4; ++j)
#pragma unroll
            for (int e = 0; e < 4; ++e) { const int cl = 8 * j + 2 * e; const unsigned w = vv[i][j][e];
                const float a = (bflo(w) - mean) * rstd * p.sgu_g[ch0 + cl] + p.sgu_b[ch0 + cl], bb = (bfhi(w) - mean) * rstd * p.sgu_g[ch0 + cl + 1] + p.sgu_b[ch0 + cl + 1];
                vw[cl * VROW + sidx] = f2bf(a); vw[(cl + 1) * VROW + sidx] = f2bf(bb); } }
    asm volatile("" ::: "memory");
    const bf16_t* vrow = vw + c * VROW + hh * 8;
    float* reg = (float*)(lds + 74752 + wave * 4608);
#pragma unroll
    for (int tt = 0; tt < 4; ++tt) {
        const float bs = p.b_sp[g * CHUNK + tt * 32 + c];
        const int t2 = lane >> 1, half = lane & 1; const size_t tok = tok0 + tt * 32 + t2;
        const bf16_t* up = proj + tok * NPROJ + C_U + ch0 + half * 16; const bf16_t* zp = proj + tok * NPROJ + C_ZA + ch0 + half * 16; bf16_t* yp = yb + tok * D_MODEL + ch0 + half * 16;
        const u32x4 u0 = *(const u32x4*)(up), u1 = *(const u32x4*)(up + 8), z0 = *(const u32x4*)(zp), z1 = *(const u32x4*)(zp + 8);
        f32x16 acc = bcast16(0.f);
#pragma unroll
        for (int ks = 0; ks < 2 * (tt + 1); ++ks) { const bf16x8 af = *(const bf16x8*)(vrow + ks * 16); acc = __builtin_amdgcn_mfma_f32_32x32x16_bf16(af, wf[tt * (tt + 1) + ks], acc, 0, 0, 0); }
        f32x4 mv[4]; tile_transpose(reg, acc, bs, c, hh, lane, mv);
#pragma unroll
        for (int q = 0; q < 2; ++q) { const u32x4 uu = q ? u1 : u0, zz = q ? z1 : z0; const f32x4 a = mv[2 * q], b2 = mv[2 * q + 1]; u32x4 o;
            o[0] = cvt_pk_bf16(bflo(zz[0]) * bflo(uu[0]) * a[0], bfhi(zz[0]) * bfhi(uu[0]) * a[1]); o[1] = cvt_pk_bf16(bflo(zz[1]) * bflo(uu[1]) * a[2], bfhi(zz[1]) * bfhi(uu[1]) * a[3]);
            o[2] = cvt_pk_bf16(bflo(zz[2]) * bflo(uu[2]) * b2[0], bfhi(zz[2]) * bfhi(uu[2]) * b2[1]); o[3] = cvt_pk_bf16(bflo(zz[3]) * bflo(uu[3]) * b2[2], bfhi(zz[3]) * bfhi(uu[3]) * b2[3]);
            *(u32x4*)(yp + 8 * q) = o; }
    }
    __syncthreads();
}

__device__ void p_mixers(const Params& p, unsigned char* lds) {
    const int wave = __builtin_amdgcn_readfirstlane((int)threadIdx.x >> 6);
    for (int it = blockIdx.x; it < 256; it += gridDim.x) {
        const int xcd = it & 7, slot = it >> 3; const int bh = xcd * 8 + (slot >> 2), pr = slot & 3;
        for (int u = 0; u < 2; ++u) attn_wave_item(p, lds, bh >> 3, bh & 7, (u ? pr : 7 - pr) * 8 + wave);
    }
    __syncthreads();
    for (int it = blockIdx.x; it < 256; it += gridDim.x) sgu_item(p, lds, it >> 1, it & 1);
}

__device__ void p_ln(const Params& p) {
    int tid = threadIdx.x; asm volatile("" : "+v"(tid)); const int lane = tid & 63, wave = tid >> 6;
    for (int row = blockIdx.x * 8 + wave; row < NTOK; row += gridDim.x * 8) {
        float* rp = p.out + (size_t)row * D_MODEL; f32x4 v[4]; float s = 0.f;
#pragma unroll
        for (int j = 0; j < 4; ++j) { v[j] = *(const f32x4*)(rp + lane * 4 + 256 * j); s += (v[j][0] + v[j][1]) + (v[j][2] + v[j][3]); }
#pragma unroll
        for (int o = 32; o; o >>= 1) s += __shfl_xor(s, o);
        const float mu = s * (1.0f / 1024.f); float q = 0.f;
#pragma unroll
        for (int j = 0; j < 4; ++j) { const f32x4 d = v[j] - mu; q += (d[0] * d[0] + d[1] * d[1]) + (d[2] * d[2] + d[3] * d[3]); }
#pragma unroll
        for (int o = 32; o; o >>= 1) q += __shfl_xor(q, o);
        const float rstd = 1.0f / sqrtf(q * (1.0f / 1024.f) + LN_EPS);
#pragma unroll
        for (int j = 0; j < 4; ++j) { const int col = lane * 4 + 256 * j; const f32x4 g = *(const f32x4*)(p.ln_g + col), bb = *(const f32x4*)(p.ln_b + col);
            *(f32x4*)(rp + col) = (v[j] - mu) * rstd * g + bb; }
    }
}

#if MODE == 0
__global__ void __launch_bounds__(NT, 2) mega(Params p) {
    extern __shared__ __attribute__((aligned(16))) unsigned char lds[];
    volatile LAS unsigned* st = (volatile LAS unsigned*)((LAS unsigned char*)lds + 131072);
    if (threadIdx.x == 0) { st[0] = 0u; st[1] = 0u; st[2] = 0u; st[3] = 0u; }
    __syncthreads();
    const XcdBarrier bar = xcd_barrier_post((unsigned*)(p.ws + OFF_BAR), st);
    p0_prologue(p, lds); xcd_barrier(bar);
    p_hconv(p); xcd_barrier(bar);
    p_inproj(p, lds); xcd_barrier(bar);
    p_mixers(p, lds); xcd_barrier(bar);
    const bool fused = (gridDim.x == 256);
    p_outproj(p, lds, bar, fused);
    if (!fused) { cg::this_grid().sync(); p_ln(p); }
}
#else
__global__ void __launch_bounds__(NT, 2) mega(Params p) { extern __shared__ __attribute__((aligned(16))) unsigned char lds[]; p0_prologue(p, lds); }
__global__ void __launch_bounds__(NT, 2) k_ph1(Params p) { p_hconv(p); }
__global__ void __launch_bounds__(NT, 2) k_ph2(Params p) { extern __shared__ __attribute__((aligned(16))) unsigned char lds[]; p_inproj(p, lds); }
__global__ void __launch_bounds__(NT, 2) k_ph3(Params p) { extern __shared__ __attribute__((aligned(16))) unsigned char lds[]; p_mixers(p, lds); }
__global__ void __launch_bounds__(NT, 2) k_ph4(Params p) { extern __shared__ __attribute__((aligned(16))) unsigned char lds[]; XcdBarrier bar{}; p_outproj(p, lds, bar, false); }
__global__ void __launch_bounds__(NT, 2) k_ph5(Params p) { p_ln(p); }
#endif

extern "C" void kernel_launch(void* const* d_in, const int* in_sizes, int n_in, void* d_out, int out_size, void* d_ws, size_t ws_size, hipStream_t stream) {
    static int grid_blocks = 0;
    if (!grid_blocks) {
        int dev = 0, cus = 0, per_cu = 0;
        (void)hipGetDevice(&dev);
        (void)hipDeviceGetAttribute(&cus, hipDeviceAttributeMultiprocessorCount, dev);
        if (hipFuncSetAttribute((const void*)mega, hipFuncAttributeMaxDynamicSharedMemorySize, LDS_BYTES) != hipSuccess) fprintf(stderr, "hipFuncSetAttribute failed\n");
        if (hipOccupancyMaxActiveBlocksPerMultiprocessor(&per_cu, (const void*)mega, NT, LDS_BYTES) != hipSuccess || per_cu < 1) { fprintf(stderr, "occupancy query: %d\n", per_cu); per_cu = 1; }
        (void)hipGetLastError();
        if (per_cu > 1) per_cu = 1;
        grid_blocks = cus * per_cu;
    }
    Params p{};
    p.x = (const float*)d_in[0]; p.c = (const float*)d_in[1]; p.w_ada = (const float*)d_in[2]; p.b_ada = (const float*)d_in[3]; p.w_in = (const float*)d_in[4];
    p.sgu_g = (const float*)d_in[5]; p.sgu_b = (const float*)d_in[6]; p.w_sp = (const float*)d_in[7]; p.b_sp = (const float*)d_in[8]; p.w_out = (const float*)d_in[9];
    p.ln_g = (const float*)d_in[10]; p.ln_b = (const float*)d_in[11]; p.out = (float*)d_out; p.ws = (unsigned char*)d_ws; p.phase = 0; p.pad = 0;
#if MODE == 0
    (void)hipMemsetAsync((char*)d_ws + OFF_BAR, 0, XCD_BAR_WORDS * 4, stream);
    void* args[] = {&p};
    hipError_t e = hipLaunchCooperativeKernel((const void*)mega, dim3(grid_blocks), dim3(NT), args, LDS_BYTES, stream);
    if (e != hipSuccess) fprintf(stderr, "cooperative launch failed: %s (grid %d)\n", hipGetErrorString(e), grid_blocks);
#else
    hipFuncSetAttribute((const void*)k_ph2, hipFuncAttributeMaxDynamicSharedMemorySize, LDS_BYTES);
    hipFuncSetAttribute((const void*)k_ph3, hipFuncAttributeMaxDynamicSharedMemorySize, LDS_BYTES);
    hipFuncSetAttribute((const void*)k_ph4, hipFuncAttributeMaxDynamicSharedMemorySize, LDS_BYTES);
    hipLaunchKernelGGL(mega, dim3(grid_blocks), dim3(NT), LDS_BYTES, stream, p);
    hipLaunchKernelGGL(k_ph1, dim3(grid_blocks), dim3(NT), 0, stream, p);
    hipLaunchKernelGGL(k_ph2, dim3(grid_blocks), dim3(NT), LDS_BYTES, stream, p);
    hipLaunchKernelGGL(k_ph3, dim3(grid_blocks), dim3(NT), LDS_BYTES, stream, p);
    hipLaunchKernelGGL(k_ph4, dim3(grid_blocks), dim3(NT), LDS_BYTES, stream, p);
    hipLaunchKernelGGL(k_ph5, dim3(grid_blocks), dim3(NT), 0, stream, p);
#endif
}
```

```cpp
#include <hip/hip_runtime.h>
#include <hip/hip_cooperative_groups.h>
#include <cstdint>
#include <cstdio>
namespace cg = cooperative_groups;

#ifndef MODE
#define MODE 0
#endif

typedef unsigned short bf16_t;
typedef short bf16x8 __attribute__((ext_vector_type(8)));
typedef _Float16 f16x8 __attribute__((ext_vector_type(8)));
typedef float f32x4 __attribute__((ext_vector_type(4)));
typedef float f32x16 __attribute__((ext_vector_type(16)));
typedef unsigned u32x2 __attribute__((ext_vector_type(2)));
typedef unsigned u32x4 __attribute__((ext_vector_type(4)));

constexpr int D_MODEL = 1024, BATCH = 8, SEQ = 2048, NTOK = BATCH * SEQ;
constexpr int NPROJ = 3584, CHUNK = 128, NGRP = 8, NHEAD = 8;
constexpr int C_U = 0, C_V = 512, C_ZA = 1024, C_Q = 1536, C_K = 2048, C_VB = 2560, C_ZB = 3072;
constexpr float LN_EPS = 1e-5f;
constexpr float ALPHA = 1.189207115002721f;
constexpr float LOG2E = 1.4426950408889634f;
constexpr float QSCALE = 0.125f * LOG2E;
constexpr int NT = 512;
constexpr int LDS_BYTES = 131072 + 16;

__device__ __forceinline__ bf16_t f2bf(float f) { unsigned u = __float_as_uint(f); u += 0x7fffu + ((u >> 16) & 1u); return (bf16_t)(u >> 16); }
__device__ __forceinline__ float bf2f(bf16_t b) { return __uint_as_float(((unsigned)b) << 16); }
__device__ __forceinline__ float bflo(unsigned w) { return __uint_as_float(w << 16); }
__device__ __forceinline__ float bfhi(unsigned w) { return __uint_as_float(w & 0xffff0000u); }
typedef float f32x2_ __attribute__((ext_vector_type(2)));
typedef __bf16 bf16x2_ __attribute__((ext_vector_type(2)));
typedef _Float16 f16x2_ __attribute__((ext_vector_type(2)));
__device__ __forceinline__ unsigned cvt_pk_bf16(float lo, float hi) { f32x2_ v = {lo, hi}; return __builtin_bit_cast(unsigned, __builtin_convertvector(v, bf16x2_)); }
__device__ __forceinline__ unsigned cvt_pk_f16(float lo, float hi) { f32x2_ v = {lo, hi}; return __builtin_bit_cast(unsigned, __builtin_convertvector(v, f16x2_)); }
__device__ __forceinline__ float sigmoidf_(float v) { return __builtin_amdgcn_rcpf(1.0f + __builtin_amdgcn_exp2f(-v * LOG2E)); }
__device__ __forceinline__ float siluf_(float v) { return v * sigmoidf_(v); }
__device__ __forceinline__ float geluf_(float v) { return v * sigmoidf_(1.5957691216057308f * (v + 0.044715f * v * v * v)); }

constexpr size_t OFF_MOD = 0;
constexpr size_t OFF_HB = 1 << 20;
constexpr size_t OFF_WIN = OFF_HB + (size_t)NTOK * D_MODEL * 2;
constexpr size_t OFF_WOUT = OFF_WIN + (size_t)NPROJ * D_MODEL * 2;
constexpr size_t OFF_WSP = OFF_WOUT + (size_t)D_MODEL * D_MODEL * 2;
constexpr size_t OFF_PROJ = OFF_WSP + (size_t)NGRP * CHUNK * CHUNK * 2;
constexpr size_t OFF_Y = OFF_PROJ + (size_t)NTOK * NPROJ * 2;

struct Params {
    const float* x; const float* c; const float* w_ada; const float* b_ada; const float* w_in; const float* sgu_g; const float* sgu_b;
    const float* w_sp; const float* b_sp; const float* w_out; const float* ln_g; const float* ln_b;
    float* out; unsigned char* ws; int phase; int pad;
};


#define XB_TMO      128
#define XB_XCNT(j)  (256  + 64 * (j))
#define XB_XSUB(j)  (1280 + 64 * (j))
#define XB_XGEN(j)  (2304 + 64 * (j))
#define XB_TOP      3328
#define XB_TOPGEN   3392
#define XCD_BAR_WORDS 3456
#define XB_SPIN_CAP (1u << 18)
#define LAS __attribute__((address_space(3)))
__device__ __forceinline__ unsigned xb_ld(unsigned* p)              { return __hip_atomic_load(p, __ATOMIC_RELAXED, __HIP_MEMORY_SCOPE_AGENT); }
__device__ __forceinline__ unsigned xb_add(unsigned* p, unsigned v) { return __hip_atomic_fetch_add(p, v, __ATOMIC_RELAXED, __HIP_MEMORY_SCOPE_AGENT); }
__device__ __forceinline__ unsigned xb_xcc_id() { return (unsigned)__builtin_amdgcn_s_getreg((3 << 11) | 20) & 0xFu; }
#define XB_SPIN(cond, bar) do { unsigned _sp = 0; while (cond) { __builtin_amdgcn_s_sleep(1); \
    if ((++_sp & 255u) == 0u) { if (xb_ld(&(bar)[XB_TMO])) break; if (_sp > XB_SPIN_CAP) { atomicAdd(&(bar)[XB_TMO], 1u); break; } } } } while (0)
struct XcdBarrier { unsigned* bar; unsigned x; volatile LAS unsigned* st; };
__device__ __forceinline__ XcdBarrier xcd_barrier_post(unsigned* bar, volatile LAS unsigned* st) {
    XcdBarrier b; b.bar = bar; b.x = xb_xcc_id(); b.st = st;
    if (threadIdx.x == 0) (void)xb_add(&bar[XB_XCNT(b.x)], 1u);
    return b;
}
__device__ __forceinline__ void xcd_barrier_complete(unsigned* bar, unsigned x, unsigned& nloc, unsigned& nx) {
    const unsigned G = gridDim.x * gridDim.y * gridDim.z;
    unsigned sum, cnt, mine, sp = 0u;
    for (;;) {
        sum = 0u; cnt = 0u; mine = 0u;
#pragma unroll
        for (unsigned j = 0; j < 16; ++j) { const unsigned c = xb_ld(&bar[XB_XCNT(j)]); sum += c; cnt += (c > 0u) ? 1u : 0u; mine = (j == x) ? c : mine; }
        if (sum == G) break;
        __builtin_amdgcn_s_sleep(1);
        if ((++sp & 255u) == 0u) { if (xb_ld(&bar[XB_TMO])) break; if (sp > XB_SPIN_CAP) { atomicAdd(&bar[XB_TMO], 1u); break; } }
    }
    nloc = mine > 0u ? mine : 1u; nx = cnt > 0u ? cnt : 1u;
}
__device__ __forceinline__ void xcd_barrier(const XcdBarrier& b) {
    asm volatile("s_waitcnt vmcnt(0)" ::: "memory");
    __syncthreads();
    if (threadIdx.x == 0) {
        unsigned* bar = b.bar;
        __builtin_amdgcn_s_waitcnt(0);
        unsigned nloc = b.st[0], nx = b.st[1];
        if (nloc == 0u) { xcd_barrier_complete(bar, b.x, nloc, nx); b.st[0] = nloc; b.st[1] = nx; }
        const unsigned old = xb_add(&bar[XB_XSUB(b.x)], 1u);
        const unsigned gen = old / nloc;
        if (old + 1u == (gen + 1u) * nloc) {
            __builtin_amdgcn_fence(__ATOMIC_RELEASE, "agent");
            asm volatile("s_waitcnt vmcnt(0)" ::: "memory");
            const unsigned og = xb_add(&bar[XB_TOP], 1u);
            const unsigned tg = og / nx;
            if (og + 1u == (tg + 1u) * nx) xb_add(&bar[XB_TOPGEN], 1u);
            else XB_SPIN(xb_ld(&bar[XB_TOPGEN]) == tg, bar);
            __builtin_amdgcn_fence(__ATOMIC_ACQUIRE, "agent");
            xb_add(&bar[XB_XGEN(b.x)], 1u);
            asm volatile("s_waitcnt vmcnt(0)" ::: "memory");
        } else {
            XB_SPIN(xb_ld(&bar[XB_XGEN(b.x)]) == gen, bar);
            __builtin_amdgcn_fence(__ATOMIC_ACQUIRE, "agent");
            asm volatile("s_waitcnt vmcnt(0)" ::: "memory");
        }
    }
    __syncthreads();
}
constexpr size_t OFF_BAR = 128 * 1024;

__device__ void p0_prologue(const Params& p, unsigned char* lds) {
    int tid = threadIdx.x; asm volatile("" : "+v"(tid)); const int lane = tid & 63, wave = tid >> 6;
    float* mod = (float*)(p.ws + OFF_MOD);
    float* sc = (float*)lds;
    float* red = (float*)(lds + 32768);
    for (int it = blockIdx.x; it < 96; it += gridDim.x) {
        for (int i = tid; i < 8 * 1024; i += NT) sc[i] = siluf_(p.c[i]);
        __syncthreads();
        const int q = tid & 7, r = tid >> 3; const int c0 = it * 32 + q * 4;
        float acc[8][4];
#pragma unroll
        for (int b = 0; b < 8; ++b) { acc[b][0] = 0.f; acc[b][1] = 0.f; acc[b][2] = 0.f; acc[b][3] = 0.f; }
        f32x4 wv[16];
#pragma unroll
        for (int i = 0; i < 16; ++i) wv[i] = __builtin_nontemporal_load((const f32x4*)(p.w_ada + (size_t)(r + 64 * i) * 3072 + c0));
#pragma unroll
        for (int i = 0; i < 16; ++i) { const int k = r + 64 * i; const f32x4 w = wv[i];
#pragma unroll
            for (int b = 0; b < 8; ++b) { const float s = sc[b * 1024 + k]; acc[b][0] += s * w[0]; acc[b][1] += s * w[1]; acc[b][2] += s * w[2]; acc[b][3] += s * w[3]; } }
#pragma unroll
        for (int b = 0; b < 8; ++b)
#pragma unroll
            for (int j = 0; j < 4; ++j) { float v = acc[b][j]; v += __shfl_xor(v, 8); v += __shfl_xor(v, 16); v += __shfl_xor(v, 32); acc[b][j] = v; }
        if (lane < 8) {
#pragma unroll
            for (int b = 0; b < 8; ++b)
#pragma unroll
                for (int j = 0; j < 4; ++j) red[(wave * 8 + q) * 32 + b * 4 + j] = acc[b][j];
        }
        __syncthreads();
        if (tid < 256) { const int b = tid >> 5, col = tid & 31, qq = col >> 2, j = col & 3; float s = 0.f;
#pragma unroll
            for (int w = 0; w < 8; ++w) s += red[(w * 8 + qq) * 32 + b * 4 + j];
            mod[b * 3072 + it * 32 + col] = s + p.b_ada[it * 32 + col]; }
        __syncthreads();
    }
    float* tb = (float*)(lds + 49152);
    {   const int n4 = tid & 15, kk = tid >> 4;
        f32x4 v0, v1; int tile = blockIdx.x;
        auto tile_src = [&](int tl, const float*& W, bf16_t*& Wt, int& N, int& k0, int& n0) {
            if (tl < 896) { W = p.w_in; Wt = (bf16_t*)(p.ws + OFF_WIN); N = NPROJ; k0 = (tl / 56) * 64; n0 = (tl % 56) * 64; }
            else { const int t2 = tl - 896; W = p.w_out; Wt = (bf16_t*)(p.ws + OFF_WOUT); N = D_MODEL; k0 = (t2 / 16) * 64; n0 = (t2 % 16) * 64; } };
        if (tile < 896 + 256) { const float* W; bf16_t* Wt; int N, k0, n0; tile_src(tile, W, Wt, N, k0, n0);
            v0 = __builtin_nontemporal_load((const f32x4*)(W + (size_t)(k0 + kk) * N + n0 + n4 * 4)); v1 = __builtin_nontemporal_load((const f32x4*)(W + (size_t)(k0 + kk + 32) * N + n0 + n4 * 4)); }
        for (; tile < 896 + 256; tile += gridDim.x) {
            const float* W; bf16_t* Wt; int N, k0, n0; tile_src(tile, W, Wt, N, k0, n0);
            tb[kk * 65 + n4 * 4 + 0] = v0[0]; tb[kk * 65 + n4 * 4 + 1] = v0[1]; tb[kk * 65 + n4 * 4 + 2] = v0[2]; tb[kk * 65 + n4 * 4 + 3] = v0[3];
            tb[(kk + 32) * 65 + n4 * 4 + 0] = v1[0]; tb[(kk + 32) * 65 + n4 * 4 + 1] = v1[1]; tb[(kk + 32) * 65 + n4 * 4 + 2] = v1[2]; tb[(kk + 32) * 65 + n4 * 4 + 3] = v1[3];
            __syncthreads();
            const int nt2 = tile + gridDim.x;
            if (nt2 < 896 + 256) { const float* W2; bf16_t* Wt2; int N2, k02, n02; tile_src(nt2, W2, Wt2, N2, k02, n02);
                v0 = __builtin_nontemporal_load((const f32x4*)(W2 + (size_t)(k02 + kk) * N2 + n02 + n4 * 4)); v1 = __builtin_nontemporal_load((const f32x4*)(W2 + (size_t)(k02 + kk + 32) * N2 + n02 + n4 * 4)); }
            { const int n = tid >> 3, ks = tid & 7; u32x4 o;
              o[0] = cvt_pk_bf16(tb[(ks * 8 + 0) * 65 + n], tb[(ks * 8 + 1) * 65 + n]); o[1] = cvt_pk_bf16(tb[(ks * 8 + 2) * 65 + n], tb[(ks * 8 + 3) * 65 + n]);
              o[2] = cvt_pk_bf16(tb[(ks * 8 + 4) * 65 + n], tb[(ks * 8 + 5) * 65 + n]); o[3] = cvt_pk_bf16(tb[(ks * 8 + 6) * 65 + n], tb[(ks * 8 + 7) * 65 + n]);
              *(u32x4*)(Wt + (size_t)(n0 + n) * D_MODEL + k0 + ks * 8) = o; }
            __syncthreads();
        }
    }
    bf16_t* wsp = (bf16_t*)(p.ws + OFF_WSP);
    for (int i = blockIdx.x * NT + tid; i < NGRP * CHUNK * CHUNK / 8; i += gridDim.x * NT) {
        const int frag = i >> 6, l = i & 63, g = frag >> 5, tt = (frag >> 3) & 3, ks = frag & 7;
        const int t = tt * 32 + (l & 31), s0 = ks * 16 + (l >> 5) * 8; const int e = (g * CHUNK + t) * CHUNK + s0;
        const f32x4 a = *(const f32x4*)(p.w_sp + e), b = *(const f32x4*)(p.w_sp + e + 4);
        float v[8] = {a[0], a[1], a[2], a[3], b[0], b[1], b[2], b[3]};
#pragma unroll
        for (int j = 0; j < 8; ++j) v[j] = (s0 + j <= t) ? v[j] : 0.f;
        u32x4 o; o[0] = cvt_pk_bf16(v[0], v[1]); o[1] = cvt_pk_bf16(v[2], v[3]); o[2] = cvt_pk_bf16(v[4], v[5]); o[3] = cvt_pk_bf16(v[6], v[7]);
        *(u32x4*)(wsp + (size_t)i * 8) = o;
    }
}

__device__ void p_hconv(const Params& p) {
    const float* mod = (const float*)(p.ws + OFF_MOD); bf16_t* hb = (bf16_t*)(p.ws + OFF_HB);
    int tid = threadIdx.x; asm volatile("" : "+v"(tid));
    const size_t stride = (size_t)gridDim.x * NT, total = (size_t)NTOK * D_MODEL / 8;
    for (size_t i0 = (size_t)blockIdx.x * NT + tid; i0 < total; i0 += 4 * stride) {
        f32x4 x0[4], x1[4];
#pragma unroll
        for (int u = 0; u < 4; ++u) { const size_t i = i0 + u * stride; if (i < total) { x0[u] = __builtin_nontemporal_load((const f32x4*)(p.x + i * 8)); x1[u] = __builtin_nontemporal_load((const f32x4*)(p.x + i * 8 + 4)); } }
#pragma unroll
        for (int u = 0; u < 4; ++u) { const size_t i = i0 + u * stride; if (i < total) {
            const size_t e = i * 8; const int col = (int)(e & 1023); const int b = (int)(e >> 21);
            const f32x4 sh0 = *(const f32x4*)(mod + b * 3072 + col), sh1 = *(const f32x4*)(mod + b * 3072 + col + 4);
            const f32x4 sc0 = *(const f32x4*)(mod + b * 3072 + 1024 + col), sc1 = *(const f32x4*)(mod + b * 3072 + 1024 + col + 4);
            const f32x4 h0 = x0[u] * (1.0f + sc0) + sh0, h1 = x1[u] * (1.0f + sc1) + sh1;
            u32x4 o; o[0] = cvt_pk_bf16(h0[0], h0[1]); o[1] = cvt_pk_bf16(h0[2], h0[3]); o[2] = cvt_pk_bf16(h1[0], h1[1]); o[3] = cvt_pk_bf16(h1[2], h1[3]);
            *(u32x4*)(hb + e) = o; } }
    }
}

constexpr int BM = 256, BK = 64, HALF = 128, NXCD = 8, WGM = 8, HT = HALF * BK;
__device__ __forceinline__ int lds_byte(int r, int c) { int st = (r >> 4) * 2 + (c >> 5), rr = r & 15, cc = c & 31, ob = rr * 64 + cc * 2; return st * 1024 + (ob ^ (((ob >> 9) & 1) << 5)); }
__device__ __forceinline__ void stage_rc(int b, int& R, int& C) { int st = b / 1024, sb = b % 1024, swz = sb ^ (((sb >> 9) & 1) << 5); R = (st >> 1) * 16 + swz / 64; C = (st & 1) * 32 + (swz % 64) / 2; }

struct TileOrder {
    int nM, nN, nwg, G, c;
    __device__ void init(int M, int N, int G_, int c_) { nM = M / BM; nN = N / BM; nwg = nM * nN; G = G_; c = c_; }
    __device__ bool next(int i, int& pm, int& pn) const { const long L = (long)i * G + c; if (L >= nwg) return false; map((int)L, pm, pn); return true; }
    __device__ void map(int L, int& pm, int& pn) const {
        int wgid = L; { const int q = nwg / NXCD, r = nwg % NXCD, xcd = wgid % NXCD, off = wgid / NXCD; wgid = (xcd < r ? xcd * (q + 1) : r * (q + 1) + (xcd - r) * q) + off; }
        const int nig = WGM * nN, gid = wgid / nig, fm = gid * WGM, gsz = (nM - fm) < WGM ? (nM - fm) : WGM;
        pm = fm + ((wgid % nig) % gsz); pn = (wgid % nig) / gsz;
    }
};

__device__ __forceinline__ void gemm_tile(const bf16_t* __restrict__ A, const bf16_t* __restrict__ Bt, const int K, const int brow, const int bcol, bf16_t* shm, f32x4 (&acc)[2][2][4][2], const bool half = false) {
#define SA(b, h) (shm + ((b) * 2 + (h)) * HT)
#define SB(b, h) (shm + (4 + (b) * 2 + (h)) * HT)
#define STAGE(P, BASE, br, kt) do { const char* _gb = (const char*)(BASE) + ((size_t)(br) * K + (size_t)(kt) * BK) * 2; \
    for (int _i = 0; _i < 2; ++_i) { int _b = gtx * 16 + _i * 8192; \
      __builtin_amdgcn_global_load_lds((const unsigned*)(_gb + soff[_i]), (__attribute__((address_space(3))) unsigned*)((char*)(P) + _b), 16, 0, 0); } } while (0)
#define LDA(dst, b, h) for (int m = 0; m < 4; ++m) for (int k = 0; k < 2; ++k) \
    dst[m][k] = *reinterpret_cast<const bf16x8*>((char*)SA(b, h) + lds_byte(wr * 64 + m * 16 + fr, k * 32 + fq * 8))
#define LDB(dst, b, h) for (int n = 0; n < 2; ++n) for (int k = 0; k < 2; ++k) \
    dst[n][k] = *reinterpret_cast<const bf16x8*>((char*)SB(b, h) + lds_byte(wc * 32 + n * 16 + fr, k * 32 + fq * 8))
#define MMA(ai, bj, At_, Bt_) do { __builtin_amdgcn_s_setprio(1); \
    for (int m = 0; m < 4; ++m) for (int n = 0; n < 2; ++n) for (int k = 0; k < 2; ++k) \
      acc[ai][bj][m][n] = __builtin_amdgcn_mfma_f32_16x16x32_bf16(Bt_[n][k], At_[m][k], acc[ai][bj][m][n], 0, 0, 0); \
    __builtin_amdgcn_s_setprio(0); } while (0)
#define WAIT_V(n) asm volatile("s_waitcnt vmcnt(" #n ")" ::: "memory")
#define WAIT_L(n) asm volatile("s_waitcnt lgkmcnt(" #n ")" ::: "memory")
#define BAR __builtin_amdgcn_s_barrier()
#define SCHED __builtin_amdgcn_sched_barrier(0)
    int gtx = threadIdx.x; asm volatile("" : "+v"(gtx));
    const int wid = gtx >> 6, lane = gtx & 63, wr = __builtin_amdgcn_readfirstlane(wid >> 2), wc = wid & 3, fr = lane & 15, fq = lane >> 4;
#pragma unroll
    for (int a = 0; a < 2; ++a)
#pragma unroll
        for (int b = 0; b < 2; ++b)
#pragma unroll
            for (int m = 0; m < 4; ++m)
#pragma unroll
                for (int n = 0; n < 2; ++n) acc[a][b][m][n] = (f32x4){0.f, 0.f, 0.f, 0.f};
    bf16x8 At[4][2], B0[2][2], B1[2][2];
    unsigned soff[2];
    for (int _i = 0; _i < 2; ++_i) { int _r, _c; stage_rc(gtx * 16 + _i * 8192, _r, _c); soff[_i] = (unsigned)(_r * K + _c) * 2u; }
    const int nt = K / BK;
    STAGE(SB(0, 0), Bt, bcol, 0); STAGE(SA(0, 0), A, brow, 0);
    STAGE(SB(0, 1), Bt, bcol + HALF, 0); STAGE(SA(0, 1), A, brow + HALF, 0);
    if (wr == 1) BAR;
    WAIT_V(4); BAR;
    STAGE(SB(1, 0), Bt, bcol, 1); STAGE(SA(1, 0), A, brow, 1); STAGE(SB(1, 1), Bt, bcol + HALF, 1);
    WAIT_V(6); BAR;
    for (int t = 0; t < nt - 2; t += 2) {
        LDB(B0, 0, 0); SCHED; LDA(At, 0, 0); STAGE(SA(1, 1), A, brow + HALF, t + 1);
        WAIT_L(8); BAR; WAIT_L(0); MMA(0, 0, At, B0); BAR; SCHED;
        LDB(B1, 0, 1); STAGE(SB(0, 0), Bt, bcol, t + 2);
        BAR; WAIT_L(0); MMA(0, 1, At, B1); BAR;
        if (!half) { LDA(At, 0, 1); } STAGE(SA(0, 0), A, brow, t + 2);
        BAR; WAIT_L(0); if (!half) { MMA(1, 0, At, B0); } BAR; SCHED;
        STAGE(SB(0, 1), Bt, bcol + HALF, t + 2);
        WAIT_V(6); BAR; if (!half) { MMA(1, 1, At, B1); } BAR;
        LDB(B0, 1, 0); SCHED; LDA(At, 1, 0); STAGE(SA(0, 1), A, brow + HALF, t + 2);
        WAIT_L(8); BAR; WAIT_L(0); MMA(0, 0, At, B0); BAR; SCHED;
        LDB(B1, 1, 1); STAGE(SB(1, 0), Bt, bcol, t + 3);
        BAR; WAIT_L(0); MMA(0, 1, At, B1); BAR;
        if (!half) { LDA(At, 1, 1); } STAGE(SA(1, 0), A, brow, t + 3);
        BAR; WAIT_L(0); if (!half) { MMA(1, 0, At, B0); } BAR; SCHED;
        STAGE(SB(1, 1), Bt, bcol + HALF, t + 3);
        WAIT_V(6); BAR; if (!half) { MMA(1, 1, At, B1); } BAR;
    }
    { LDB(B0, 0, 0); LDA(At, 0, 0); STAGE(SA(1, 1), A, brow + HALF, nt - 1);
      BAR; WAIT_L(0); MMA(0, 0, At, B0); BAR;
      LDB(B1, 0, 1); BAR; WAIT_L(0); MMA(0, 1, At, B1); BAR;
      if (!half) { LDA(At, 0, 1); } WAIT_V(4); BAR; WAIT_L(0); if (!half) { MMA(1, 0, At, B0); MMA(1, 1, At, B1); } BAR; }
    { LDB(B0, 1, 0); LDA(At, 1, 0); WAIT_V(2); BAR; WAIT_L(0); MMA(0, 0, At, B0); BAR;
      LDB(B1, 1, 1); WAIT_V(0); BAR; WAIT_L(0); MMA(0, 1, At, B1); BAR;
      if (!half) { LDA(At, 1, 1); } BAR; WAIT_L(0); if (!half) { MMA(1, 0, At, B0); MMA(1, 1, At, B1); } BAR; }
    if (wr == 0) BAR;
#undef SA
#undef SB
#undef STAGE
#undef LDA
#undef LDB
#undef MMA
}

__device__ void p_inproj(const Params& p, unsigned char* lds) {
    const bf16_t* hb = (const bf16_t*)(p.ws + OFF_HB); const bf16_t* winT = (const bf16_t*)(p.ws + OFF_WIN); bf16_t* proj = (bf16_t*)(p.ws + OFF_PROJ);
    TileOrder ord; ord.init(NTOK, NPROJ, gridDim.x, blockIdx.x);
    const int G = gridDim.x, rem = ord.nwg % G, nsplit = (rem > 0 && 2 * rem <= G) ? rem : 0, nfull = ord.nwg - nsplit, nunits = nfull + 2 * nsplit;
    for (int i = 0;; ++i) {
        const int u = i * G + (int)blockIdx.x; if (u >= nunits) break;
        int pm, pn; const bool half = (u >= nfull); const int hsel = half ? ((u - nfull) & 1) : 0;
        ord.map(half ? nfull + ((u - nfull) >> 1) : u, pm, pn);
        f32x4 acc[2][2][4][2];
        gemm_tile(hb, winT, D_MODEL, pm * BM + hsel * HALF, pn * BM, (bf16_t*)lds, acc, half);
        int tx = threadIdx.x; asm volatile("" : "+v"(tx));
        const int wid = tx >> 6, lane = tx & 63, wr = wid >> 2, wc = wid & 3, fr = lane & 15, fq = lane >> 4;
        const int seg = pn >> 1;
#pragma unroll
        for (int ai = 0; ai < 2; ++ai) {
            if (half && ai == 1) break;
#pragma unroll
            for (int m = 0; m < 4; ++m) {
                const int row = pm * BM + hsel * HALF + ai * HALF + wr * 64 + m * 16 + fr;
                bf16_t* rowp = proj + (size_t)row * NPROJ + pn * BM + wc * 32 + fq * 4;
#pragma unroll
                for (int bj = 0; bj < 2; ++bj)
#pragma unroll
                    for (int n = 0; n < 2; ++n) {
                        f32x4 v = acc[ai][bj][m][n];
                        if (seg <= 1) { v[0] = geluf_(v[0]); v[1] = geluf_(v[1]); v[2] = geluf_(v[2]); v[3] = geluf_(v[3]); }
                        else if (seg == 2 || seg == 6) { v[0] = siluf_(v[0]); v[1] = siluf_(v[1]); v[2] = siluf_(v[2]); v[3] = siluf_(v[3]); }
                        else if (seg == 3) { v = v * QSCALE; }
                        u32x2 o; o[0] = cvt_pk_bf16(v[0], v[1]); o[1] = cvt_pk_bf16(v[2], v[3]);
                        *(u32x2*)(rowp + bj * HALF + n * 16) = o;
                    }
            }
        }
        asm volatile("s_waitcnt vmcnt(0)" ::: "memory");
    }
}

constexpr size_t OFF_STATS = 256 * 1024;
__device__ void p_outproj(const Params& p, unsigned char* lds, const XcdBarrier& bar, const bool fused) {
    const bf16_t* yb = (const bf16_t*)(p.ws + OFF_Y); const bf16_t* woutT = (const bf16_t*)(p.ws + OFF_WOUT); const float* mod = (const float*)(p.ws + OFF_MOD);
    TileOrder ord; ord.init(NTOK, D_MODEL, gridDim.x, blockIdx.x);
    for (int i = 0;; ++i) {
        int pm, pn; if (!ord.next(i, pm, pn)) break;
        f32x4 acc[2][2][4][2];
        gemm_tile(yb, woutT, D_MODEL, pm * BM, pn * BM, (bf16_t*)lds, acc);
        int tx = threadIdx.x; asm volatile("" : "+v"(tx));
        const int wid = tx >> 6, lane = tx & 63, wr = wid >> 2, wc = wid & 3, fr = lane & 15, fq = lane >> 4;
        const int b = (pm * BM) / SEQ; const int col0 = pn * BM + wc * 32 + fq * 4;
        {   f32x4 gate[2][2];
#pragma unroll
            for (int bj = 0; bj < 2; ++bj)
#pragma unroll
                for (int n = 0; n < 2; ++n) gate[bj][n] = *(const f32x4*)(mod + b * 3072 + 2048 + col0 + bj * HALF + n * 16);
#pragma unroll
            for (int ai = 0; ai < 2; ++ai) {
                f32x4 xv[4][2][2];
#pragma unroll
                for (int m = 0; m < 4; ++m) { const size_t off = (size_t)(pm * BM + ai * HALF + wr * 64 + m * 16 + fr) * D_MODEL + col0;
#pragma unroll
                    for (int bj = 0; bj < 2; ++bj)
#pragma unroll
                        for (int n = 0; n < 2; ++n) xv[m][bj][n] = __builtin_nontemporal_load((const f32x4*)(p.x + off + bj * HALF + n * 16)); }
#pragma unroll
                for (int m = 0; m < 4; ++m)
#pragma unroll
                    for (int bj = 0; bj < 2; ++bj)
#pragma unroll
                        for (int n = 0; n < 2; ++n) acc[ai][bj][m][n] = xv[m][bj][n] * ALPHA + gate[bj][n] * acc[ai][bj][m][n];
            } }
        if (!fused) {
#pragma unroll
            for (int ai = 0; ai < 2; ++ai)
#pragma unroll
                for (int m = 0; m < 4; ++m) { const size_t off = (size_t)(pm * BM + ai * HALF + wr * 64 + m * 16 + fr) * D_MODEL + col0;
#pragma unroll
                    for (int bj = 0; bj < 2; ++bj)
#pragma unroll
                        for (int n = 0; n < 2; ++n) *(f32x4*)(p.out + off + bj * HALF + n * 16) = acc[ai][bj][m][n]; }
            asm volatile("s_waitcnt vmcnt(0)" ::: "memory");
            continue;
        }
        float* P = (float*)lds;
        float* S = (float*)(lds + 8192);
        float* gstats = (float*)(p.ws + OFF_STATS);
#pragma unroll
        for (int ai = 0; ai < 2; ++ai)
#pragma unroll
            for (int m = 0; m < 4; ++m) { float s1 = 0.f, s2 = 0.f;
#pragma unroll
                for (int bj = 0; bj < 2; ++bj)
#pragma unroll
                    for (int n = 0; n < 2; ++n) { const f32x4 v = acc[ai][bj][m][n]; s1 += (v[0] + v[1]) + (v[2] + v[3]); s2 += (v[0] * v[0] + v[1] * v[1]) + (v[2] * v[2] + v[3] * v[3]); }
                s1 += __shfl_xor(s1, 16); s2 += __shfl_xor(s2, 16); s1 += __shfl_xor(s1, 32); s2 += __shfl_xor(s2, 32);
                if (fq == 0) { const int rl = ai * HALF + wr * 64 + m * 16 + fr; P[(rl * 4 + wc) * 2] = s1; P[(rl * 4 + wc) * 2 + 1] = s2; } }
        __syncthreads();
        if (tx < 256) { const f32x4 a = *(const f32x4*)(P + tx * 8), c2 = *(const f32x4*)(P + tx * 8 + 4);
            float* gp = gstats + ((size_t)(pm * BM + tx) * 4 + pn) * 2; gp[0] = (a[0] + a[2]) + (c2[0] + c2[2]); gp[1] = (a[1] + a[3]) + (c2[1] + c2[3]); }
        xcd_barrier(bar);
        if (tx < 256) { const float* gp = gstats + (size_t)(pm * BM + tx) * 8; const f32x4 a = *(const f32x4*)gp, c2 = *(const f32x4*)(gp + 4);
            const float mean = ((a[0] + a[2]) + (c2[0] + c2[2])) * (1.0f / 1024.f); const float ex2 = ((a[1] + a[3]) + (c2[1] + c2[3])) * (1.0f / 1024.f);
            const float var = fmaxf(ex2 - mean * mean, 0.f); S[tx * 2] = mean; S[tx * 2 + 1] = 1.0f / sqrtf(var + LN_EPS); }
        __syncthreads();
        {   f32x4 gg[2][2], bb[2][2];
#pragma unroll
            for (int bj = 0; bj < 2; ++bj)
#pragma unroll
                for (int n = 0; n < 2; ++n) { gg[bj][n] = *(const f32x4*)(p.ln_g + col0 + bj * HALF + n * 16); bb[bj][n] = *(const f32x4*)(p.ln_b + col0 + bj * HALF + n * 16); }
#pragma unroll
            for (int ai = 0; ai < 2; ++ai)
#pragma unroll
                for (int m = 0; m < 4; ++m) { const int rl = ai * HALF + wr * 64 + m * 16 + fr; const float mean = S[rl * 2], rstd = S[rl * 2 + 1];
                    const size_t off = (size_t)(pm * BM + rl) * D_MODEL + col0;
#pragma unroll
                    for (int bj = 0; bj < 2; ++bj)
#pragma unroll
                        for (int n = 0; n < 2; ++n) __builtin_nontemporal_store((acc[ai][bj][m][n] - mean) * rstd * gg[bj][n] + bb[bj][n], (f32x4*)(p.out + off + bj * HALF + n * 16)); } }
    }
}

constexpr int KROW = 72;
__device__ __forceinline__ float relu_(float x) { int i = __builtin_bit_cast(int, x); i = i > 0 ? i : 0; return __builtin_bit_cast(float, i); }
__device__ __forceinline__ void softplus_pack(const f32x16& z, f16x8 (&lf)[2]) {
    unsigned w[8];
#pragma unroll
    for (int i = 0; i < 8; ++i) {
        const float z0 = z[2 * i], z1 = z[2 * i + 1];
        const float l0 = __builtin_amdgcn_logf(1.0f + __builtin_amdgcn_exp2f(-__builtin_fabsf(z0))), l1 = __builtin_amdgcn_logf(1.0f + __builtin_amdgcn_exp2f(-__builtin_fabsf(z1)));
        w[i] = cvt_pk_f16(relu_(z0) + l0, relu_(z1) + l1);
    }
    u32x4 t0 = {w[0], w[1], w[2], w[3]}, t1 = {w[4], w[5], w[6], w[7]};
    lf[0] = __builtin_bit_cast(f16x8, t0); lf[1] = __builtin_bit_cast(f16x8, t1);
}
__device__ __forceinline__ void expo_pack(const f32x16& z, const f32x16& cum, bf16x8 (&pf)[2]) {
    unsigned w[8];
#pragma unroll
    for (int i = 0; i < 8; ++i) w[i] = cvt_pk_bf16(__builtin_amdgcn_exp2f(z[2 * i] + cum[2 * i]), __builtin_amdgcn_exp2f(z[2 * i + 1] + cum[2 * i + 1]));
    u32x4 t0 = {w[0], w[1], w[2], w[3]}, t1 = {w[4], w[5], w[6], w[7]};
    pf[0] = __builtin_bit_cast(bf16x8, t0); pf[1] = __builtin_bit_cast(bf16x8, t1);
}
__device__ __forceinline__ void exp_pack(const f32x16& e, bf16x8 (&pf)[2]) {
    unsigned w[8];
#pragma unroll
    for (int i = 0; i < 8; ++i) w[i] = cvt_pk_bf16(__builtin_amdgcn_exp2f(e[2 * i]), __builtin_amdgcn_exp2f(e[2 * i + 1]));
    u32x4 t0 = {w[0], w[1], w[2], w[3]}, t1 = {w[4], w[5], w[6], w[7]};
    pf[0] = __builtin_bit_cast(bf16x8, t0); pf[1] = __builtin_bit_cast(bf16x8, t1);
}
__device__ __forceinline__ f32x16 bcast16(float v) { f32x16 r;
#pragma unroll
    for (int i = 0; i < 16; ++i) r[i] = v;
    return r; }

__device__ __forceinline__ void tile_transpose(float* reg, const f32x16& acc, const float add, const int c, const int hh, const int lane, f32x4 (&out)[4]) {
    asm volatile("" ::: "memory");
#pragma unroll
    for (int g4 = 0; g4 < 4; ++g4) { f32x4 v = {acc[4 * g4 + 0] + add, acc[4 * g4 + 1] + add, acc[4 * g4 + 2] + add, acc[4 * g4 + 3] + add}; *(f32x4*)(reg + c * 36 + 8 * g4 + 4 * hh) = v; }
    asm volatile("" ::: "memory");
    const int t = lane >> 1, half = lane & 1;
#pragma unroll
    for (int j = 0; j < 4; ++j) out[j] = *(const f32x4*)(reg + t * 36 + half * 16 + 4 * j);
    asm volatile("" ::: "memory");
}

constexpr int VTROW = 40;
__device__ __forceinline__ void attn_wave_item(const Params& p, unsigned char* lds, const int b, const int h, const int qblk) {
    const bf16_t* proj = (const bf16_t*)(p.ws + OFF_PROJ); bf16_t* yb = (bf16_t*)(p.ws + OFF_Y);
    int tid = threadIdx.x; asm volatile("" : "+v"(tid)); const int lane = tid & 63, wave = __builtin_amdgcn_readfirstlane(tid >> 6), c = lane & 31, hh = lane >> 5;
    bf16_t* Kw = (bf16_t*)(lds + wave * 9728);
    bf16_t* Vt = (bf16_t*)(lds + wave * 9728 + 4608);
    const size_t tokbase = (size_t)b * SEQ; const int tq0 = qblk * 32;
    bf16x8 qf[4];
    { const bf16_t* qp = proj + (tokbase + tq0 + c) * NPROJ + C_Q + h * 64 + hh * 8;
#pragma unroll
      for (int ks = 0; ks < 4; ++ks) qf[ks] = *(const bf16x8*)(qp + ks * 16); }
    f16x8 uf[2];
#pragma unroll
    for (int ks2 = 0; ks2 < 2; ++ks2)
#pragma unroll
        for (int jj = 0; jj < 8; ++jj) { const int key = 16 * ks2 + 8 * (jj >> 2) + 4 * hh + (jj & 3); uf[ks2][jj] = (key >= c) ? (_Float16)-1.0f : (_Float16)0.0f; }
    f32x16 o0 = bcast16(0.f), o1 = bcast16(0.f);
    float R = 0.f;
    const int swr = ((c >> 3) & 3) << 3;
    const int lkey = lane >> 3, lch = lane & 7;
    const bf16_t* kvbase = proj + (tokbase + lkey) * NPROJ + h * 64 + lch * 8;
    u32x4 kreg[4], vreg[4];
#pragma unroll
    for (int j = 0; j < 4; ++j) { const bf16_t* rp = kvbase + (size_t)(tq0 + 8 * j) * NPROJ; kreg[j] = *(const u32x4*)(rp + C_K); vreg[j] = *(const u32x4*)(rp + C_VB); }
#pragma unroll
    for (int ks = 0; ks < 4; ++ks) asm volatile("" : "+v"(qf[ks]));
    for (int ks0 = tq0; ks0 >= 0; ks0 -= 32) {
        asm volatile("" ::: "memory");
#pragma unroll
        for (int j = 0; j < 4; ++j) { const int key = lkey + 8 * j; const int spk = ((key & ~12) | ((key & 4) << 1) | ((key & 8) >> 1)) ^ ((lch & 3) << 3);
            *(u32x4*)(Kw + key * KROW + lch * 8) = kreg[j];
            bf16_t* vp = Vt + (lch * 8) * VTROW + spk;
#pragma unroll
            for (int e = 0; e < 4; ++e) { vp[(2 * e) * VTROW] = (bf16_t)(vreg[j][e] & 0xffffu); vp[(2 * e + 1) * VTROW] = (bf16_t)(vreg[j][e] >> 16); } }
        asm volatile("" ::: "memory");
        if (ks0 >= 32) {
#pragma unroll
            for (int j = 0; j < 4; ++j) { const bf16_t* rp = kvbase + (size_t)(ks0 - 32 + 8 * j) * NPROJ; kreg[j] = *(const u32x4*)(rp + C_K); vreg[j] = *(const u32x4*)(rp + C_VB); }
        }
        f32x16 z = bcast16(0.f);
#pragma unroll
        for (int ks = 0; ks < 4; ++ks) { const bf16x8 kf = *(const bf16x8*)(Kw + c * KROW + ks * 16 + hh * 8); z = __builtin_amdgcn_mfma_f32_32x32x16_bf16(kf, qf[ks], z, 0, 0, 0); }
        if (ks0 == tq0) {
#pragma unroll
            for (int r = 0; r < 16; ++r) { const int sl = (r & 3) + 8 * (r >> 2) + 4 * hh; z[r] = (sl >= c) ? -__builtin_inff() : z[r]; }
        }
        f16x8 lf[2]; softplus_pack(z, lf);
        f32x16 e = z + R;
        e = __builtin_amdgcn_mfma_f32_32x32x16_f16(uf[0], lf[0], e, 0, 0, 0);
        e = __builtin_amdgcn_mfma_f32_32x32x16_f16(uf[1], lf[1], e, 0, 0, 0);
        bf16x8 pf[2]; exp_pack(e, pf);
        { const float z0 = z[0]; const float cum0 = (z0 == -__builtin_inff()) ? R : (e[0] - z0); R = __shfl(cum0, c); }
#pragma unroll
        for (int ks2 = 0; ks2 < 2; ++ks2) {
            const bf16x8 v0 = *(const bf16x8*)(Vt + (c) * VTROW + ((ks2 * 16 + hh * 8) ^ swr)), v1 = *(const bf16x8*)(Vt + (32 + c) * VTROW + ((ks2 * 16 + hh * 8) ^ swr));
            o0 = __builtin_amdgcn_mfma_f32_32x32x16_bf16(v0, pf[ks2], o0, 0, 0, 0); o1 = __builtin_amdgcn_mfma_f32_32x32x16_bf16(v1, pf[ks2], o1, 0, 0, 0);
        }
        if (__builtin_amdgcn_ballot_w64(R > -140.0f) == 0ull) break;
    }
    { float* reg = (float*)(lds + 77824 + wave * 4608);
      const int t = lane >> 1, half = lane & 1; const size_t tok = tokbase + tq0 + t;
      const bf16_t* zp = proj + tok * NPROJ + C_ZB + h * 64 + half * 16; bf16_t* yp = yb + tok * D_MODEL + 512 + h * 64 + half * 16;
      u32x4 zz[2][2];
#pragma unroll
      for (int dt = 0; dt < 2; ++dt) { zz[dt][0] = *(const u32x4*)(zp + dt * 32); zz[dt][1] = *(const u32x4*)(zp + dt * 32 + 8); }
#pragma unroll
      for (int dt = 0; dt < 2; ++dt) { f32x4 ov[4]; tile_transpose(reg, dt ? o1 : o0, 0.f, c, hh, lane, ov);
#pragma unroll
          for (int q = 0; q < 2; ++q) { const u32x4 z4 = zz[dt][q]; const f32x4 a = ov[2 * q], b2 = ov[2 * q + 1]; u32x4 o;
              o[0] = cvt_pk_bf16(bflo(z4[0]) * a[0], bfhi(z4[0]) * a[1]); o[1] = cvt_pk_bf16(bflo(z4[1]) * a[2], bfhi(z4[1]) * a[3]);
              o[2] = cvt_pk_bf16(bflo(z4[2]) * b2[0], bfhi(z4[2]) * b2[1]); o[3] = cvt_pk_bf16(bflo(z4[3]) * b2[2], bfhi(z4[3]) * b2[3]);
              *(u32x4*)(yp + dt * 32 + 8 * q) = o; } } }
}

constexpr int VROW = 136;
__device__ __forceinline__ void sgu_item(const Params& p, unsigned char* lds, const int ch, const int hf) {
    const bf16_t* proj = (const bf16_t*)(p.ws + OFF_PROJ); bf16_t* yb = (bf16_t*)(p.ws + OFF_Y); const bf16_t* wsp = (const bf16_t*)(p.ws + OFF_WSP);
    int tid = threadIdx.x; asm volatile("" : "+v"(tid)); const int lane = tid & 63, wave = __builtin_amdgcn_readfirstlane(tid >> 6), c = lane & 31, hh = lane >> 5;
    float* stats = (float*)(lds + 73728);
    bf16_t* vw = (bf16_t*)(lds + wave * 8704);
    const size_t tok0 = (size_t)ch * CHUNK;
    const int g = hf * 4 + (wave >> 1), ct = wave & 1, ch0 = g * 64 + ct * 32;
    u32x4 vv[2][4];
#pragma unroll
    for (int i = 0; i < 2; ++i) { const bf16_t* vp = proj + (tok0 + lane + 64 * i) * NPROJ + C_V + ch0;
#pragma unroll
        for (int j = 0; j < 4; ++j) vv[i][j] = *(const u32x4*)(vp + 8 * j); }
    bf16x8 wf[20];
#pragma unroll
    for (int tt = 0; tt < 4; ++tt) {
#pragma unroll
        for (int ks = 0; ks < 2 * (tt + 1); ++ks) wf[tt * (tt + 1) + ks] = *(const bf16x8*)(wsp + ((size_t)(((g * 4 + tt) * 8 + ks) * 64 + lane)) * 8); }
    { const int l16 = lane & 15, tq = lane >> 4;
#pragma unroll
      for (int it4 = 0; it4 < 4; ++it4) { const int token = wave * 16 + it4 * 4 + tq; const bf16_t* vp = proj + (tok0 + token) * NPROJ + C_V + l16 * 8; float s1 = 0.f, s2 = 0.f;
          u32x4 w[4];
#pragma unroll
          for (int i = 0; i < 4; ++i) w[i] = *(const u32x4*)(vp + i * 128);
#pragma unroll
          for (int i = 0; i < 4; ++i)
#pragma unroll
              for (int e = 0; e < 4; ++e) { const float a = bflo(w[i][e]), bb = bfhi(w[i][e]); s1 += a + bb; s2 += a * a + bb * bb; }
#pragma unroll
          for (int o = 1; o < 16; o <<= 1) { s1 += __shfl_xor(s1, o); s2 += __shfl_xor(s2, o); }
          const float mean = s1 * (1.0f / 512.f); const float var = fmaxf(s2 * (1.0f / 512.f) - mean * mean, 0.f);
          if (l16 == 0) { stats[token * 2] = mean; stats[token * 2 + 1] = 1.0f / sqrtf(var + LN_EPS); } } }
    __syncthreads();
#pragma unroll
    for (int i = 0; i < 2; ++i) { const int sidx = lane + 64 * i; const float mean = stats[sidx * 2], rstd = stats[sidx * 2 + 1];
#pragma unroll
        for (int j = 0; j < 4; ++j)
#pragma unroll
            for (int e = 0; e < 4; ++e) { const int cl = 8 * j + 2 * e; const unsigned w = vv[i][j][e];
                const float a = (bflo(w) - mean) * rstd * p.sgu_g[ch0 + cl] + p.sgu_b[ch0 + cl], bb = (bfhi(w) - mean) * rstd * p.sgu_g[ch0 + cl + 1] + p.sgu_b[ch0 + cl + 1];
                vw[cl * VROW + sidx] = f2bf(a); vw[(cl + 1) * VROW + sidx] = f2bf(bb); } }
    asm volatile("" ::: "memory");
    const bf16_t* vrow = vw + c * VROW + hh * 8;
    float* reg = (float*)(lds + 74752 + wave * 4608);
#pragma unroll
    for (int tt = 0; tt < 4; ++tt) {
        const float bs = p.b_sp[g * CHUNK + tt * 32 + c];
        const int t2 = lane >> 1, half = lane & 1; const size_t tok = tok0 + tt * 32 + t2;
        const bf16_t* up = proj + tok * NPROJ + C_U + ch0 + half * 16; const bf16_t* zp = proj + tok * NPROJ + C_ZA + ch0 + half * 16; bf16_t* yp = yb + tok * D_MODEL + ch0 + half * 16;
        const u32x4 u0 = *(const u32x4*)(up), u1 = *(const u32x4*)(up + 8), z0 = *(const u32x4*)(zp), z1 = *(const u32x4*)(zp + 8);
        f32x16 acc = bcast16(0.f);
#pragma unroll
        for (int ks = 0; ks < 2 * (tt + 1); ++ks) { const bf16x8 af = *(const bf16x8*)(vrow + ks * 16); acc = __builtin_amdgcn_mfma_f32_32x32x16_bf16(af, wf[tt * (tt + 1) + ks], acc, 0, 0, 0); }
        f32x4 mv[4]; tile_transpose(reg, acc, bs, c, hh, lane, mv);
#pragma unroll
        for (int q = 0; q < 2; ++q) { const u32x4 uu = q ? u1 : u0, zz = q ? z1 : z0; const f32x4 a = mv[2 * q], b2 = mv[2 * q + 1]; u32x4 o;
            o[0] = cvt_pk_bf16(bflo(zz[0]) * bflo(uu[0]) * a[0], bfhi(zz[0]) * bfhi(uu[0]) * a[1]); o[1] = cvt_pk_bf16(bflo(zz[1]) * bflo(uu[1]) * a[2], bfhi(zz[1]) * bfhi(uu[1]) * a[3]);
            o[2] = cvt_pk_bf16(bflo(zz[2]) * bflo(uu[2]) * b2[0], bfhi(zz[2]) * bfhi(uu[2]) * b2[1]); o[3] = cvt_pk_bf16(bflo(zz[3]) * bflo(uu[3]) * b2[2], bfhi(zz[3]) * bfhi(uu[3]) * b2[3]);
            *(u32x4*)(yp + 8 * q) = o; }
    }
    __syncthreads();
}

__device__ void p_mixers(const Params& p, unsigned char* lds) {
    const int wave = __builtin_amdgcn_readfirstlane((int)threadIdx.x >> 6);
    for (int it = blockIdx.x; it < 256; it += gridDim.x) {
        const int xcd = it & 7, slot = it >> 3; const int bh = xcd * 8 + (slot >> 2), pr = slot & 3;
        for (int u = 0; u < 2; ++u) attn_wave_item(p, lds, bh >> 3, bh & 7, (u ? pr : 7 - pr) * 8 + wave);
    }
    __syncthreads();
    for (int it = blockIdx.x; it < 256; it += gridDim.x) sgu_item(p, lds, it >> 1, it & 1);
}

__device__ void p_ln(const Params& p) {
    int tid = threadIdx.x; asm volatile("" : "+v"(tid)); const int lane = tid & 63, wave = tid >> 6;
    for (int row = blockIdx.x * 8 + wave; row < NTOK; row += gridDim.x * 8) {
        float* rp = p.out + (size_t)row * D_MODEL; f32x4 v[4]; float s = 0.f;
#pragma unroll
        for (int j = 0; j < 4; ++j) { v[j] = *(const f32x4*)(rp + lane * 4 + 256 * j); s += (v[j][0] + v[j][1]) + (v[j][2] + v[j][3]); }
#pragma unroll
        for (int o = 32; o; o >>= 1) s += __shfl_xor(s, o);
        const float mu = s * (1.0f / 1024.f); float q = 0.f;
#pragma unroll
        for (int j = 0; j < 4; ++j) { const f32x4 d = v[j] - mu; q += (d[0] * d[0] + d[1] * d[1]) + (d[2] * d[2] + d[3] * d[3]); }
#pragma unroll
        for (int o = 32; o; o >>= 1) q += __shfl_xor(q, o);
        const float rstd = 1.0f / sqrtf(q * (1.0f / 1024.f) + LN_EPS);
#pragma unroll
        for (int j = 0; j < 4; ++j) { const int col = lane * 4 + 256 * j; const f32x4 g = *(const f32x4*)(p.ln_g + col), bb = *(const f32x4*)(p.ln_b + col);
            *(f32x4*)(rp + col) = (v[j] - mu) * rstd * g + bb; }
    }
}

#if MODE == 0
__global__ void __launch_bounds__(NT, 2) mega(Params p) {
    extern __shared__ __attribute__((aligned(16))) unsigned char lds[];
    volatile LAS unsigned* st = (volatile LAS unsigned*)((LAS unsigned char*)lds + 131072);
    if (threadIdx.x == 0) { st[0] = 0u; st[1] = 0u; st[2] = 0u; st[3] = 0u; }
    __syncthreads();
    const XcdBarrier bar = xcd_barrier_post((unsigned*)(p.ws + OFF_BAR), st);
    if (p.pad == 0x7fffffff) cg::this_grid().sync();
    p0_prologue(p, lds); xcd_barrier(bar);
    p_hconv(p); xcd_barrier(bar);
    p_inproj(p, lds); xcd_barrier(bar);
    p_mixers(p, lds); xcd_barrier(bar);
    const bool fused = (gridDim.x == 256);
    p_outproj(p, lds, bar, fused);
    if (!fused) { xcd_barrier(bar); p_ln(p); }
}
#else
__global__ void __launch_bounds__(NT, 2) mega(Params p) { extern __shared__ __attribute__((aligned(16))) unsigned char lds[]; p0_prologue(p, lds); }
__global__ void __launch_bounds__(NT, 2) k_ph1(Params p) { p_hconv(p); }
__global__ void __launch_bounds__(NT, 2) k_ph2(Params p) { extern __shared__ __attribute__((aligned(16))) unsigned char lds[]; p_inproj(p, lds); }
__global__ void __launch_bounds__(NT, 2) k_ph3(Params p) { extern __shared__ __attribute__((aligned(16))) unsigned char lds[]; p_mixers(p, lds); }
__global__ void __launch_bounds__(NT, 2) k_ph4(Params p) { extern __shared__ __attribute__((aligned(16))) unsigned char lds[]; XcdBarrier bar{}; p_outproj(p, lds, bar, false); }
__global__ void __launch_bounds__(NT, 2) k_ph5(Params p) { p_ln(p); }
#endif

extern "C" void kernel_launch(void* const* d_in, const int* in_sizes, int n_in, void* d_out, int out_size, void* d_ws, size_t ws_size, hipStream_t stream) {
    static int grid_blocks = 0;
    if (!grid_blocks) {
        int dev = 0, cus = 0, per_cu = 0;
        (void)hipGetDevice(&dev);
        (void)hipDeviceGetAttribute(&cus, hipDeviceAttributeMultiprocessorCount, dev);
        if (hipFuncSetAttribute((const void*)mega, hipFuncAttributeMaxDynamicSharedMemorySize, LDS_BYTES) != hipSuccess) fprintf(stderr, "hipFuncSetAttribute failed\n");
        if (hipOccupancyMaxActiveBlocksPerMultiprocessor(&per_cu, (const void*)mega, NT, LDS_BYTES) != hipSuccess || per_cu < 1) { fprintf(stderr, "occupancy query: %d\n", per_cu); per_cu = 1; }
        (void)hipGetLastError();
        if (per_cu > 1) per_cu = 1;
        grid_blocks = cus * per_cu;
    }
    Params p{};
    p.x = (const float*)d_in[0]; p.c = (const float*)d_in[1]; p.w_ada = (const float*)d_in[2]; p.b_ada = (const float*)d_in[3]; p.w_in = (const float*)d_in[4];
    p.sgu_g = (const float*)d_in[5]; p.sgu_b = (const float*)d_in[6]; p.w_sp = (const float*)d_in[7]; p.b_sp = (const float*)d_in[8]; p.w_out = (const float*)d_in[9];
    p.ln_g = (const float*)d_in[10]; p.ln_b = (const float*)d_in[11]; p.out = (float*)d_out; p.ws = (unsigned char*)d_ws; p.phase = 0; p.pad = 0;
#if MODE == 0
    (void)hipMemsetAsync((char*)d_ws + OFF_BAR, 0, XCD_BAR_WORDS * 4, stream);
    void* args[] = {&p};
    hipError_t e = hipLaunchCooperativeKernel((const void*)mega, dim3(grid_blocks), dim3(NT), args, LDS_BYTES, stream);
    if (e != hipSuccess) fprintf(stderr, "cooperative launch failed: %s (grid %d)\n", hipGetErrorString(e), grid_blocks);
#else
    hipFuncSetAttribute((const void*)k_ph2, hipFuncAttributeMaxDynamicSharedMemorySize, LDS_BYTES);
    hipFuncSetAttribute((const void*)k_ph3, hipFuncAttributeMaxDynamicSharedMemorySize, LDS_BYTES);
    hipFuncSetAttribute((const void*)k_ph4, hipFuncAttributeMaxDynamicSharedMemorySize, LDS_BYTES);
    hipLaunchKernelGGL(mega, dim3(grid_blocks), dim3(NT), LDS_BYTES, stream, p);
    hipLaunchKernelGGL(k_ph1, dim3(grid_blocks), dim3(NT), 0, stream, p);
    hipLaunchKernelGGL(k_ph2, dim3(grid_blocks), dim3(NT), LDS_BYTES, stream, p);
    hipLaunchKernelGGL(k_ph3, dim3(grid_blocks), dim3(NT), LDS_BYTES, stream, p);
    hipLaunchKernelGGL(k_ph4, dim3(grid_blocks), dim3(NT), LDS_BYTES, stream, p);
    hipLaunchKernelGGL(k_ph5, dim3(grid_blocks), dim3(NT), 0, stream, p);
#endif
}
```

```cpp
#include <hip/hip_runtime.h>
#include <hip/hip_cooperative_groups.h>
#include <cstdint>
#include <cstdio>
namespace cg = cooperative_groups;

#ifndef MODE
#define MODE 0
#endif

typedef unsigned short bf16_t;
typedef short bf16x8 __attribute__((ext_vector_type(8)));
typedef _Float16 f16x8 __attribute__((ext_vector_type(8)));
typedef float f32x4 __attribute__((ext_vector_type(4)));
typedef float f32x16 __attribute__((ext_vector_type(16)));
typedef unsigned u32x2 __attribute__((ext_vector_type(2)));
typedef unsigned u32x4 __attribute__((ext_vector_type(4)));

constexpr int D_MODEL = 1024, BATCH = 8, SEQ = 2048, NTOK = BATCH * SEQ;
constexpr int NPROJ = 3584, CHUNK = 128, NGRP = 8, NHEAD = 8;
constexpr int C_U = 0, C_V = 512, C_ZA = 1024, C_Q = 1536, C_K = 2048, C_VB = 2560, C_ZB = 3072;
constexpr float LN_EPS = 1e-5f;
constexpr float ALPHA = 1.189207115002721f;
constexpr float LOG2E = 1.4426950408889634f;
constexpr float QSCALE = 0.125f * LOG2E;
constexpr int NT = 512;
constexpr int LDS_BYTES = 131072 + 16;

__device__ __forceinline__ bf16_t f2bf(float f) { unsigned u = __float_as_uint(f); u += 0x7fffu + ((u >> 16) & 1u); return (bf16_t)(u >> 16); }
__device__ __forceinline__ float bf2f(bf16_t b) { return __uint_as_float(((unsigned)b) << 16); }
__device__ __forceinline__ float bflo(unsigned w) { return __uint_as_float(w << 16); }
__device__ __forceinline__ float bfhi(unsigned w) { return __uint_as_float(w & 0xffff0000u); }
typedef float f32x2_ __attribute__((ext_vector_type(2)));
typedef __bf16 bf16x2_ __attribute__((ext_vector_type(2)));
typedef _Float16 f16x2_ __attribute__((ext_vector_type(2)));
__device__ __forceinline__ unsigned cvt_pk_bf16(float lo, float hi) { f32x2_ v = {lo, hi}; return __builtin_bit_cast(unsigned, __builtin_convertvector(v, bf16x2_)); }
__device__ __forceinline__ unsigned cvt_pk_f16(float lo, float hi) { f32x2_ v = {lo, hi}; return __builtin_bit_cast(unsigned, __builtin_convertvector(v, f16x2_)); }
__device__ __forceinline__ float sigmoidf_(float v) { return __builtin_amdgcn_rcpf(1.0f + __builtin_amdgcn_exp2f(-v * LOG2E)); }
__device__ __forceinline__ float siluf_(float v) { return v * sigmoidf_(v); }
__device__ __forceinline__ float geluf_(float v) { return v * sigmoidf_(1.5957691216057308f * (v + 0.044715f * v * v * v)); }
typedef float f32x2v __attribute__((ext_vector_type(2)));
__device__ __forceinline__ f32x2v gelu2_(f32x2v v) { const f32x2v u = v * ((v * v) * 0.044715f + 1.0f); const f32x2v t = u * (-1.5957691216057308f * LOG2E);
    f32x2v e; e.x = __builtin_amdgcn_exp2f(t.x); e.y = __builtin_amdgcn_exp2f(t.y); const f32x2v d = e + 1.0f; f32x2v r; r.x = __builtin_amdgcn_rcpf(d.x); r.y = __builtin_amdgcn_rcpf(d.y); return v * r; }
__device__ __forceinline__ f32x2v silu2_(f32x2v v) { const f32x2v t = v * (-LOG2E);
    f32x2v e; e.x = __builtin_amdgcn_exp2f(t.x); e.y = __builtin_amdgcn_exp2f(t.y); const f32x2v d = e + 1.0f; f32x2v r; r.x = __builtin_amdgcn_rcpf(d.x); r.y = __builtin_amdgcn_rcpf(d.y); return v * r; }

constexpr size_t OFF_MOD = 0;
constexpr size_t OFF_HB = 1 << 20;
constexpr size_t OFF_WIN = OFF_HB + (size_t)NTOK * D_MODEL * 2;
constexpr size_t OFF_WOUT = OFF_WIN + (size_t)NPROJ * D_MODEL * 2;
constexpr size_t OFF_WSP = OFF_WOUT + (size_t)D_MODEL * D_MODEL * 2;
constexpr size_t OFF_PROJ = OFF_WSP + (size_t)NGRP * CHUNK * CHUNK * 2;
constexpr size_t OFF_Y = OFF_PROJ + (size_t)NTOK * NPROJ * 2;
constexpr size_t OFF_VST = OFF_Y + (size_t)NTOK * D_MODEL * 2;

struct Params {
    const float* x; const float* c; const float* w_ada; const float* b_ada; const float* w_in; const float* sgu_g; const float* sgu_b;
    const float* w_sp; const float* b_sp; const float* w_out; const float* ln_g; const float* ln_b;
    float* out; unsigned char* ws; int phase; int pad;
};


#define XB_TMO      128
#define XB_XCNT(j)  (256  + 64 * (j))
#define XB_XSUB(j)  (1280 + 64 * (j))
#define XB_XGEN(j)  (2304 + 64 * (j))
#define XB_TOP      3328
#define XB_TOPGEN   3392
#define XCD_BAR_WORDS 3456
#define XB_SPIN_CAP (1u << 18)
#define LAS __attribute__((address_space(3)))
__device__ __forceinline__ unsigned xb_ld(unsigned* p)              { return __hip_atomic_load(p, __ATOMIC_RELAXED, __HIP_MEMORY_SCOPE_AGENT); }
__device__ __forceinline__ unsigned xb_add(unsigned* p, unsigned v) { return __hip_atomic_fetch_add(p, v, __ATOMIC_RELAXED, __HIP_MEMORY_SCOPE_AGENT); }
__device__ __forceinline__ unsigned xb_xcc_id() { return (unsigned)__builtin_amdgcn_s_getreg((3 << 11) | 20) & 0xFu; }
#define XB_SPIN(cond, bar) do { unsigned _sp = 0; while (cond) { __builtin_amdgcn_s_sleep(1); \
    if ((++_sp & 255u) == 0u) { if (xb_ld(&(bar)[XB_TMO])) break; if (_sp > XB_SPIN_CAP) { atomicAdd(&(bar)[XB_TMO], 1u); break; } } } } while (0)
struct XcdBarrier { unsigned* bar; unsigned x; volatile LAS unsigned* st; };
__device__ __forceinline__ XcdBarrier xcd_barrier_post(unsigned* bar, volatile LAS unsigned* st) {
    XcdBarrier b; b.bar = bar; b.x = xb_xcc_id(); b.st = st;
    if (threadIdx.x == 0) (void)xb_add(&bar[XB_XCNT(b.x)], 1u);
    return b;
}
__device__ __forceinline__ void xcd_barrier_complete(unsigned* bar, unsigned x, unsigned& nloc, unsigned& nx) {
    const unsigned G = gridDim.x * gridDim.y * gridDim.z;
    unsigned sum, cnt, mine, sp = 0u;
    for (;;) {
        sum = 0u; cnt = 0u; mine = 0u;
#pragma unroll
        for (unsigned j = 0; j < 16; ++j) { const unsigned c = xb_ld(&bar[XB_XCNT(j)]); sum += c; cnt += (c > 0u) ? 1u : 0u; mine = (j == x) ? c : mine; }
        if (sum == G) break;
        __builtin_amdgcn_s_sleep(1);
        if ((++sp & 255u) == 0u) { if (xb_ld(&bar[XB_TMO])) break; if (sp > XB_SPIN_CAP) { atomicAdd(&bar[XB_TMO], 1u); break; } }
    }
    nloc = mine > 0u ? mine : 1u; nx = cnt > 0u ? cnt : 1u;
}
__device__ __forceinline__ void xcd_barrier(const XcdBarrier& b) {
    asm volatile("s_waitcnt vmcnt(0)" ::: "memory");
    __syncthreads();
    if (threadIdx.x == 0) {
        unsigned* bar = b.bar;
        __builtin_amdgcn_s_waitcnt(0);
        unsigned nloc = b.st[0], nx = b.st[1];
        if (nloc == 0u) { xcd_barrier_complete(bar, b.x, nloc, nx); b.st[0] = nloc; b.st[1] = nx; }
        const unsigned old = xb_add(&bar[XB_XSUB(b.x)], 1u);
        const unsigned gen = old / nloc;
        if (old + 1u == (gen + 1u) * nloc) {
            __builtin_amdgcn_fence(__ATOMIC_RELEASE, "agent");
            asm volatile("s_waitcnt vmcnt(0)" ::: "memory");
            const unsigned og = xb_add(&bar[XB_TOP], 1u);
            const unsigned tg = og / nx;
            if (og + 1u == (tg + 1u) * nx) xb_add(&bar[XB_TOPGEN], 1u);
            else XB_SPIN(xb_ld(&bar[XB_TOPGEN]) == tg, bar);
            __builtin_amdgcn_fence(__ATOMIC_ACQUIRE, "agent");
            xb_add(&bar[XB_XGEN(b.x)], 1u);
            asm volatile("s_waitcnt vmcnt(0)" ::: "memory");
        } else {
            XB_SPIN(xb_ld(&bar[XB_XGEN(b.x)]) == gen, bar);
            __builtin_amdgcn_fence(__ATOMIC_ACQUIRE, "agent");
            asm volatile("s_waitcnt vmcnt(0)" ::: "memory");
        }
    }
    __syncthreads();
}
#define XB_EXIT 64
__device__ unsigned g_bar[XCD_BAR_WORDS];
__device__ __forceinline__ void xcd_barrier_retire(unsigned* bar) {
    __syncthreads();
    if (threadIdx.x == 0) {
        const unsigned G = gridDim.x * gridDim.y * gridDim.z;
        if (xb_add(&bar[XB_EXIT], 1u) == G - 1u) {
            __hip_atomic_store(&bar[XB_TMO], 0u, __ATOMIC_RELAXED, __HIP_MEMORY_SCOPE_AGENT);
            for (int j = 0; j < 16; ++j) { __hip_atomic_store(&bar[XB_XCNT(j)], 0u, __ATOMIC_RELAXED, __HIP_MEMORY_SCOPE_AGENT); __hip_atomic_store(&bar[XB_XSUB(j)], 0u, __ATOMIC_RELAXED, __HIP_MEMORY_SCOPE_AGENT);
                                           __hip_atomic_store(&bar[XB_XGEN(j)], 0u, __ATOMIC_RELAXED, __HIP_MEMORY_SCOPE_AGENT); }
            __hip_atomic_store(&bar[XB_TOP], 0u, __ATOMIC_RELAXED, __HIP_MEMORY_SCOPE_AGENT); __hip_atomic_store(&bar[XB_TOPGEN], 0u, __ATOMIC_RELAXED, __HIP_MEMORY_SCOPE_AGENT);
            __hip_atomic_store(&bar[XB_EXIT], 0u, __ATOMIC_RELAXED, __HIP_MEMORY_SCOPE_AGENT);
        }
    }
}

__device__ void p0_prologue(const Params& p, unsigned char* lds) {
    int tid = threadIdx.x; asm volatile("" : "+v"(tid)); const int lane = tid & 63, wave = tid >> 6;
    float* mod = (float*)(p.ws + OFF_MOD);
    float* sc = (float*)lds;
    float* red = (float*)(lds + 32768);
    for (int it = blockIdx.x; it < 96; it += gridDim.x) {
        for (int i = tid; i < 8 * 1024; i += NT) sc[i] = siluf_(p.c[i]);
        __syncthreads();
        const int q = tid & 7, r = tid >> 3; const int c0 = it * 32 + q * 4;
        float acc[8][4];
#pragma unroll
        for (int b = 0; b < 8; ++b) { acc[b][0] = 0.f; acc[b][1] = 0.f; acc[b][2] = 0.f; acc[b][3] = 0.f; }
        f32x4 wv[16];
#pragma unroll
        for (int i = 0; i < 16; ++i) wv[i] = __builtin_nontemporal_load((const f32x4*)(p.w_ada + (size_t)(r + 64 * i) * 3072 + c0));
#pragma unroll
        for (int i = 0; i < 16; ++i) { const int k = r + 64 * i; const f32x4 w = wv[i];
#pragma unroll
            for (int b = 0; b < 8; ++b) { const float s = sc[b * 1024 + k]; acc[b][0] += s * w[0]; acc[b][1] += s * w[1]; acc[b][2] += s * w[2]; acc[b][3] += s * w[3]; } }
#pragma unroll
        for (int b = 0; b < 8; ++b)
#pragma unroll
            for (int j = 0; j < 4; ++j) { float v = acc[b][j]; v += __shfl_xor(v, 8); v += __shfl_xor(v, 16); v += __shfl_xor(v, 32); acc[b][j] = v; }
        if (lane < 8) {
#pragma unroll
            for (int b = 0; b < 8; ++b)
#pragma unroll
                for (int j = 0; j < 4; ++j) red[(wave * 8 + q) * 32 + b * 4 + j] = acc[b][j];
        }
        __syncthreads();
        if (tid < 256) { const int b = tid >> 5, col = tid & 31, qq = col >> 2, j = col & 3; float s = 0.f;
#pragma unroll
            for (int w = 0; w < 8; ++w) s += red[(w * 8 + qq) * 32 + b * 4 + j];
            mod[b * 3072 + it * 32 + col] = s + p.b_ada[it * 32 + col]; }
        __syncthreads();
    }
    float* tb = (float*)(lds + 49152);
    {   const int n4 = tid & 15, kk = tid >> 4;
        f32x4 v0, v1;
        const int G = gridDim.x, bx = blockIdx.x, nh = (G > 96) ? G - 96 : 0, r1 = (nh > 0 && 5 * nh <= 896 + 256) ? 5 : 0, T1 = r1 * nh;
        auto my_tile = [&](int k) -> int { if (bx >= 96) { if (k < r1) return (bx - 96) + k * nh; k -= r1; } return T1 + bx + k * G; };
        auto tile_src = [&](int tl, const float*& W, bf16_t*& Wt, int& N, int& k0, int& n0) {
            if (tl < 896) { W = p.w_in; Wt = (bf16_t*)(p.ws + OFF_WIN); N = NPROJ; k0 = (tl / 56) * 64; n0 = (tl % 56) * 64; }
            else { const int t2 = tl - 896; W = p.w_out; Wt = (bf16_t*)(p.ws + OFF_WOUT); N = D_MODEL; k0 = (t2 / 16) * 64; n0 = (t2 % 16) * 64; } };
        f32x4 w0, w1;
#define TP_LOAD(R0, R1, TL) do { if ((TL) < 896 + 256) { const float* W_; bf16_t* Wt_; int N_, k0_, n0_; tile_src((TL), W_, Wt_, N_, k0_, n0_); \
            R0 = __builtin_nontemporal_load((const f32x4*)(W_ + (size_t)(k0_ + kk) * N_ + n0_ + n4 * 4)); R1 = __builtin_nontemporal_load((const f32x4*)(W_ + (size_t)(k0_ + kk + 32) * N_ + n0_ + n4 * 4)); } } while (0)
#define TP_BODY(R0, R1, TL, TLNEXT) do { const float* W; bf16_t* Wt; int N, k0, n0; tile_src((TL), W, Wt, N, k0, n0); \
            tb[kk * 65 + n4 * 4 + 0] = R0[0]; tb[kk * 65 + n4 * 4 + 1] = R0[1]; tb[kk * 65 + n4 * 4 + 2] = R0[2]; tb[kk * 65 + n4 * 4 + 3] = R0[3]; \
            tb[(kk + 32) * 65 + n4 * 4 + 0] = R1[0]; tb[(kk + 32) * 65 + n4 * 4 + 1] = R1[1]; tb[(kk + 32) * 65 + n4 * 4 + 2] = R1[2]; tb[(kk + 32) * 65 + n4 * 4 + 3] = R1[3]; \
            __syncthreads(); \
            TP_LOAD(R0, R1, (TLNEXT)); \
            { const int n = tid >> 3, ks = tid & 7; u32x4 o; \
              o[0] = cvt_pk_bf16(tb[(ks * 8 + 0) * 65 + n], tb[(ks * 8 + 1) * 65 + n]); o[1] = cvt_pk_bf16(tb[(ks * 8 + 2) * 65 + n], tb[(ks * 8 + 3) * 65 + n]); \
              o[2] = cvt_pk_bf16(tb[(ks * 8 + 4) * 65 + n], tb[(ks * 8 + 5) * 65 + n]); o[3] = cvt_pk_bf16(tb[(ks * 8 + 6) * 65 + n], tb[(ks * 8 + 7) * 65 + n]); \
              *(u32x4*)(Wt + (size_t)(n0 + n) * D_MODEL + k0 + ks * 8) = o; } \
            __syncthreads(); } while (0)
        TP_LOAD(v0, v1, my_tile(0)); TP_LOAD(w0, w1, my_tile(1));
        for (int kidx = 0;; kidx += 2) {
            const int ta = my_tile(kidx); if (ta >= 896 + 256) break;
            TP_BODY(v0, v1, ta, my_tile(kidx + 2));
            const int tb2 = my_tile(kidx + 1); if (tb2 >= 896 + 256) break;
            TP_BODY(w0, w1, tb2, my_tile(kidx + 3));
        }
#undef TP_LOAD
#undef TP_BODY
    }
    bf16_t* wsp = (bf16_t*)(p.ws + OFF_WSP);
    for (int i = blockIdx.x * NT + tid; i < NGRP * CHUNK * CHUNK / 8; i += gridDim.x * NT) {
        const int frag = i >> 6, l = i & 63, g = frag >> 5, tt = (frag >> 3) & 3, ks = frag & 7;
        const int t = tt * 32 + (l & 31), s0 = ks * 16 + (l >> 5) * 8; const int e = (g * CHUNK + t) * CHUNK + s0;
        const f32x4 a = *(const f32x4*)(p.w_sp + e), b = *(const f32x4*)(p.w_sp + e + 4);
        float v[8] = {a[0], a[1], a[2], a[3], b[0], b[1], b[2], b[3]};
#pragma unroll
        for (int j = 0; j < 8; ++j) v[j] = (s0 + j <= t) ? v[j] : 0.f;
        u32x4 o; o[0] = cvt_pk_bf16(v[0], v[1]); o[1] = cvt_pk_bf16(v[2], v[3]); o[2] = cvt_pk_bf16(v[4], v[5]); o[3] = cvt_pk_bf16(v[6], v[7]);
        *(u32x4*)(wsp + (size_t)i * 8) = o;
    }
}

__device__ void p_hconv(const Params& p) {
    const float* mod = (const float*)(p.ws + OFF_MOD); bf16_t* hb = (bf16_t*)(p.ws + OFF_HB);
    int tid = threadIdx.x; asm volatile("" : "+v"(tid));
    const size_t stride = (size_t)gridDim.x * NT, total = (size_t)NTOK * D_MODEL / 8;
    for (size_t i0 = (size_t)blockIdx.x * NT + tid; i0 < total; i0 += 4 * stride) {
        f32x4 x0[4], x1[4];
#pragma unroll
        for (int u = 0; u < 4; ++u) { const size_t i = i0 + u * stride; if (i < total) { x0[u] = __builtin_nontemporal_load((const f32x4*)(p.x + i * 8)); x1[u] = __builtin_nontemporal_load((const f32x4*)(p.x + i * 8 + 4)); } }
#pragma unroll
        for (int u = 0; u < 4; ++u) { const size_t i = i0 + u * stride; if (i < total) {
            const size_t e = i * 8; const int col = (int)(e & 1023); const int b = (int)(e >> 21);
            const f32x4 sh0 = *(const f32x4*)(mod + b * 3072 + col), sh1 = *(const f32x4*)(mod + b * 3072 + col + 4);
            const f32x4 sc0 = *(const f32x4*)(mod + b * 3072 + 1024 + col), sc1 = *(const f32x4*)(mod + b * 3072 + 1024 + col + 4);
            const f32x4 h0 = x0[u] * (1.0f + sc0) + sh0, h1 = x1[u] * (1.0f + sc1) + sh1;
            u32x4 o; o[0] = cvt_pk_bf16(h0[0], h0[1]); o[1] = cvt_pk_bf16(h0[2], h0[3]); o[2] = cvt_pk_bf16(h1[0], h1[1]); o[3] = cvt_pk_bf16(h1[2], h1[3]);
            *(u32x4*)(hb + e) = o; } }
    }
}

constexpr int BM = 256, BK = 64, HALF = 128, NXCD = 8, WGM = 8, HT = HALF * BK;
__device__ __forceinline__ int lds_byte(int r, int c) { int st = (r >> 4) * 2 + (c >> 5), rr = r & 15, cc = c & 31, ob = rr * 64 + cc * 2; return st * 1024 + (ob ^ (((ob >> 9) & 1) << 5)); }
__device__ __forceinline__ void stage_rc(int b, int& R, int& C) { int st = b / 1024, sb = b % 1024, swz = sb ^ (((sb >> 9) & 1) << 5); R = (st >> 1) * 16 + swz / 64; C = (st & 1) * 32 + (swz % 64) / 2; }

struct TileOrder {
    int nM, nN, nwg, G, c;
    __device__ void init(int M, int N, int G_, int c_) { nM = M / BM; nN = N / BM; nwg = nM * nN; G = G_; c = c_; }
    __device__ bool next(int i, int& pm, int& pn) const { const long L = (long)i * G + c; if (L >= nwg) return false; map((int)L, pm, pn); return true; }
    __device__ void map(int L, int& pm, int& pn) const {
        int wgid = L; { const int q = nwg / NXCD, r = nwg % NXCD, xcd = wgid % NXCD, off = wgid / NXCD; wgid = (xcd < r ? xcd * (q + 1) : r * (q + 1) + (xcd - r) * q) + off; }
        const int nig = WGM * nN, gid = wgid / nig, fm = gid * WGM, gsz = (nM - fm) < WGM ? (nM - fm) : WGM;
        pm = fm + ((wgid % nig) % gsz); pn = (wgid % nig) / gsz;
    }
};

struct GUnit { int pm, pn, half, hsel; };
constexpr int HTB = HALF * BK * 2;
template <class Epi, class Sched>
__device__ __forceinline__ void gemm_phase(LAS unsigned char* lds, const bf16_t* __restrict__ Ag, const bf16_t* __restrict__ Btg, const Sched& S, const Epi& E) {
    constexpr int K = D_MODEL, nt = K / BK;
    int gtx = threadIdx.x; asm volatile("" : "+v"(gtx));
    const int wid = __builtin_amdgcn_readfirstlane(gtx >> 6), lane = gtx & 63, wr = wid >> 2, wc = wid & 3, fr = lane & 15, fq = lane >> 4;
    unsigned voff[2], voffB[2];
#pragma unroll
    for (int i = 0; i < 2; ++i) { int R, C; stage_rc(gtx * 16 + i * 8192, R, C); voff[i] = (unsigned)(R * K + C) * 2u;
        const int rho = R & 31, nn = rho >> 4, ii = rho & 15, p32 = 8 * (ii >> 2) + 4 * nn + (ii & 3);
        const int Rg = Epi::PERM ? ((R >> 5) * 64 + p32) : R;
        voffB[i] = (unsigned)(Rg * K + C) * 2u; }
    constexpr size_t bstep = Epi::PERM ? (size_t)32 * K * 2 : (size_t)HALF * K * 2;
    constexpr size_t kstep = (size_t)(BK * 2), hstep = (size_t)HALF * K * 2, tstep = 2 * hstep;
    const unsigned ldsw = (unsigned)wid * 1024u;
    const int aoff = lds_byte(wr * 64 + fr, fq * 8), boff = lds_byte(wc * 32 + fr, fq * 8);
#define PG8_SA(b, h) (((b) * 2 + (h)) * HTB)
#define PG8_SB(b, h) ((4 + (b) * 2 + (h)) * HTB)
#define PG8_STAGE_(bufoff, gbase, vo) do { _Pragma("unroll") for (int _i = 0; _i < 2; ++_i) \
        __builtin_amdgcn_global_load_lds((const unsigned*)((const char*)(gbase) + (vo)[_i]), (LAS unsigned*)(lds + (bufoff) + ldsw + _i * 8192), 16, 0, 0); } while (0)
#define PG8_STAGE(bufoff, gbase) PG8_STAGE_(bufoff, gbase, voff)
#define PG8_STAGEB(bufoff, gbase, h) PG8_STAGE_(bufoff, (gbase) + (h) * bstep, voffB)
#define PG8_LDA(dst, b, h) do { _Pragma("unroll") for (int m = 0; m < 4; ++m) _Pragma("unroll") for (int k = 0; k < 2; ++k) dst[m][k] = *(const LAS bf16x8*)(lds + PG8_SA(b, h) + aoff + m * 2048 + k * 1024); } while (0)
#define PG8_LDB(dst, b, h) do { _Pragma("unroll") for (int n = 0; n < 2; ++n) _Pragma("unroll") for (int k = 0; k < 2; ++k) dst[n][k] = *(const LAS bf16x8*)(lds + PG8_SB(b, h) + boff + n * 2048 + k * 1024); } while (0)
#define PG8_MMA(ai, bj, At, Bt) do { __builtin_amdgcn_s_setprio(1); _Pragma("unroll") for (int m = 0; m < 4; ++m) _Pragma("unroll") for (int n = 0; n < 2; ++n) _Pragma("unroll") for (int k = 0; k < 2; ++k) \
        acc[ai][bj][m][n] = __builtin_amdgcn_mfma_f32_16x16x32_bf16(Bt[n][k], At[m][k], acc[ai][bj][m][n], 0, 0, 0); __builtin_amdgcn_s_setprio(0); } while (0)
#define PG8_WAIT_V(n) asm volatile("s_waitcnt vmcnt(" #n ")" ::: "memory")
#define PG8_WAIT_L(n) asm volatile("s_waitcnt lgkmcnt(" #n ")" ::: "memory")
#define PG8_BAR __builtin_amdgcn_s_barrier()
#define PG8_SCHED __builtin_amdgcn_sched_barrier(0)
    GUnit cur, nxt; int ui = 0;
    if (!S.next(0, cur)) return;
    f32x4 acc[2][2][4][2];
#pragma unroll
    for (int a = 0; a < 2; ++a)
#pragma unroll
        for (int b = 0; b < 2; ++b)
#pragma unroll
            for (int m = 0; m < 4; ++m)
#pragma unroll
                for (int n = 0; n < 2; ++n) acc[a][b][m][n] = (f32x4){0.f, 0.f, 0.f, 0.f};
    bf16x8 At[4][2], B0[2][2], B1[2][2];
    const char* cA = (const char*)Ag + (size_t)cur.pm * tstep + (size_t)cur.hsel * hstep; const char* cB = (const char*)Btg + (size_t)cur.pn * tstep;
    PG8_STAGEB(PG8_SB(0, 0), cB, 0); PG8_STAGEB(PG8_SB(0, 1), cB, 1); PG8_STAGE(PG8_SA(0, 0), cA); PG8_STAGE(PG8_SA(0, 1), cA + hstep);
    if (wr == 1) PG8_BAR;
    PG8_WAIT_V(2); PG8_BAR;
    PG8_STAGEB(PG8_SB(1, 0), cB + kstep, 0); PG8_STAGE(PG8_SA(1, 0), cA + kstep); PG8_STAGEB(PG8_SB(1, 1), cB + kstep, 1);
    PG8_WAIT_V(6); PG8_BAR;
    for (;;) {
        const bool has_next = S.next(ui + 1, nxt);
        const char* nA = has_next ? (const char*)Ag + (size_t)nxt.pm * tstep + (size_t)nxt.hsel * hstep : cA; const char* nB = has_next ? (const char*)Btg + (size_t)nxt.pn * tstep : cB;
        const bool full = !cur.half;
        for (int t = 0; t < nt; t += 2) {
            const bool last = (t == nt - 2);
            const char* a1 = cA + (size_t)(t + 1) * kstep;
            const char* a2 = last ? nA : cA + (size_t)(t + 2) * kstep; const char* b2 = last ? nB : cB + (size_t)(t + 2) * kstep;
            const char* a3 = a2 + kstep; const char* b3 = b2 + kstep;
            PG8_LDB(B0, 0, 0); PG8_LDB(B1, 0, 1); PG8_SCHED; PG8_LDA(At, 0, 0); PG8_STAGE(PG8_SA(1, 1), a1 + hstep);
            PG8_WAIT_V(8); PG8_WAIT_L(0); PG8_BAR; PG8_MMA(0, 0, At, B0); PG8_MMA(0, 1, At, B1); PG8_BAR; PG8_SCHED;
            if (full) { PG8_LDA(At, 0, 1); } PG8_STAGEB(PG8_SB(0, 0), b2, 0); PG8_STAGEB(PG8_SB(0, 1), b2, 1); PG8_STAGE(PG8_SA(0, 0), a2);
            PG8_WAIT_V(8); PG8_WAIT_L(0); PG8_BAR; if (full) { PG8_MMA(1, 0, At, B0); PG8_MMA(1, 1, At, B1); } PG8_BAR; PG8_SCHED;
            PG8_LDB(B0, 1, 0); PG8_LDB(B1, 1, 1); PG8_SCHED; PG8_LDA(At, 1, 0); PG8_STAGE(PG8_SA(0, 1), a2 + hstep);
            PG8_WAIT_V(8); PG8_WAIT_L(0); PG8_BAR; PG8_MMA(0, 0, At, B0); PG8_MMA(0, 1, At, B1); PG8_BAR; PG8_SCHED;
            if (full) { PG8_LDA(At, 1, 1); } PG8_STAGEB(PG8_SB(1, 0), b3, 0); PG8_STAGEB(PG8_SB(1, 1), b3, 1); PG8_STAGE(PG8_SA(1, 0), a3);
            PG8_WAIT_V(8); PG8_WAIT_L(0); PG8_BAR; if (full) { PG8_MMA(1, 0, At, B0); PG8_MMA(1, 1, At, B1); } PG8_BAR; PG8_SCHED;
        }
        if (wr == 0) PG8_BAR;
        E(acc, cur);
        if (!has_next) break;
#pragma unroll
        for (int a = 0; a < 2; ++a)
#pragma unroll
            for (int b = 0; b < 2; ++b)
#pragma unroll
                for (int m = 0; m < 4; ++m)
#pragma unroll
                    for (int n = 0; n < 2; ++n) acc[a][b][m][n] = (f32x4){0.f, 0.f, 0.f, 0.f};
        cur = nxt; cA = nA; cB = nB; ++ui;
        if (wr == 1) PG8_BAR;
    }
    PG8_WAIT_V(0);
    PG8_BAR;
#undef PG8_SA
#undef PG8_SB
#undef PG8_STAGE
#undef PG8_STAGEB
#undef PG8_STAGE_
#undef PG8_LDA
#undef PG8_LDB
#undef PG8_MMA
#undef PG8_WAIT_V
#undef PG8_WAIT_L
#undef PG8_BAR
#undef PG8_SCHED
}

struct InprojSched {
    TileOrder ord; int G, c, nfull, nunits;
    __device__ void init(int G_, int c_) { ord.init(NTOK, NPROJ, G_, c_); G = G_; c = c_; const int rem = ord.nwg % G, nsplit = (rem > 0 && 2 * rem <= G) ? rem : 0; nfull = ord.nwg - nsplit; nunits = nfull + 2 * nsplit; }
    __device__ bool next(int i, GUnit& u) const {
        const int L = i * G + c; if (L >= nunits) return false;
        u.half = (L >= nfull) ? 1 : 0; u.hsel = u.half ? ((L - nfull) & 1) : 0;
        ord.map(u.half ? nfull + ((L - nfull) >> 1) : L, u.pm, u.pn); return true;
    }
};
struct EpiInproj {
    static constexpr bool PERM = true;
    bf16_t* proj; float* vstb;
    __device__ __forceinline__ void operator()(const f32x4 (&acc)[2][2][4][2], const GUnit& u) const {
        int tx = threadIdx.x; asm volatile("" : "+v"(tx));
        const int wid = tx >> 6, lane = tx & 63, wr = wid >> 2, wc = wid & 3, fr = lane & 15, fq = lane >> 4;
        const int pm = u.pm, pn = u.pn, hsel = u.hsel; const bool half = u.half != 0;
        const int seg = pn >> 1;
#pragma unroll
        for (int ai = 0; ai < 2; ++ai) {
            if (half && ai == 1) break;
#pragma unroll
            for (int m = 0; m < 4; ++m) {
                const int row = pm * BM + hsel * HALF + ai * HALF + wr * 64 + m * 16 + fr;
                bf16_t* rowp = proj + (size_t)row * NPROJ + pn * BM + wc * 64 + fq * 8;
                float s1 = 0.f, s2 = 0.f;
#pragma unroll
                for (int bj = 0; bj < 2; ++bj) {
                    u32x4 o4;
#pragma unroll
                    for (int n = 0; n < 2; ++n) {
                        f32x4 v = acc[ai][bj][m][n];
                        if (seg <= 1) { const f32x2v a = gelu2_((f32x2v){v[0], v[1]}), b2 = gelu2_((f32x2v){v[2], v[3]}); v = (f32x4){a.x, a.y, b2.x, b2.y}; }
                        else if (seg == 2 || seg == 6) { const f32x2v a = silu2_((f32x2v){v[0], v[1]}), b2 = silu2_((f32x2v){v[2], v[3]}); v = (f32x4){a.x, a.y, b2.x, b2.y}; }
                        else if (seg == 3) { v = v * QSCALE; }
                        const unsigned o0 = cvt_pk_bf16(v[0], v[1]), o1 = cvt_pk_bf16(v[2], v[3]);
                        o4[2 * n] = o0; o4[2 * n + 1] = o1;
                        if (seg == 1) {
                            const float a0 = bflo(o0), a1 = bfhi(o0), a2 = bflo(o1), a3 = bfhi(o1);
                            s1 += (a0 + a1) + (a2 + a3); s2 += (a0 * a0 + a1 * a1) + (a2 * a2 + a3 * a3); }
                    }
                    *(u32x4*)(rowp + bj * 32) = o4;
                }
                if (seg == 1) {
                    s1 += __shfl_xor(s1, 16); s2 += __shfl_xor(s2, 16); s1 += __shfl_xor(s1, 32); s2 += __shfl_xor(s2, 32);
                    if (fq == 0) { float* vst = vstb + ((size_t)row * 8 + (pn & 1) * 4 + wc) * 2; vst[0] = s1; vst[1] = s2; }
                }
            }
        }
    }
};
__device__ void p_inproj(const Params& p, unsigned char* lds) {
    InprojSched S; S.init(gridDim.x, blockIdx.x);
    EpiInproj E{(bf16_t*)(p.ws + OFF_PROJ), (float*)(p.ws + OFF_VST)};
    gemm_phase<EpiInproj, InprojSched>((LAS unsigned char*)lds, (const bf16_t*)(p.ws + OFF_HB), (const bf16_t*)(p.ws + OFF_WIN), S, E);
}

constexpr size_t OFF_STATS = 256 * 1024;
struct OutprojSched { TileOrder ord;
    __device__ void init(int G_, int c_) { ord.init(NTOK, D_MODEL, G_, c_); }
    __device__ bool next(int i, GUnit& u) const { if (!ord.next(i, u.pm, u.pn)) return false; u.half = 0; u.hsel = 0; return true; } };
struct EpiOutproj {
    static constexpr bool PERM = false;
    const float* x; float* out; const float* ln_g; const float* ln_b; unsigned char* ws; unsigned char* lds; const XcdBarrier* bar; bool fused;
    __device__ __forceinline__ void operator()(f32x4 (&acc)[2][2][4][2], const GUnit& u) const {
        const float* mod = (const float*)(ws + OFF_MOD); const int pm = u.pm, pn = u.pn;
        int tx = threadIdx.x; asm volatile("" : "+v"(tx));
        const int wid = tx >> 6, lane = tx & 63, wr = wid >> 2, wc = wid & 3, fr = lane & 15, fq = lane >> 4;
        const int b = (pm * BM) / SEQ; const int col0 = pn * BM + wc * 32 + fq * 4;
        {   f32x4 gate[2][2];
#pragma unroll
            for (int bj = 0; bj < 2; ++bj)
#pragma unroll
                for (int n = 0; n < 2; ++n) gate[bj][n] = *(const f32x4*)(mod + b * 3072 + 2048 + col0 + bj * HALF + n * 16);
            f32x4 xa[4][2][2], xb[1][2][2];
#define XLOAD(dst, ai_, m_) do { const size_t off_ = (size_t)(pm * BM + (ai_) * HALF + wr * 64 + (m_) * 16 + fr) * D_MODEL + col0; \
                _Pragma("unroll") for (int bj = 0; bj < 2; ++bj) _Pragma("unroll") for (int n = 0; n < 2; ++n) dst[bj][n] = __builtin_nontemporal_load((const f32x4*)(x + off_ + bj * HALF + n * 16)); } while (0)
#define XFMA(src, ai_, m_) do { _Pragma("unroll") for (int bj = 0; bj < 2; ++bj) _Pragma("unroll") for (int n = 0; n < 2; ++n) acc[ai_][bj][m_][n] = src[bj][n] * ALPHA + gate[bj][n] * acc[ai_][bj][m_][n]; } while (0)
            XLOAD(xa[0], 0, 0); XLOAD(xa[1], 0, 1); XLOAD(xa[2], 0, 2); XLOAD(xa[3], 0, 3); XLOAD(xb[0], 1, 0);
            XFMA(xa[0], 0, 0); XFMA(xa[1], 0, 1); XFMA(xa[2], 0, 2); XFMA(xa[3], 0, 3);
            XLOAD(xa[0], 1, 1); XLOAD(xa[1], 1, 2); XLOAD(xa[2], 1, 3);
            XFMA(xb[0], 1, 0); XFMA(xa[0], 1, 1); XFMA(xa[1], 1, 2); XFMA(xa[2], 1, 3);
#undef XLOAD
#undef XFMA
        }
        if (!fused) {
#pragma unroll
            for (int ai = 0; ai < 2; ++ai)
#pragma unroll
                for (int m = 0; m < 4; ++m) { const size_t off = (size_t)(pm * BM + ai * HALF + wr * 64 + m * 16 + fr) * D_MODEL + col0;
#pragma unroll
                    for (int bj = 0; bj < 2; ++bj)
#pragma unroll
                        for (int n = 0; n < 2; ++n) *(f32x4*)(out + off + bj * HALF + n * 16) = acc[ai][bj][m][n]; }
            return;
        }
        asm volatile("s_waitcnt vmcnt(0)" ::: "memory"); __syncthreads();
        float* P = (float*)lds;
        float* S = (float*)(lds + 8192);
        float* gstats = (float*)(ws + OFF_STATS);
#pragma unroll
        for (int ai = 0; ai < 2; ++ai)
#pragma unroll
            for (int m = 0; m < 4; ++m) { float s1 = 0.f, s2 = 0.f;
#pragma unroll
                for (int bj = 0; bj < 2; ++bj)
#pragma unroll
                    for (int n = 0; n < 2; ++n) { const f32x4 v = acc[ai][bj][m][n]; s1 += (v[0] + v[1]) + (v[2] + v[3]); s2 += (v[0] * v[0] + v[1] * v[1]) + (v[2] * v[2] + v[3] * v[3]); }
                s1 += __shfl_xor(s1, 16); s2 += __shfl_xor(s2, 16); s1 += __shfl_xor(s1, 32); s2 += __shfl_xor(s2, 32);
                if (fq == 0) { const int rl = ai * HALF + wr * 64 + m * 16 + fr; P[(rl * 4 + wc) * 2] = s1; P[(rl * 4 + wc) * 2 + 1] = s2; } }
        __syncthreads();
        if (tx < 256) { const f32x4 a = *(const f32x4*)(P + tx * 8), c2 = *(const f32x4*)(P + tx * 8 + 4);
            float* gp = gstats + ((size_t)(pm * BM + tx) * 4 + pn) * 2; gp[0] = (a[0] + a[2]) + (c2[0] + c2[2]); gp[1] = (a[1] + a[3]) + (c2[1] + c2[3]); }
        xcd_barrier(*bar);
        if (tx < 256) { const float* gp = gstats + (size_t)(pm * BM + tx) * 8; const f32x4 a = *(const f32x4*)gp, c2 = *(const f32x4*)(gp + 4);
            const float mean = ((a[0] + a[2]) + (c2[0] + c2[2])) * (1.0f / 1024.f); const float ex2 = ((a[1] + a[3]) + (c2[1] + c2[3])) * (1.0f / 1024.f);
            const float var = fmaxf(ex2 - mean * mean, 0.f); S[tx * 2] = mean; S[tx * 2 + 1] = 1.0f / sqrtf(var + LN_EPS); }
        __syncthreads();
        {   f32x4 gg[2][2], bb[2][2];
#pragma unroll
            for (int bj = 0; bj < 2; ++bj)
#pragma unroll
                for (int n = 0; n < 2; ++n) { gg[bj][n] = *(const f32x4*)(ln_g + col0 + bj * HALF + n * 16); bb[bj][n] = *(const f32x4*)(ln_b + col0 + bj * HALF + n * 16); }
#pragma unroll
            for (int ai = 0; ai < 2; ++ai)
#pragma unroll
                for (int m = 0; m < 4; ++m) { const int rl = ai * HALF + wr * 64 + m * 16 + fr; const float mean = S[rl * 2], rstd = S[rl * 2 + 1];
                    const size_t off = (size_t)(pm * BM + rl) * D_MODEL + col0;
#pragma unroll
                    for (int bj = 0; bj < 2; ++bj)
#pragma unroll
                        for (int n = 0; n < 2; ++n) __builtin_nontemporal_store((acc[ai][bj][m][n] - mean) * rstd * gg[bj][n] + bb[bj][n], (f32x4*)(out + off + bj * HALF + n * 16)); } }
    }
};
__device__ void p_outproj(const Params& p, unsigned char* lds, const XcdBarrier& bar, const bool fused) {
    OutprojSched S; S.init(gridDim.x, blockIdx.x);
    EpiOutproj E{p.x, p.out, p.ln_g, p.ln_b, p.ws, lds, &bar, fused};
    gemm_phase<EpiOutproj, OutprojSched>((LAS unsigned char*)lds, (const bf16_t*)(p.ws + OFF_Y), (const bf16_t*)(p.ws + OFF_WOUT), S, E);
}

constexpr int KROW = 72;
__device__ __forceinline__ float relu_(float x) { int i = __builtin_bit_cast(int, x); i = i > 0 ? i : 0; return __builtin_bit_cast(float, i); }
__device__ __forceinline__ void softplus_pack(const f32x16& z, f16x8 (&lf)[2]) {
    unsigned w[8];
#pragma unroll
    for (int i = 0; i < 8; ++i) {
        const float z0 = z[2 * i], z1 = z[2 * i + 1];
        const float l0 = __builtin_amdgcn_logf(1.0f + __builtin_amdgcn_exp2f(-__builtin_fabsf(z0))), l1 = __builtin_amdgcn_logf(1.0f + __builtin_amdgcn_exp2f(-__builtin_fabsf(z1)));
        w[i] = cvt_pk_f16(relu_(z0) + l0, relu_(z1) + l1);
    }
    u32x4 t0 = {w[0], w[1], w[2], w[3]}, t1 = {w[4], w[5], w[6], w[7]};
    lf[0] = __builtin_bit_cast(f16x8, t0); lf[1] = __builtin_bit_cast(f16x8, t1);
}
__device__ __forceinline__ void expo_pack(const f32x16& z, const f32x16& cum, bf16x8 (&pf)[2]) {
    unsigned w[8];
#pragma unroll
    for (int i = 0; i < 8; ++i) w[i] = cvt_pk_bf16(__builtin_amdgcn_exp2f(z[2 * i] + cum[2 * i]), __builtin_amdgcn_exp2f(z[2 * i + 1] + cum[2 * i + 1]));
    u32x4 t0 = {w[0], w[1], w[2], w[3]}, t1 = {w[4], w[5], w[6], w[7]};
    pf[0] = __builtin_bit_cast(bf16x8, t0); pf[1] = __builtin_bit_cast(bf16x8, t1);
}
__device__ __forceinline__ void exp_pack(const f32x16& e, bf16x8 (&pf)[2]) {
    unsigned w[8];
#pragma unroll
    for (int i = 0; i < 8; ++i) w[i] = cvt_pk_bf16(__builtin_amdgcn_exp2f(e[2 * i]), __builtin_amdgcn_exp2f(e[2 * i + 1]));
    u32x4 t0 = {w[0], w[1], w[2], w[3]}, t1 = {w[4], w[5], w[6], w[7]};
    pf[0] = __builtin_bit_cast(bf16x8, t0); pf[1] = __builtin_bit_cast(bf16x8, t1);
}
__device__ __forceinline__ f32x16 bcast16(float v) { f32x16 r;
#pragma unroll
    for (int i = 0; i < 16; ++i) r[i] = v;
    return r; }

__device__ __forceinline__ void tile_transpose(float* reg, const f32x16& acc, const float add, const int c, const int hh, const int lane, f32x4 (&out)[4]) {
    asm volatile("" ::: "memory");
#pragma unroll
    for (int g4 = 0; g4 < 4; ++g4) { f32x4 v = {acc[4 * g4 + 0] + add, acc[4 * g4 + 1] + add, acc[4 * g4 + 2] + add, acc[4 * g4 + 3] + add}; *(f32x4*)(reg + c * 36 + 8 * g4 + 4 * hh) = v; }
    asm volatile("" ::: "memory");
    const int t = lane >> 1, half = lane & 1;
#pragma unroll
    for (int j = 0; j < 4; ++j) out[j] = *(const f32x4*)(reg + t * 36 + half * 16 + 4 * j);
    asm volatile("" ::: "memory");
}

constexpr int WAVE_LDS = 14336;
typedef short s16x4 __attribute__((ext_vector_type(4)));
constexpr int VTROW = 40;
__device__ __forceinline__ void attn_wave_item(const Params& p, unsigned char* lds, const int b, const int h, const int qblk) {
    const bf16_t* proj = (const bf16_t*)(p.ws + OFF_PROJ); bf16_t* yb = (bf16_t*)(p.ws + OFF_Y);
    int tid = threadIdx.x; asm volatile("" : "+v"(tid)); const int lane = tid & 63, wave = __builtin_amdgcn_readfirstlane(tid >> 6), c = lane & 31, hh = lane >> 5;
    bf16_t* Kw = (bf16_t*)(lds + wave * WAVE_LDS);
    LAS unsigned char* Vw = (LAS unsigned char*)lds + wave * WAVE_LDS + 4608;
    const size_t tokbase = (size_t)b * SEQ; const int tq0 = qblk * 32;
    bf16x8 qf[4];
    { const bf16_t* qp = proj + (tokbase + tq0 + c) * NPROJ + C_Q + h * 64 + hh * 8;
#pragma unroll
      for (int ks = 0; ks < 4; ++ks) qf[ks] = *(const bf16x8*)(qp + ks * 16); }
    f16x8 uf[2];
#pragma unroll
    for (int ks2 = 0; ks2 < 2; ++ks2)
#pragma unroll
        for (int jj = 0; jj < 8; ++jj) { const int key = 16 * ks2 + 8 * (jj >> 2) + 4 * hh + (jj & 3); uf[ks2][jj] = (key >= c) ? (_Float16)-1.0f : (_Float16)0.0f; }
    f32x16 o0 = bcast16(0.f), o1 = bcast16(0.f);
    float R = 0.f;
    unsigned troff[2];
    { const int blk = (lane >> 4) & 1, q = (lane & 15) >> 2, pp = lane & 3, sw = (q >> 1) & 1;
#pragma unroll
      for (int dt = 0; dt < 2; ++dt) troff[dt] = (unsigned)((4 * hh + q) * 128 + 64 * (dt ^ sw) + 16 * (2 * blk + (pp >> 1)) + 8 * (pp & 1)); }
    const int lkey = lane >> 3, lch = lane & 7;
    const bf16_t* kvbase = proj + (tokbase + lkey) * NPROJ + h * 64 + lch * 8;
    u32x4 kreg[4], vreg[4];
#pragma unroll
    for (int j = 0; j < 4; ++j) { const bf16_t* rp = kvbase + (size_t)(tq0 + 8 * j) * NPROJ; kreg[j] = *(const u32x4*)(rp + C_K); vreg[j] = *(const u32x4*)(rp + C_VB); }
#pragma unroll
    for (int ks = 0; ks < 4; ++ks) asm volatile("" : "+v"(qf[ks]));
    for (int ks0 = tq0; ks0 >= 0; ks0 -= 32) {
        asm volatile("" ::: "memory");
#pragma unroll
        for (int j = 0; j < 4; ++j) { const int key = lkey + 8 * j;
            *(u32x4*)(Kw + key * KROW + lch * 8) = kreg[j];
            *(LAS u32x4*)(Vw + key * 128 + 16 * (lch ^ (((key >> 1) & 1) << 2))) = vreg[j]; }
        asm volatile("" ::: "memory");
        if (ks0 >= 32) {
#pragma unroll
            for (int j = 0; j < 4; ++j) { const bf16_t* rp = kvbase + (size_t)(ks0 - 32 + 8 * j) * NPROJ; kreg[j] = *(const u32x4*)(rp + C_K); vreg[j] = *(const u32x4*)(rp + C_VB); }
        }
        f32x16 z = bcast16(0.f);
#pragma unroll
        for (int ks = 0; ks < 4; ++ks) { const bf16x8 kf = *(const bf16x8*)(Kw + c * KROW + ks * 16 + hh * 8); z = __builtin_amdgcn_mfma_f32_32x32x16_bf16(kf, qf[ks], z, 0, 0, 0); }
        if (ks0 == tq0) {
#pragma unroll
            for (int r = 0; r < 16; ++r) { const int sl = (r & 3) + 8 * (r >> 2) + 4 * hh; z[r] = (sl >= c) ? -__builtin_inff() : z[r]; }
        }
        f16x8 lf[2]; softplus_pack(z, lf);
        f32x16 e = z + R;
        e = __builtin_amdgcn_mfma_f32_32x32x16_f16(uf[0], lf[0], e, 0, 0, 0);
        e = __builtin_amdgcn_mfma_f32_32x32x16_f16(uf[1], lf[1], e, 0, 0, 0);
        bf16x8 pf[2]; exp_pack(e, pf);
        { const float z0 = z[0]; const float cum0 = (z0 == -__builtin_inff()) ? R : (e[0] - z0); const auto rr = __builtin_amdgcn_permlane32_swap(__float_as_uint(cum0), __float_as_uint(cum0), false, false);
          R = __uint_as_float(rr[0]); }
#pragma unroll
        for (int ks2 = 0; ks2 < 2; ++ks2) {
            const s16x4 t00 = __builtin_amdgcn_ds_read_tr16_b64_v4i16((LAS s16x4*)(Vw + troff[0] + ks2 * 2048)), t01 = __builtin_amdgcn_ds_read_tr16_b64_v4i16((LAS s16x4*)(Vw + troff[0] + ks2 * 2048 + 1024));
            const s16x4 t10 = __builtin_amdgcn_ds_read_tr16_b64_v4i16((LAS s16x4*)(Vw + troff[1] + ks2 * 2048)), t11 = __builtin_amdgcn_ds_read_tr16_b64_v4i16((LAS s16x4*)(Vw + troff[1] + ks2 * 2048 + 1024));
            const bf16x8 v0 = {t00[0], t00[1], t00[2], t00[3], t01[0], t01[1], t01[2], t01[3]}, v1 = {t10[0], t10[1], t10[2], t10[3], t11[0], t11[1], t11[2], t11[3]};
            o0 = __builtin_amdgcn_mfma_f32_32x32x16_bf16(v0, pf[ks2], o0, 0, 0, 0); o1 = __builtin_amdgcn_mfma_f32_32x32x16_bf16(v1, pf[ks2], o1, 0, 0, 0);
        }
        if (__builtin_amdgcn_ballot_w64(R > -140.0f) == 0ull) break;
    }
    { float* reg = (float*)(lds + wave * WAVE_LDS + 9728);
      const int t = lane >> 1, half = lane & 1; const size_t tok = tokbase + tq0 + t;
      const bf16_t* zp = proj + tok * NPROJ + C_ZB + h * 64 + half * 16; bf16_t* yp = yb + tok * D_MODEL + 512 + h * 64 + half * 16;
      u32x4 zz[2][2];
#pragma unroll
      for (int dt = 0; dt < 2; ++dt) { zz[dt][0] = *(const u32x4*)(zp + dt * 32); zz[dt][1] = *(const u32x4*)(zp + dt * 32 + 8); }
#pragma unroll
      for (int dt = 0; dt < 2; ++dt) { f32x4 ov[4]; tile_transpose(reg, dt ? o1 : o0, 0.f, c, hh, lane, ov);
#pragma unroll
          for (int q = 0; q < 2; ++q) { const u32x4 z4 = zz[dt][q]; const f32x4 a = ov[2 * q], b2 = ov[2 * q + 1]; u32x4 o;
              o[0] = cvt_pk_bf16(bflo(z4[0]) * a[0], bfhi(z4[0]) * a[1]); o[1] = cvt_pk_bf16(bflo(z4[1]) * a[2], bfhi(z4[1]) * a[3]);
              o[2] = cvt_pk_bf16(bflo(z4[2]) * b2[0], bfhi(z4[2]) * b2[1]); o[3] = cvt_pk_bf16(bflo(z4[3]) * b2[2], bfhi(z4[3]) * b2[3]);
              *(u32x4*)(yp + dt * 32 + 8 * q) = o; } } }
}

constexpr int VROW = 136;
__device__ __forceinline__ void sgu_item(const Params& p, unsigned char* lds, const int ch, const int hf) {
    const bf16_t* proj = (const bf16_t*)(p.ws + OFF_PROJ); bf16_t* yb = (bf16_t*)(p.ws + OFF_Y); const bf16_t* wsp = (const bf16_t*)(p.ws + OFF_WSP);
    int tid = threadIdx.x; asm volatile("" : "+v"(tid)); const int lane = tid & 63, wave = __builtin_amdgcn_readfirstlane(tid >> 6), c = lane & 31, hh = lane >> 5;
    bf16_t* vw = (bf16_t*)(lds + wave * WAVE_LDS);
    const size_t tok0 = (size_t)ch * CHUNK;
    const int g = hf * 4 + (wave >> 1), ct = wave & 1, ch0 = g * 64 + ct * 32;
    u32x4 vv[2][4]; f32x4 st[2][4];
#pragma unroll
    for (int i = 0; i < 2; ++i) { const bf16_t* vp = proj + (tok0 + lane + 64 * i) * NPROJ + C_V + ch0; const float* sp = (const float*)(p.ws + OFF_VST) + (tok0 + lane + 64 * i) * 16;
#pragma unroll
        for (int j = 0; j < 4; ++j) { vv[i][j] = *(const u32x4*)(vp + 8 * j); st[i][j] = *(const f32x4*)(sp + 4 * j); } }
    bf16x8 wf[20];
#pragma unroll
    for (int tt = 0; tt < 4; ++tt) {
#pragma unroll
        for (int ks = 0; ks < 2 * (tt + 1); ++ks) wf[tt * (tt + 1) + ks] = *(const bf16x8*)(wsp + ((size_t)(((g * 4 + tt) * 8 + ks) * 64 + lane)) * 8); }
#pragma unroll
    for (int i = 0; i < 2; ++i) { const int sidx = lane + 64 * i;
        const float s1 = ((st[i][0][0] + st[i][0][2]) + (st[i][1][0] + st[i][1][2])) + ((st[i][2][0] + st[i][2][2]) + (st[i][3][0] + st[i][3][2]));
        const float s2 = ((st[i][0][1] + st[i][0][3]) + (st[i][1][1] + st[i][1][3])) + ((st[i][2][1] + st[i][2][3]) + (st[i][3][1] + st[i][3][3]));
        const float mean = s1 * (1.0f / 512.f); const float var = fmaxf(s2 * (1.0f / 512.f) - mean * mean, 0.f); const float rstd = 1.0f / sqrtf(var + LN_EPS);
#pragma unroll
        for (int j = 0; j < 4; ++j)
#pragma unroll
            for (int e = 0; e < 4; ++e) { const int cl = 8 * j + 2 * e; const unsigned w = vv[i][j][e];
                const float a = (bflo(w) - mean) * rstd * p.sgu_g[ch0 + cl] + p.sgu_b[ch0 + cl], bb = (bfhi(w) - mean) * rstd * p.sgu_g[ch0 + cl + 1] + p.sgu_b[ch0 + cl + 1];
                vw[cl * VROW + sidx] = f2bf(a); vw[(cl + 1) * VROW + sidx] = f2bf(bb); } }
    asm volatile("" ::: "memory");
    const bf16_t* vrow = vw + c * VROW + hh * 8;
    float* reg = (float*)(lds + wave * WAVE_LDS + 9728);
#pragma unroll
    for (int tt = 0; tt < 4; ++tt) {
        const float bs = p.b_sp[g * CHUNK + tt * 32 + c];
        const int t2 = lane >> 1, half = lane & 1; const size_t tok = tok0 + tt * 32 + t2;
        const bf16_t* up = proj + tok * NPROJ + C_U + ch0 + half * 16; const bf16_t* zp = proj + tok * NPROJ + C_ZA + ch0 + half * 16; bf16_t* yp = yb + tok * D_MODEL + ch0 + half * 16;
        const u32x4 u0 = *(const u32x4*)(up), u1 = *(const u32x4*)(up + 8), z0 = *(const u32x4*)(zp), z1 = *(const u32x4*)(zp + 8);
        f32x16 acc = bcast16(0.f);
#pragma unroll
        for (int ks = 0; ks < 2 * (tt + 1); ++ks) { const bf16x8 af = *(const bf16x8*)(vrow + ks * 16); acc = __builtin_amdgcn_mfma_f32_32x32x16_bf16(af, wf[tt * (tt + 1) + ks], acc, 0, 0, 0); }
        f32x4 mv[4]; tile_transpose(reg, acc, bs, c, hh, lane, mv);
#pragma unroll
        for (int q = 0; q < 2; ++q) { const u32x4 uu = q ? u1 : u0, zz = q ? z1 : z0; const f32x4 a = mv[2 * q], b2 = mv[2 * q + 1]; u32x4 o;
            o[0] = cvt_pk_bf16(bflo(zz[0]) * bflo(uu[0]) * a[0], bfhi(zz[0]) * bfhi(uu[0]) * a[1]); o[1] = cvt_pk_bf16(bflo(zz[1]) * bflo(uu[1]) * a[2], bfhi(zz[1]) * bfhi(uu[1]) * a[3]);
            o[2] = cvt_pk_bf16(bflo(zz[2]) * bflo(uu[2]) * b2[0], bfhi(zz[2]) * bfhi(uu[2]) * b2[1]); o[3] = cvt_pk_bf16(bflo(zz[3]) * bflo(uu[3]) * b2[2], bfhi(zz[3]) * bfhi(uu[3]) * b2[3]);
            *(u32x4*)(yp + 8 * q) = o; }
    }
    asm volatile("" ::: "memory");
}

__device__ void p_mixers(const Params& p, unsigned char* lds) {
    const int wave = __builtin_amdgcn_readfirstlane((int)threadIdx.x >> 6);
    const int sgu_step = (wave < 4) ? 0 : 2;
    for (int it = blockIdx.x; it < 256; it += gridDim.x) {
        const int xcd = it & 7, slot = it >> 3; const int bh = xcd * 8 + (slot >> 2), pr = slot & 3;
        int u = 0;
        for (int step = 0; step < 3; ++step) {
            if (step == sgu_step) sgu_item(p, lds, it >> 1, it & 1);
            else { attn_wave_item(p, lds, bh >> 3, bh & 7, (u ? pr : 7 - pr) * 8 + wave); ++u; }
        }
    }
}

__device__ void p_ln(const Params& p) {
    int tid = threadIdx.x; asm volatile("" : "+v"(tid)); const int lane = tid & 63, wave = tid >> 6;
    for (int row = blockIdx.x * 8 + wave; row < NTOK; row += gridDim.x * 8) {
        float* rp = p.out + (size_t)row * D_MODEL; f32x4 v[4]; float s = 0.f;
#pragma unroll
        for (int j = 0; j < 4; ++j) { v[j] = *(const f32x4*)(rp + lane * 4 + 256 * j); s += (v[j][0] + v[j][1]) + (v[j][2] + v[j][3]); }
#pragma unroll
        for (int o = 32; o; o >>= 1) s += __shfl_xor(s, o);
        const float mu = s * (1.0f / 1024.f); float q = 0.f;
#pragma unroll
        for (int j = 0; j < 4; ++j) { const f32x4 d = v[j] - mu; q += (d[0] * d[0] + d[1] * d[1]) + (d[2] * d[2] + d[3] * d[3]); }
#pragma unroll
        for (int o = 32; o; o >>= 1) q += __shfl_xor(q, o);
        const float rstd = 1.0f / sqrtf(q * (1.0f / 1024.f) + LN_EPS);
#pragma unroll
        for (int j = 0; j < 4; ++j) { const int col = lane * 4 + 256 * j; const f32x4 g = *(const f32x4*)(p.ln_g + col), bb = *(const f32x4*)(p.ln_b + col);
            *(f32x4*)(rp + col) = (v[j] - mu) * rstd * g + bb; }
    }
}

#if MODE == 0
__global__ void __launch_bounds__(NT, 2) mega(Params p) {
    extern __shared__ __attribute__((aligned(16))) unsigned char lds[];
    volatile LAS unsigned* st = (volatile LAS unsigned*)((LAS unsigned char*)lds + 131072);
    if (threadIdx.x == 0) { st[0] = 0u; st[1] = 0u; st[2] = 0u; st[3] = 0u; }
    __syncthreads();
    const XcdBarrier bar = xcd_barrier_post(g_bar, st);
    if (p.pad == 0x7fffffff) cg::this_grid().sync();
    p0_prologue(p, lds); xcd_barrier(bar);
    p_hconv(p); xcd_barrier(bar);
    p_inproj(p, lds); xcd_barrier(bar);
    p_mixers(p, lds); xcd_barrier(bar);
    const bool fused = (gridDim.x == 256);
    p_outproj(p, lds, bar, fused);
    if (!fused) { xcd_barrier(bar); p_ln(p); }
    xcd_barrier_retire(g_bar);
}
#else
__global__ void __launch_bounds__(NT, 2) mega(Params p) { extern __shared__ __attribute__((aligned(16))) unsigned char lds[]; p0_prologue(p, lds); }
__global__ void __launch_bounds__(NT, 2) k_ph1(Params p) { p_hconv(p); }
__global__ void __launch_bounds__(NT, 2) k_ph2(Params p) { extern __shared__ __attribute__((aligned(16))) unsigned char lds[]; p_inproj(p, lds); }
__global__ void __launch_bounds__(NT, 2) k_ph3(Params p) { extern __shared__ __attribute__((aligned(16))) unsigned char lds[]; p_mixers(p, lds); }
__global__ void __launch_bounds__(NT, 2) k_ph4(Params p) { extern __shared__ __attribute__((aligned(16))) unsigned char lds[]; XcdBarrier bar{}; p_outproj(p, lds, bar, false); }
__global__ void __launch_bounds__(NT, 2) k_ph5(Params p) { p_ln(p); }
#endif

extern "C" void kernel_launch(void* const* d_in, const int* in_sizes, int n_in, void* d_out, int out_size, void* d_ws, size_t ws_size, hipStream_t stream) {
    static int grid_blocks = 0;
    if (!grid_blocks) {
        int dev = 0, cus = 0, per_cu = 0;
        (void)hipGetDevice(&dev);
        (void)hipDeviceGetAttribute(&cus, hipDeviceAttributeMultiprocessorCount, dev);
        if (hipFuncSetAttribute((const void*)mega, hipFuncAttributeMaxDynamicSharedMemorySize, LDS_BYTES) != hipSuccess) fprintf(stderr, "hipFuncSetAttribute failed\n");
        if (hipOccupancyMaxActiveBlocksPerMultiprocessor(&per_cu, (const void*)mega, NT, LDS_BYTES) != hipSuccess || per_cu < 1) { fprintf(stderr, "occupancy query: %d\n", per_cu); per_cu = 1; }
        (void)hipGetLastError();
        if (per_cu > 1) per_cu = 1;
        grid_blocks = cus * per_cu;
    }
    Params p{};
    p.x = (const float*)d_in[0]; p.c = (const float*)d_in[1]; p.w_ada = (const float*)d_in[2]; p.b_ada = (const float*)d_in[3]; p.w_in = (const float*)d_in[4];
    p.sgu_g = (const float*)d_in[5]; p.sgu_b = (const float*)d_in[6]; p.w_sp = (const float*)d_in[7]; p.b_sp = (const float*)d_in[8]; p.w_out = (const float*)d_in[9];
    p.ln_g = (const float*)d_in[10]; p.ln_b = (const float*)d_in[11]; p.out = (float*)d_out; p.ws = (unsigned char*)d_ws; p.phase = 0; p.pad = 0;
#if MODE == 0
    void* args[] = {&p};
    hipError_t e = hipLaunchCooperativeKernel((const void*)mega, dim3(grid_blocks), dim3(NT), args, LDS_BYTES, stream);
    if (e != hipSuccess) fprintf(stderr, "cooperative launch failed: %s (grid %d)\n", hipGetErrorString(e), grid_blocks);
#else
    hipFuncSetAttribute((const void*)k_ph2, hipFuncAttributeMaxDynamicSharedMemorySize, LDS_BYTES);
    hipFuncSetAttribute((const void*)k_ph3, hipFuncAttributeMaxDynamicSharedMemorySize, LDS_BYTES);
    hipFuncSetAttribute((const void*)k_ph4, hipFuncAttributeMaxDynamicSharedMemorySize, LDS_BYTES);
    hipLaunchKernelGGL(mega, dim3(grid_blocks), dim3(NT), LDS_BYTES, stream, p);
    hipLaunchKernelGGL(k_ph1, dim3(grid_blocks), dim3(NT), 0, stream, p);
    hipLaunchKernelGGL(k_ph2, dim3(grid_blocks), dim3(NT), LDS_BYTES, stream, p);
    hipLaunchKernelGGL(k_ph3, dim3(grid_blocks), dim3(NT), LDS_BYTES, stream, p);
    hipLaunchKernelGGL(k_ph4, dim3(grid_blocks), dim3(NT), LDS_BYTES, stream, p);
    hipLaunchKernelGGL(k_ph5, dim3(grid_blocks), dim3(NT), 0, stream, p);
#endif
}
```

```cpp
#include <hip/hip_runtime.h>
#include <hip/hip_cooperative_groups.h>
#include <cstdint>
#include <cstdio>
namespace cg = cooperative_groups;

#ifndef MODE
#define MODE 0
#endif

typedef unsigned short bf16_t;
typedef short bf16x8 __attribute__((ext_vector_type(8)));
typedef _Float16 f16x8 __attribute__((ext_vector_type(8)));
typedef float f32x4 __attribute__((ext_vector_type(4)));
typedef float f32x16 __attribute__((ext_vector_type(16)));
typedef unsigned u32x2 __attribute__((ext_vector_type(2)));
typedef unsigned u32x4 __attribute__((ext_vector_type(4)));

constexpr int D_MODEL = 1024, BATCH = 8, SEQ = 2048, NTOK = BATCH * SEQ;
constexpr int NPROJ = 3584, CHUNK = 128, NGRP = 8, NHEAD = 8;
constexpr int C_U = 0, C_V = 512, C_ZA = 1024, C_Q = 1536, C_K = 2048, C_VB = 2560, C_ZB = 3072;
constexpr float LN_EPS = 1e-5f;
constexpr float ALPHA = 1.189207115002721f;
constexpr float LOG2E = 1.4426950408889634f;
constexpr float QSCALE = 0.125f * LOG2E;
constexpr int NT = 512;
constexpr int LDS_BYTES = 131072 + 16;

__device__ __forceinline__ bf16_t f2bf(float f) { unsigned u = __float_as_uint(f); u += 0x7fffu + ((u >> 16) & 1u); return (bf16_t)(u >> 16); }
__device__ __forceinline__ float bf2f(bf16_t b) { return __uint_as_float(((unsigned)b) << 16); }
__device__ __forceinline__ float bflo(unsigned w) { return __uint_as_float(w << 16); }
__device__ __forceinline__ float bfhi(unsigned w) { return __uint_as_float(w & 0xffff0000u); }
typedef float f32x2_ __attribute__((ext_vector_type(2)));
typedef __bf16 bf16x2_ __attribute__((ext_vector_type(2)));
typedef _Float16 f16x2_ __attribute__((ext_vector_type(2)));
__device__ __forceinline__ unsigned cvt_pk_bf16(float lo, float hi) { f32x2_ v = {lo, hi}; return __builtin_bit_cast(unsigned, __builtin_convertvector(v, bf16x2_)); }
__device__ __forceinline__ unsigned cvt_pk_f16(float lo, float hi) { f32x2_ v = {lo, hi}; return __builtin_bit_cast(unsigned, __builtin_convertvector(v, f16x2_)); }
__device__ __forceinline__ float sigmoidf_(float v) { return __builtin_amdgcn_rcpf(1.0f + __builtin_amdgcn_exp2f(-v * LOG2E)); }
__device__ __forceinline__ float siluf_(float v) { return v * sigmoidf_(v); }
__device__ __forceinline__ float geluf_(float v) { return v * sigmoidf_(1.5957691216057308f * (v + 0.044715f * v * v * v)); }
typedef float f32x2v __attribute__((ext_vector_type(2)));
__device__ __forceinline__ f32x2v gelu2_(f32x2v v) { const f32x2v u = v * ((v * v) * 0.044715f + 1.0f); const f32x2v t = u * (-1.5957691216057308f * LOG2E);
    f32x2v e; e.x = __builtin_amdgcn_exp2f(t.x); e.y = __builtin_amdgcn_exp2f(t.y); const f32x2v d = e + 1.0f; f32x2v r; r.x = __builtin_amdgcn_rcpf(d.x); r.y = __builtin_amdgcn_rcpf(d.y); return v * r; }
__device__ __forceinline__ f32x2v silu2_(f32x2v v) { const f32x2v t = v * (-LOG2E);
    f32x2v e; e.x = __builtin_amdgcn_exp2f(t.x); e.y = __builtin_amdgcn_exp2f(t.y); const f32x2v d = e + 1.0f; f32x2v r; r.x = __builtin_amdgcn_rcpf(d.x); r.y = __builtin_amdgcn_rcpf(d.y); return v * r; }

constexpr size_t OFF_MOD = 0;
constexpr size_t OFF_HB = 1 << 20;
constexpr size_t OFF_WIN = OFF_HB + (size_t)NTOK * D_MODEL * 2;
constexpr size_t OFF_WOUT = OFF_WIN + (size_t)NPROJ * D_MODEL * 2;
constexpr size_t OFF_WSP = OFF_WOUT + (size_t)D_MODEL * D_MODEL * 2;
constexpr size_t OFF_PROJ = OFF_WSP + (size_t)NGRP * CHUNK * CHUNK * 2;
constexpr size_t OFF_Y = OFF_PROJ + (size_t)NTOK * NPROJ * 2;
constexpr size_t OFF_VST = OFF_Y + (size_t)NTOK * D_MODEL * 2;

struct Params {
    const float* x; const float* c; const float* w_ada; const float* b_ada; const float* w_in; const float* sgu_g; const float* sgu_b;
    const float* w_sp; const float* b_sp; const float* w_out; const float* ln_g; const float* ln_b;
    float* out; unsigned char* ws; int phase; int pad;
};


#define XB_TMO      128
#define XB_XCNT(j)  (256  + 64 * (j))
#define XB_XSUB(j)  (1280 + 64 * (j))
#define XB_XGEN(j)  (2304 + 64 * (j))
#define XB_TOP      3328
#define XB_TOPGEN   3392
#define XCD_BAR_WORDS 3456
#define XB_SPIN_CAP (1u << 18)
#define LAS __attribute__((address_space(3)))
__device__ __forceinline__ unsigned xb_ld(unsigned* p)              { return __hip_atomic_load(p, __ATOMIC_RELAXED, __HIP_MEMORY_SCOPE_AGENT); }
__device__ __forceinline__ unsigned xb_add(unsigned* p, unsigned v) { return __hip_atomic_fetch_add(p, v, __ATOMIC_RELAXED, __HIP_MEMORY_SCOPE_AGENT); }
__device__ __forceinline__ unsigned xb_xcc_id() { return (unsigned)__builtin_amdgcn_s_getreg((3 << 11) | 20) & 0xFu; }
#define XB_SPIN(cond, bar) do { unsigned _sp = 0; while (cond) { __builtin_amdgcn_s_sleep(1); \
    if ((++_sp & 255u) == 0u) { if (xb_ld(&(bar)[XB_TMO])) break; if (_sp > XB_SPIN_CAP) { atomicAdd(&(bar)[XB_TMO], 1u); break; } } } } while (0)
struct XcdBarrier { unsigned* bar; unsigned x; volatile LAS unsigned* st; };
__device__ __forceinline__ XcdBarrier xcd_barrier_post(unsigned* bar, volatile LAS unsigned* st) {
    XcdBarrier b; b.bar = bar; b.x = xb_xcc_id(); b.st = st;
    if (threadIdx.x == 0) (void)xb_add(&bar[XB_XCNT(b.x)], 1u);
    return b;
}
__device__ __forceinline__ void xcd_barrier_complete(unsigned* bar, unsigned x, unsigned& nloc, unsigned& nx) {
    const unsigned G = gridDim.x * gridDim.y * gridDim.z;
    unsigned sum, cnt, mine, sp = 0u;
    for (;;) {
        sum = 0u; cnt = 0u; mine = 0u;
#pragma unroll
        for (unsigned j = 0; j < 16; ++j) { const unsigned c = xb_ld(&bar[XB_XCNT(j)]); sum += c; cnt += (c > 0u) ? 1u : 0u; mine = (j == x) ? c : mine; }
        if (sum == G) break;
        __builtin_amdgcn_s_sleep(1);
        if ((++sp & 255u) == 0u) { if (xb_ld(&bar[XB_TMO])) break; if (sp > XB_SPIN_CAP) { atomicAdd(&bar[XB_TMO], 1u); break; } }
    }
    nloc = mine > 0u ? mine : 1u; nx = cnt > 0u ? cnt : 1u;
}
__device__ __forceinline__ void xcd_barrier(const XcdBarrier& b) {
    asm volatile("s_waitcnt vmcnt(0)" ::: "memory");
    __syncthreads();
    if (threadIdx.x == 0) {
        unsigned* bar = b.bar;
        __builtin_amdgcn_s_waitcnt(0);
        unsigned nloc = b.st[0], nx = b.st[1];
        if (nloc == 0u) { xcd_barrier_complete(bar, b.x, nloc, nx); b.st[0] = nloc; b.st[1] = nx; }
        const unsigned old = xb_add(&bar[XB_XSUB(b.x)], 1u);
        const unsigned gen = old / nloc;
        if (old + 1u == (gen + 1u) * nloc) {
            __builtin_amdgcn_fence(__ATOMIC_RELEASE, "agent");
            asm volatile("s_waitcnt vmcnt(0)" ::: "memory");
            const unsigned og = xb_add(&bar[XB_TOP], 1u);
            const unsigned tg = og / nx;
            if (og + 1u == (tg + 1u) * nx) xb_add(&bar[XB_TOPGEN], 1u);
            else XB_SPIN(xb_ld(&bar[XB_TOPGEN]) == tg, bar);
            __builtin_amdgcn_fence(__ATOMIC_ACQUIRE, "agent");
            xb_add(&bar[XB_XGEN(b.x)], 1u);
            asm volatile("s_waitcnt vmcnt(0)" ::: "memory");
        } else {
            XB_SPIN(xb_ld(&bar[XB_XGEN(b.x)]) == gen, bar);
            __builtin_amdgcn_fence(__ATOMIC_ACQUIRE, "agent");
            asm volatile("s_waitcnt vmcnt(0)" ::: "memory");
        }
    }
    __syncthreads();
}
#define XB_EXIT 64
__device__ unsigned g_bar[XCD_BAR_WORDS];
__device__ __forceinline__ void xcd_barrier_retire(unsigned* bar) {
    __syncthreads();
    if (threadIdx.x == 0) {
        const unsigned G = gridDim.x * gridDim.y * gridDim.z;
        if (xb_add(&bar[XB_EXIT], 1u) == G - 1u) {
            __hip_atomic_store(&bar[XB_TMO], 0u, __ATOMIC_RELAXED, __HIP_MEMORY_SCOPE_AGENT);
            for (int j = 0; j < 16; ++j) { __hip_atomic_store(&bar[XB_XCNT(j)], 0u, __ATOMIC_RELAXED, __HIP_MEMORY_SCOPE_AGENT); __hip_atomic_store(&bar[XB_XSUB(j)], 0u, __ATOMIC_RELAXED, __HIP_MEMORY_SCOPE_AGENT);
                                           __hip_atomic_store(&bar[XB_XGEN(j)], 0u, __ATOMIC_RELAXED, __HIP_MEMORY_SCOPE_AGENT); }
            __hip_atomic_store(&bar[XB_TOP], 0u, __ATOMIC_RELAXED, __HIP_MEMORY_SCOPE_AGENT); __hip_atomic_store(&bar[XB_TOPGEN], 0u, __ATOMIC_RELAXED, __HIP_MEMORY_SCOPE_AGENT);
            __hip_atomic_store(&bar[XB_EXIT], 0u, __ATOMIC_RELAXED, __HIP_MEMORY_SCOPE_AGENT);
        }
    }
}

__device__ void p0_prologue(const Params& p, unsigned char* lds) {
    int tid = threadIdx.x; asm volatile("" : "+v"(tid)); const int lane = tid & 63, wave = tid >> 6;
    float* mod = (float*)(p.ws + OFF_MOD);
    float* sc = (float*)lds;
    float* red = (float*)(lds + 32768);
    for (int it = blockIdx.x; it < 96; it += gridDim.x) {
        for (int i = tid; i < 8 * 1024; i += NT) sc[i] = siluf_(p.c[i]);
        __syncthreads();
        const int q = tid & 7, r = tid >> 3; const int c0 = it * 32 + q * 4;
        float acc[8][4];
#pragma unroll
        for (int b = 0; b < 8; ++b) { acc[b][0] = 0.f; acc[b][1] = 0.f; acc[b][2] = 0.f; acc[b][3] = 0.f; }
        f32x4 wv[16];
#pragma unroll
        for (int i = 0; i < 16; ++i) wv[i] = __builtin_nontemporal_load((const f32x4*)(p.w_ada + (size_t)(r + 64 * i) * 3072 + c0));
#pragma unroll
        for (int i = 0; i < 16; ++i) { const int k = r + 64 * i; const f32x4 w = wv[i];
#pragma unroll
            for (int b = 0; b < 8; ++b) { const float s = sc[b * 1024 + k]; acc[b][0] += s * w[0]; acc[b][1] += s * w[1]; acc[b][2] += s * w[2]; acc[b][3] += s * w[3]; } }
#pragma unroll
        for (int b = 0; b < 8; ++b)
#pragma unroll
            for (int j = 0; j < 4; ++j) { float v = acc[b][j]; v += __shfl_xor(v, 8); v += __shfl_xor(v, 16); v += __shfl_xor(v, 32); acc[b][j] = v; }
        if (lane < 8) {
#pragma unroll
            for (int b = 0; b < 8; ++b)
#pragma unroll
                for (int j = 0; j < 4; ++j) red[(wave * 8 + q) * 32 + b * 4 + j] = acc[b][j];
        }
        __syncthreads();
        if (tid < 256) { const int b = tid >> 5, col = tid & 31, qq = col >> 2, j = col & 3; float s = 0.f;
#pragma unroll
            for (int w = 0; w < 8; ++w) s += red[(w * 8 + qq) * 32 + b * 4 + j];
            mod[b * 3072 + it * 32 + col] = s + p.b_ada[it * 32 + col]; }
        __syncthreads();
    }
    float* tb = (float*)(lds + 49152);
    {   const int n4 = tid & 15, kk = tid >> 4;
        f32x4 v0, v1;
        const int G = gridDim.x, bx = blockIdx.x, nh = (G > 96) ? G - 96 : 0, r1 = (nh > 0 && 5 * nh <= 896 + 256) ? 5 : 0, T1 = r1 * nh;
        auto my_tile = [&](int k) -> int { if (bx >= 96) { if (k < r1) return (bx - 96) + k * nh; k -= r1; } return T1 + bx + k * G; };
        auto tile_src = [&](int tl, const float*& W, bf16_t*& Wt, int& N, int& k0, int& n0) {
            if (tl < 896) { W = p.w_in; Wt = (bf16_t*)(p.ws + OFF_WIN); N = NPROJ; k0 = (tl / 56) * 64; n0 = (tl % 56) * 64; }
            else { const int t2 = tl - 896; W = p.w_out; Wt = (bf16_t*)(p.ws + OFF_WOUT); N = D_MODEL; k0 = (t2 / 16) * 64; n0 = (t2 % 16) * 64; } };
        f32x4 w0, w1;
#define TP_LOAD(R0, R1, TL) do { if ((TL) < 896 + 256) { const float* W_; bf16_t* Wt_; int N_, k0_, n0_; tile_src((TL), W_, Wt_, N_, k0_, n0_); \
            R0 = __builtin_nontemporal_load((const f32x4*)(W_ + (size_t)(k0_ + kk) * N_ + n0_ + n4 * 4)); R1 = __builtin_nontemporal_load((const f32x4*)(W_ + (size_t)(k0_ + kk + 32) * N_ + n0_ + n4 * 4)); } } while (0)
#define TP_BODY(R0, R1, TL, TLNEXT) do { const float* W; bf16_t* Wt; int N, k0, n0; tile_src((TL), W, Wt, N, k0, n0); \
            tb[kk * 65 + n4 * 4 + 0] = R0[0]; tb[kk * 65 + n4 * 4 + 1] = R0[1]; tb[kk * 65 + n4 * 4 + 2] = R0[2]; tb[kk * 65 + n4 * 4 + 3] = R0[3]; \
            tb[(kk + 32) * 65 + n4 * 4 + 0] = R1[0]; tb[(kk + 32) * 65 + n4 * 4 + 1] = R1[1]; tb[(kk + 32) * 65 + n4 * 4 + 2] = R1[2]; tb[(kk + 32) * 65 + n4 * 4 + 3] = R1[3]; \
            __syncthreads(); \
            TP_LOAD(R0, R1, (TLNEXT)); \
            { const int n = tid >> 3, ks = tid & 7; u32x4 o; \
              o[0] = cvt_pk_bf16(tb[(ks * 8 + 0) * 65 + n], tb[(ks * 8 + 1) * 65 + n]); o[1] = cvt_pk_bf16(tb[(ks * 8 + 2) * 65 + n], tb[(ks * 8 + 3) * 65 + n]); \
              o[2] = cvt_pk_bf16(tb[(ks * 8 + 4) * 65 + n], tb[(ks * 8 + 5) * 65 + n]); o[3] = cvt_pk_bf16(tb[(ks * 8 + 6) * 65 + n], tb[(ks * 8 + 7) * 65 + n]); \
              *(u32x4*)(Wt + (size_t)(n0 + n) * D_MODEL + k0 + ks * 8) = o; } \
            __syncthreads(); } while (0)
        TP_LOAD(v0, v1, my_tile(0)); TP_LOAD(w0, w1, my_tile(1));
        for (int kidx = 0;; kidx += 2) {
            const int ta = my_tile(kidx); if (ta >= 896 + 256) break;
            TP_BODY(v0, v1, ta, my_tile(kidx + 2));
            const int tb2 = my_tile(kidx + 1); if (tb2 >= 896 + 256) break;
            TP_BODY(w0, w1, tb2, my_tile(kidx + 3));
        }
#undef TP_LOAD
#undef TP_BODY
    }
    bf16_t* wsp = (bf16_t*)(p.ws + OFF_WSP);
    for (int i = blockIdx.x * NT + tid; i < NGRP * CHUNK * CHUNK / 8; i += gridDim.x * NT) {
        const int frag = i >> 6, l = i & 63, g = frag >> 5, tt = (frag >> 3) & 3, ks = frag & 7;
        const int t = tt * 32 + (l & 31), s0 = ks * 16 + (l >> 5) * 8; const int e = (g * CHUNK + t) * CHUNK + s0;
        const f32x4 a = *(const f32x4*)(p.w_sp + e), b = *(const f32x4*)(p.w_sp + e + 4);
        float v[8] = {a[0], a[1], a[2], a[3], b[0], b[1], b[2], b[3]};
#pragma unroll
        for (int j = 0; j < 8; ++j) v[j] = (s0 + j <= t) ? v[j] : 0.f;
        u32x4 o; o[0] = cvt_pk_bf16(v[0], v[1]); o[1] = cvt_pk_bf16(v[2], v[3]); o[2] = cvt_pk_bf16(v[4], v[5]); o[3] = cvt_pk_bf16(v[6], v[7]);
        *(u32x4*)(wsp + (size_t)i * 8) = o;
    }
}

__device__ void p_hconv(const Params& p) {
    const float* mod = (const float*)(p.ws + OFF_MOD); bf16_t* hb = (bf16_t*)(p.ws + OFF_HB);
    int tid = threadIdx.x; asm volatile("" : "+v"(tid));
    const size_t stride = (size_t)gridDim.x * NT, total = (size_t)NTOK * D_MODEL / 8;
    for (size_t i0 = (size_t)blockIdx.x * NT + tid; i0 < total; i0 += 4 * stride) {
        f32x4 x0[4], x1[4];
#pragma unroll
        for (int u = 0; u < 4; ++u) { const size_t i = i0 + u * stride; if (i < total) { x0[u] = __builtin_nontemporal_load((const f32x4*)(p.x + i * 8)); x1[u] = __builtin_nontemporal_load((const f32x4*)(p.x + i * 8 + 4)); } }
#pragma unroll
        for (int u = 0; u < 4; ++u) { const size_t i = i0 + u * stride; if (i < total) {
            const size_t e = i * 8; const int col = (int)(e & 1023); const int b = (int)(e >> 21);
            const f32x4 sh0 = *(const f32x4*)(mod + b * 3072 + col), sh1 = *(const f32x4*)(mod + b * 3072 + col + 4);
            const f32x4 sc0 = *(const f32x4*)(mod + b * 3072 + 1024 + col), sc1 = *(const f32x4*)(mod + b * 3072 + 1024 + col + 4);
            const f32x4 h0 = x0[u] * (1.0f + sc0) + sh0, h1 = x1[u] * (1.0f + sc1) + sh1;
            u32x4 o; o[0] = cvt_pk_bf16(h0[0], h0[1]); o[1] = cvt_pk_bf16(h0[2], h0[3]); o[2] = cvt_pk_bf16(h1[0], h1[1]); o[3] = cvt_pk_bf16(h1[2], h1[3]);
            *(u32x4*)(hb + e) = o; } }
    }
}

constexpr int BM = 256, BK = 64, HALF = 128, NXCD = 8, WGM = 8, HT = HALF * BK;
__device__ __forceinline__ int lds_byte(int r, int c) { int st = (r >> 4) * 2 + (c >> 5), rr = r & 15, cc = c & 31, ob = rr * 64 + cc * 2; return st * 1024 + (ob ^ (((ob >> 9) & 1) << 5)); }
__device__ __forceinline__ void stage_rc(int b, int& R, int& C) { int st = b / 1024, sb = b % 1024, swz = sb ^ (((sb >> 9) & 1) << 5); R = (st >> 1) * 16 + swz / 64; C = (st & 1) * 32 + (swz % 64) / 2; }

struct TileOrder {
    int nM, nN, nwg, G, c;
    __device__ void init(int M, int N, int G_, int c_) { nM = M / BM; nN = N / BM; nwg = nM * nN; G = G_; c = c_; }
    __device__ bool next(int i, int& pm, int& pn) const { const long L = (long)i * G + c; if (L >= nwg) return false; map((int)L, pm, pn); return true; }
    __device__ void map(int L, int& pm, int& pn) const {
        int wgid = L; { const int q = nwg / NXCD, r = nwg % NXCD, xcd = wgid % NXCD, off = wgid / NXCD; wgid = (xcd < r ? xcd * (q + 1) : r * (q + 1) + (xcd - r) * q) + off; }
        const int nig = WGM * nN, gid = wgid / nig, fm = gid * WGM, gsz = (nM - fm) < WGM ? (nM - fm) : WGM;
        pm = fm + ((wgid % nig) % gsz); pn = (wgid % nig) / gsz;
    }
};

struct GUnit { int pm, pn, half, hsel; };
constexpr int HTB = HALF * BK * 2;
template <class Epi, class Sched>
__device__ __forceinline__ void gemm_phase(LAS unsigned char* lds, const bf16_t* __restrict__ Ag, const bf16_t* __restrict__ Btg, const Sched& S, const Epi& E) {
    constexpr int K = D_MODEL, nt = K / BK;
    int gtx = threadIdx.x; asm volatile("" : "+v"(gtx));
    const int wid = __builtin_amdgcn_readfirstlane(gtx >> 6), lane = gtx & 63, wr = wid >> 2, wc = wid & 3, fr = lane & 15, fq = lane >> 4;
    unsigned voff[2], voffB[2];
#pragma unroll
    for (int i = 0; i < 2; ++i) { int R, C; stage_rc(gtx * 16 + i * 8192, R, C); voff[i] = (unsigned)(R * K + C) * 2u;
        const int rho = R & 31, nn = rho >> 4, ii = rho & 15, p32 = 8 * (ii >> 2) + 4 * nn + (ii & 3);
        const int Rg = Epi::PERM ? ((R >> 5) * 64 + p32) : R;
        voffB[i] = (unsigned)(Rg * K + C) * 2u; }
    constexpr size_t bstep = Epi::PERM ? (size_t)32 * K * 2 : (size_t)HALF * K * 2;
    constexpr size_t kstep = (size_t)(BK * 2), hstep = (size_t)HALF * K * 2, tstep = 2 * hstep;
    const unsigned ldsw = (unsigned)wid * 1024u;
    const int aoff = lds_byte(wr * 64 + fr, fq * 8), boff = lds_byte(wc * 32 + fr, fq * 8);
#define PG8_SA(b, h) (((b) * 2 + (h)) * HTB)
#define PG8_SB(b, h) ((4 + (b) * 2 + (h)) * HTB)
#define PG8_STAGE_(bufoff, gbase, vo) do { _Pragma("unroll") for (int _i = 0; _i < 2; ++_i) \
        __builtin_amdgcn_global_load_lds((const unsigned*)((const char*)(gbase) + (vo)[_i]), (LAS unsigned*)(lds + (bufoff) + ldsw + _i * 8192), 16, 0, 0); } while (0)
#define PG8_STAGE(bufoff, gbase) PG8_STAGE_(bufoff, gbase, voff)
#define PG8_STAGEB(bufoff, gbase, h) PG8_STAGE_(bufoff, (gbase) + (h) * bstep, voffB)
#define PG8_LDA(dst, b, h) do { _Pragma("unroll") for (int m = 0; m < 4; ++m) _Pragma("unroll") for (int k = 0; k < 2; ++k) dst[m][k] = *(const LAS bf16x8*)(lds + PG8_SA(b, h) + aoff + m * 2048 + k * 1024); } while (0)
#define PG8_LDB(dst, b, h) do { _Pragma("unroll") for (int n = 0; n < 2; ++n) _Pragma("unroll") for (int k = 0; k < 2; ++k) dst[n][k] = *(const LAS bf16x8*)(lds + PG8_SB(b, h) + boff + n * 2048 + k * 1024); } while (0)
#define PG8_MMA(ai, bj, At, Bt) do { __builtin_amdgcn_s_setprio(1); _Pragma("unroll") for (int m = 0; m < 4; ++m) _Pragma("unroll") for (int n = 0; n < 2; ++n) _Pragma("unroll") for (int k = 0; k < 2; ++k) \
        acc[ai][bj][m][n] = __builtin_amdgcn_mfma_f32_16x16x32_bf16(Bt[n][k], At[m][k], acc[ai][bj][m][n], 0, 0, 0); __builtin_amdgcn_s_setprio(0); } while (0)
#define PG8_WAIT_V(n) asm volatile("s_waitcnt vmcnt(" #n ")" ::: "memory")
#define PG8_WAIT_L(n) asm volatile("s_waitcnt lgkmcnt(" #n ")" ::: "memory")
#define PG8_BAR __builtin_amdgcn_s_barrier()
#define PG8_SCHED __builtin_amdgcn_sched_barrier(0)
    GUnit cur, nxt; int ui = 0;
    if (!S.next(0, cur)) return;
    f32x4 acc[2][2][4][2];
#pragma unroll
    for (int a = 0; a < 2; ++a)
#pragma unroll
        for (int b = 0; b < 2; ++b)
#pragma unroll
            for (int m = 0; m < 4; ++m)
#pragma unroll
                for (int n = 0; n < 2; ++n) acc[a][b][m][n] = (f32x4){0.f, 0.f, 0.f, 0.f};
    bf16x8 At[4][2], B0[2][2], B1[2][2];
    const char* cA = (const char*)Ag + (size_t)cur.pm * tstep + (size_t)cur.hsel * hstep; const char* cB = (const char*)Btg + (size_t)cur.pn * tstep;
    PG8_STAGEB(PG8_SB(0, 0), cB, 0); PG8_STAGEB(PG8_SB(0, 1), cB, 1); PG8_STAGE(PG8_SA(0, 0), cA); PG8_STAGE(PG8_SA(0, 1), cA + hstep);
    if (wr == 1) PG8_BAR;
    PG8_WAIT_V(2); PG8_BAR;
    PG8_STAGEB(PG8_SB(1, 0), cB + kstep, 0); PG8_STAGE(PG8_SA(1, 0), cA + kstep); PG8_STAGEB(PG8_SB(1, 1), cB + kstep, 1);
    PG8_WAIT_V(6); PG8_BAR;
    for (;;) {
        const bool has_next = S.next(ui + 1, nxt);
        const char* nA = has_next ? (const char*)Ag + (size_t)nxt.pm * tstep + (size_t)nxt.hsel * hstep : cA; const char* nB = has_next ? (const char*)Btg + (size_t)nxt.pn * tstep : cB;
        const bool full = !cur.half;
        for (int t = 0; t < nt; t += 2) {
            const bool last = (t == nt - 2);
            const char* a1 = cA + (size_t)(t + 1) * kstep;
            const char* a2 = last ? nA : cA + (size_t)(t + 2) * kstep; const char* b2 = last ? nB : cB + (size_t)(t + 2) * kstep;
            const char* a3 = a2 + kstep; const char* b3 = b2 + kstep;
            PG8_LDB(B0, 0, 0); PG8_LDB(B1, 0, 1); PG8_SCHED; PG8_LDA(At, 0, 0); PG8_STAGE(PG8_SA(1, 1), a1 + hstep);
            PG8_WAIT_V(8); PG8_WAIT_L(0); PG8_BAR; PG8_MMA(0, 0, At, B0); PG8_MMA(0, 1, At, B1); PG8_BAR; PG8_SCHED;
            if (full) { PG8_LDA(At, 0, 1); } PG8_STAGEB(PG8_SB(0, 0), b2, 0); PG8_STAGEB(PG8_SB(0, 1), b2, 1); PG8_STAGE(PG8_SA(0, 0), a2);
            PG8_WAIT_V(8); PG8_WAIT_L(0); PG8_BAR; if (full) { PG8_MMA(1, 0, At, B0); PG8_MMA(1, 1, At, B1); } PG8_BAR; PG8_SCHED;
            PG8_LDB(B0, 1, 0); PG8_LDB(B1, 1, 1); PG8_SCHED; PG8_LDA(At, 1, 0); PG8_STAGE(PG8_SA(0, 1), a2 + hstep);
            PG8_WAIT_V(8); PG8_WAIT_L(0); PG8_BAR; PG8_MMA(0, 0, At, B0); PG8_MMA(0, 1, At, B1); PG8_BAR; PG8_SCHED;
            if (full) { PG8_LDA(At, 1, 1); } PG8_STAGEB(PG8_SB(1, 0), b3, 0); PG8_STAGEB(PG8_SB(1, 1), b3, 1); PG8_STAGE(PG8_SA(1, 0), a3);
            PG8_WAIT_V(8); PG8_WAIT_L(0); PG8_BAR; if (full) { PG8_MMA(1, 0, At, B0); PG8_MMA(1, 1, At, B1); } PG8_BAR; PG8_SCHED;
        }
        if (wr == 0) PG8_BAR;
        E(acc, cur);
        if (!has_next) break;
#pragma unroll
        for (int a = 0; a < 2; ++a)
#pragma unroll
            for (int b = 0; b < 2; ++b)
#pragma unroll
                for (int m = 0; m < 4; ++m)
#pragma unroll
                    for (int n = 0; n < 2; ++n) acc[a][b][m][n] = (f32x4){0.f, 0.f, 0.f, 0.f};
        cur = nxt; cA = nA; cB = nB; ++ui;
        if (wr == 1) PG8_BAR;
    }
    PG8_WAIT_V(0);
    PG8_BAR;
#undef PG8_SA
#undef PG8_SB
#undef PG8_STAGE
#undef PG8_STAGEB
#undef PG8_STAGE_
#undef PG8_LDA
#undef PG8_LDB
#undef PG8_MMA
#undef PG8_WAIT_V
#undef PG8_WAIT_L
#undef PG8_BAR
#undef PG8_SCHED
}

struct InprojSched {
    TileOrder ord; int G, c, nfull, nunits;
    __device__ void init(int G_, int c_) { ord.init(NTOK, NPROJ, G_, c_); G = G_; c = c_; const int rem = ord.nwg % G, nsplit = (rem > 0 && 2 * rem <= G) ? rem : 0; nfull = ord.nwg - nsplit; nunits = nfull + 2 * nsplit; }
    __device__ bool next(int i, GUnit& u) const {
        const int L = i * G + c; if (L >= nunits) return false;
        u.half = (L >= nfull) ? 1 : 0; u.hsel = u.half ? ((L - nfull) & 1) : 0;
        ord.map(u.half ? nfull + ((L - nfull) >> 1) : L, u.pm, u.pn); return true;
    }
};
struct EpiInproj {
    static constexpr bool PERM = true;
    bf16_t* proj; float* vstb;
    __device__ __forceinline__ void operator()(const f32x4 (&acc)[2][2][4][2], const GUnit& u) const {
        int tx = threadIdx.x; asm volatile("" : "+v"(tx));
        const int wid = tx >> 6, lane = tx & 63, wr = wid >> 2, wc = wid & 3, fr = lane & 15, fq = lane >> 4;
        const int pm = u.pm, pn = u.pn, hsel = u.hsel; const bool half = u.half != 0;
        const int seg = pn >> 1;
#pragma unroll
        for (int ai = 0; ai < 2; ++ai) {
            if (half && ai == 1) break;
#pragma unroll
            for (int m = 0; m < 4; ++m) {
                const int row = pm * BM + hsel * HALF + ai * HALF + wr * 64 + m * 16 + fr;
                bf16_t* rowp = proj + (size_t)row * NPROJ + pn * BM + wc * 64 + fq * 8;
                float s1 = 0.f, s2 = 0.f;
#pragma unroll
                for (int bj = 0; bj < 2; ++bj) {
                    u32x4 o4;
#pragma unroll
                    for (int n = 0; n < 2; ++n) {
                        f32x4 v = acc[ai][bj][m][n];
                        if (seg <= 1) { const f32x2v a = gelu2_((f32x2v){v[0], v[1]}), b2 = gelu2_((f32x2v){v[2], v[3]}); v = (f32x4){a.x, a.y, b2.x, b2.y}; }
                        else if (seg == 2 || seg == 6) { const f32x2v a = silu2_((f32x2v){v[0], v[1]}), b2 = silu2_((f32x2v){v[2], v[3]}); v = (f32x4){a.x, a.y, b2.x, b2.y}; }
                        else if (seg == 3) { v = v * QSCALE; }
                        const unsigned o0 = cvt_pk_bf16(v[0], v[1]), o1 = cvt_pk_bf16(v[2], v[3]);
                        o4[2 * n] = o0; o4[2 * n + 1] = o1;
                        if (seg == 1) {
                            const float a0 = bflo(o0), a1 = bfhi(o0), a2 = bflo(o1), a3 = bfhi(o1);
                            s1 += (a0 + a1) + (a2 + a3); s2 += (a0 * a0 + a1 * a1) + (a2 * a2 + a3 * a3); }
                    }
                    *(u32x4*)(rowp + bj * 32) = o4;
                }
                if (seg == 1) {
                    s1 += __shfl_xor(s1, 16); s2 += __shfl_xor(s2, 16); s1 += __shfl_xor(s1, 32); s2 += __shfl_xor(s2, 32);
                    if (fq == 0) { float* vst = vstb + ((size_t)row * 8 + (pn & 1) * 4 + wc) * 2; vst[0] = s1; vst[1] = s2; }
                }
            }
        }
    }
};
__device__ void p_inproj(const Params& p, unsigned char* lds) {
    InprojSched S; S.init(gridDim.x, blockIdx.x);
    EpiInproj E{(bf16_t*)(p.ws + OFF_PROJ), (float*)(p.ws + OFF_VST)};
    gemm_phase<EpiInproj, InprojSched>((LAS unsigned char*)lds, (const bf16_t*)(p.ws + OFF_HB), (const bf16_t*)(p.ws + OFF_WIN), S, E);
}

constexpr size_t OFF_STATS = 256 * 1024;
struct OutprojSched { TileOrder ord;
    __device__ void init(int G_, int c_) { ord.init(NTOK, D_MODEL, G_, c_); }
    __device__ bool next(int i, GUnit& u) const { if (!ord.next(i, u.pm, u.pn)) return false; u.half = 0; u.hsel = 0; return true; } };
struct EpiOutproj {
    static constexpr bool PERM = false;
    const float* x; float* out; const float* ln_g; const float* ln_b; unsigned char* ws; unsigned char* lds; const XcdBarrier* bar; bool fused;
    __device__ __forceinline__ void operator()(f32x4 (&acc)[2][2][4][2], const GUnit& u) const {
        const float* mod = (const float*)(ws + OFF_MOD); const int pm = u.pm, pn = u.pn;
        int tx = threadIdx.x; asm volatile("" : "+v"(tx));
        const int wid = tx >> 6, lane = tx & 63, wr = wid >> 2, wc = wid & 3, fr = lane & 15, fq = lane >> 4;
        const int b = (pm * BM) / SEQ; const int col0 = pn * BM + wc * 32 + fq * 4;
        {   f32x4 gate[2][2];
#pragma unroll
            for (int bj = 0; bj < 2; ++bj)
#pragma unroll
                for (int n = 0; n < 2; ++n) gate[bj][n] = *(const f32x4*)(mod + b * 3072 + 2048 + col0 + bj * HALF + n * 16);
            f32x4 xa[4][2][2], xb[1][2][2];
#define XLOAD(dst, ai_, m_) do { const size_t off_ = (size_t)(pm * BM + (ai_) * HALF + wr * 64 + (m_) * 16 + fr) * D_MODEL + col0; \
                _Pragma("unroll") for (int bj = 0; bj < 2; ++bj) _Pragma("unroll") for (int n = 0; n < 2; ++n) dst[bj][n] = __builtin_nontemporal_load((const f32x4*)(x + off_ + bj * HALF + n * 16)); } while (0)
#define XFMA(src, ai_, m_) do { _Pragma("unroll") for (int bj = 0; bj < 2; ++bj) _Pragma("unroll") for (int n = 0; n < 2; ++n) acc[ai_][bj][m_][n] = src[bj][n] * ALPHA + gate[bj][n] * acc[ai_][bj][m_][n]; } while (0)
            XLOAD(xa[0], 0, 0); XLOAD(xa[1], 0, 1); XLOAD(xa[2], 0, 2); XLOAD(xa[3], 0, 3); XLOAD(xb[0], 1, 0);
            XFMA(xa[0], 0, 0); XFMA(xa[1], 0, 1); XFMA(xa[2], 0, 2); XFMA(xa[3], 0, 3);
            XLOAD(xa[0], 1, 1); XLOAD(xa[1], 1, 2); XLOAD(xa[2], 1, 3);
            XFMA(xb[0], 1, 0); XFMA(xa[0], 1, 1); XFMA(xa[1], 1, 2); XFMA(xa[2], 1, 3);
#undef XLOAD
#undef XFMA
        }
        if (!fused) {
#pragma unroll
            for (int ai = 0; ai < 2; ++ai)
#pragma unroll
                for (int m = 0; m < 4; ++m) { const size_t off = (size_t)(pm * BM + ai * HALF + wr * 64 + m * 16 + fr) * D_MODEL + col0;
#pragma unroll
                    for (int bj = 0; bj < 2; ++bj)
#pragma unroll
                        for (int n = 0; n < 2; ++n) *(f32x4*)(out + off + bj * HALF + n * 16) = acc[ai][bj][m][n]; }
            return;
        }
        asm volatile("s_waitcnt vmcnt(0)" ::: "memory"); __syncthreads();
        float* P = (float*)lds;
        float* S = (float*)(lds + 8192);
        float* gstats = (float*)(ws + OFF_STATS);
#pragma unroll
        for (int ai = 0; ai < 2; ++ai)
#pragma unroll
            for (int m = 0; m < 4; ++m) { float s1 = 0.f, s2 = 0.f;
#pragma unroll
                for (int bj = 0; bj < 2; ++bj)
#pragma unroll
                    for (int n = 0; n < 2; ++n) { const f32x4 v = acc[ai][bj][m][n]; s1 += (v[0] + v[1]) + (v[2] + v[3]); s2 += (v[0] * v[0] + v[1] * v[1]) + (v[2] * v[2] + v[3] * v[3]); }
                s1 += __shfl_xor(s1, 16); s2 += __shfl_xor(s2, 16); s1 += __shfl_xor(s1, 32); s2 += __shfl_xor(s2, 32);
                if (fq == 0) { const int rl = ai * HALF + wr * 64 + m * 16 + fr; P[(rl * 4 + wc) * 2] = s1; P[(rl * 4 + wc) * 2 + 1] = s2; } }
        __syncthreads();
        if (tx < 256) { const f32x4 a = *(const f32x4*)(P + tx * 8), c2 = *(const f32x4*)(P + tx * 8 + 4);
            float* gp = gstats + ((size_t)(pm * BM + tx) * 4 + pn) * 2; gp[0] = (a[0] + a[2]) + (c2[0] + c2[2]); gp[1] = (a[1] + a[3]) + (c2[1] + c2[3]); }
        xcd_barrier(*bar);
        if (tx < 256) { const float* gp = gstats + (size_t)(pm * BM + tx) * 8; const f32x4 a = *(const f32x4*)gp, c2 = *(const f32x4*)(gp + 4);
            const float mean = ((a[0] + a[2]) + (c2[0] + c2[2])) * (1.0f / 1024.f); const float ex2 = ((a[1] + a[3]) + (c2[1] + c2[3])) * (1.0f / 1024.f);
            const float var = fmaxf(ex2 - mean * mean, 0.f); S[tx * 2] = mean; S[tx * 2 + 1] = 1.0f / sqrtf(var + LN_EPS); }
        __syncthreads();
        {   f32x4 gg[2][2], bb[2][2];
#pragma unroll
            for (int bj = 0; bj < 2; ++bj)
#pragma unroll
                for (int n = 0; n < 2; ++n) { gg[bj][n] = *(const f32x4*)(ln_g + col0 + bj * HALF + n * 16); bb[bj][n] = *(const f32x4*)(ln_b + col0 + bj * HALF + n * 16); }
#pragma unroll
            for (int ai = 0; ai < 2; ++ai)
#pragma unroll
                for (int m = 0; m < 4; ++m) { const int rl = ai * HALF + wr * 64 + m * 16 + fr; const float mean = S[rl * 2], rstd = S[rl * 2 + 1];
                    const size_t off = (size_t)(pm * BM + rl) * D_MODEL + col0;
#pragma unroll
                    for (int bj = 0; bj < 2; ++bj)
#pragma unroll
                        for (int n = 0; n < 2; ++n) __builtin_nontemporal_store((acc[ai][bj][m][n] - mean) * rstd * gg[bj][n] + bb[bj][n], (f32x4*)(out + off + bj * HALF + n * 16)); } }
    }
};
__device__ void p_outproj(const Params& p, unsigned char* lds, const XcdBarrier& bar, const bool fused) {
    OutprojSched S; S.init(gridDim.x, blockIdx.x);
    EpiOutproj E{p.x, p.out, p.ln_g, p.ln_b, p.ws, lds, &bar, fused};
    gemm_phase<EpiOutproj, OutprojSched>((LAS unsigned char*)lds, (const bf16_t*)(p.ws + OFF_Y), (const bf16_t*)(p.ws + OFF_WOUT), S, E);
}

constexpr int KROW = 72;
__device__ __forceinline__ float relu_(float x) { int i = __builtin_bit_cast(int, x); i = i > 0 ? i : 0; return __builtin_bit_cast(float, i); }
__device__ __forceinline__ void softplus_pack(const f32x16& z, f16x8 (&lf)[2]) {
    unsigned w[8];
#pragma unroll
    for (int i = 0; i < 8; ++i) {
        const float z0 = z[2 * i], z1 = z[2 * i + 1];
        const float l0 = __builtin_amdgcn_logf(1.0f + __builtin_amdgcn_exp2f(-__builtin_fabsf(z0))), l1 = __builtin_amdgcn_logf(1.0f + __builtin_amdgcn_exp2f(-__builtin_fabsf(z1)));
        w[i] = cvt_pk_f16(relu_(z0) + l0, relu_(z1) + l1);
    }
    u32x4 t0 = {w[0], w[1], w[2], w[3]}, t1 = {w[4], w[5], w[6], w[7]};
    lf[0] = __builtin_bit_cast(f16x8, t0); lf[1] = __builtin_bit_cast(f16x8, t1);
}
__device__ __forceinline__ void expo_pack(const f32x16& z, const f32x16& cum, bf16x8 (&pf)[2]) {
    unsigned w[8];
#pragma unroll
    for (int i = 0; i < 8; ++i) w[i] = cvt_pk_bf16(__builtin_amdgcn_exp2f(z[2 * i] + cum[2 * i]), __builtin_amdgcn_exp2f(z[2 * i + 1] + cum[2 * i + 1]));
    u32x4 t0 = {w[0], w[1], w[2], w[3]}, t1 = {w[4], w[5], w[6], w[7]};
    pf[0] = __builtin_bit_cast(bf16x8, t0); pf[1] = __builtin_bit_cast(bf16x8, t1);
}
__device__ __forceinline__ void exp_pack(const f32x16& e, bf16x8 (&pf)[2]) {
    unsigned w[8];
#pragma unroll
    for (int i = 0; i < 8; ++i) w[i] = cvt_pk_bf16(__builtin_amdgcn_exp2f(e[2 * i]), __builtin_amdgcn_exp2f(e[2 * i + 1]));
    u32x4 t0 = {w[0], w[1], w[2], w[3]}, t1 = {w[4], w[5], w[6], w[7]};
    pf[0] = __builtin_bit_cast(bf16x8, t0); pf[1] = __builtin_bit_cast(bf16x8, t1);
}
__device__ __forceinline__ f32x16 bcast16(float v) { f32x16 r;
#pragma unroll
    for (int i = 0; i < 16; ++i) r[i] = v;
    return r; }

__device__ __forceinline__ void tile_transpose(float* reg, const f32x16& acc, const float add, const int c, const int hh, const int lane, f32x4 (&out)[4]) {
    asm volatile("" ::: "memory");
#pragma unroll
    for (int g4 = 0; g4 < 4; ++g4) { f32x4 v = {acc[4 * g4 + 0] + add, acc[4 * g4 + 1] + add, acc[4 * g4 + 2] + add, acc[4 * g4 + 3] + add}; *(f32x4*)(reg + c * 36 + 8 * g4 + 4 * hh) = v; }
    asm volatile("" ::: "memory");
    const int t = lane >> 1, half = lane & 1;
#pragma unroll
    for (int j = 0; j < 4; ++j) out[j] = *(const f32x4*)(reg + t * 36 + half * 16 + 4 * j);
    asm volatile("" ::: "memory");
}

constexpr int WAVE_LDS = 14336;
typedef short s16x4 __attribute__((ext_vector_type(4)));
constexpr int VTROW = 40;
__device__ __forceinline__ void attn_wave_item(const Params& p, unsigned char* lds, const int b, const int h, const int qb64) {
    const bf16_t* proj = (const bf16_t*)(p.ws + OFF_PROJ); bf16_t* yb = (bf16_t*)(p.ws + OFF_Y);
    int tid = threadIdx.x; asm volatile("" : "+v"(tid)); const int lane = tid & 63, wave = __builtin_amdgcn_readfirstlane(tid >> 6), c = lane & 31, hh = lane >> 5;
    bf16_t* Kw = (bf16_t*)(lds + wave * WAVE_LDS);
    LAS unsigned char* Vw = (LAS unsigned char*)lds + wave * WAVE_LDS + 4608;
    const size_t tokbase = (size_t)b * SEQ; const int tq0 = qb64 * 64;
    bf16x8 qfA[4], qfB[4];
    { const bf16_t* qp = proj + (tokbase + tq0 + c) * NPROJ + C_Q + h * 64 + hh * 8;
#pragma unroll
      for (int ks = 0; ks < 4; ++ks) { qfA[ks] = *(const bf16x8*)(qp + ks * 16); qfB[ks] = *(const bf16x8*)(qp + (size_t)32 * NPROJ + ks * 16); } }
    f16x8 uf[2];
#pragma unroll
    for (int ks2 = 0; ks2 < 2; ++ks2)
#pragma unroll
        for (int jj = 0; jj < 8; ++jj) { const int key = 16 * ks2 + 8 * (jj >> 2) + 4 * hh + (jj & 3); uf[ks2][jj] = (key >= c) ? (_Float16)-1.0f : (_Float16)0.0f; }
    f32x16 oA0 = bcast16(0.f), oA1 = bcast16(0.f), oB0 = bcast16(0.f), oB1 = bcast16(0.f);
    float RA = 0.f, RB = 0.f;
    unsigned troff[2];
    { const int blk = (lane >> 4) & 1, q = (lane & 15) >> 2, pp = lane & 3, sw = (q >> 1) & 1;
#pragma unroll
      for (int dt = 0; dt < 2; ++dt) troff[dt] = (unsigned)((4 * hh + q) * 128 + 64 * (dt ^ sw) + 16 * (2 * blk + (pp >> 1)) + 8 * (pp & 1)); }
    const int lkey = lane >> 3, lch = lane & 7;
    const bf16_t* kvbase = proj + (tokbase + lkey) * NPROJ + h * 64 + lch * 8;
    u32x4 kreg[4], vreg[4];
#pragma unroll
    for (int j = 0; j < 4; ++j) { const bf16_t* rp = kvbase + (size_t)(tq0 + 32 + 8 * j) * NPROJ; kreg[j] = *(const u32x4*)(rp + C_K); vreg[j] = *(const u32x4*)(rp + C_VB); }
#pragma unroll
    for (int ks = 0; ks < 4; ++ks) { asm volatile("" : "+v"(qfA[ks])); asm volatile("" : "+v"(qfB[ks])); }
    bool doneA = false, doneB = false;
#define ATT_QK(Z, QF) do { Z = bcast16(0.f); _Pragma("unroll") for (int ks = 0; ks < 4; ++ks) { const bf16x8 kf = *(const bf16x8*)(Kw + c * KROW + ks * 16 + hh * 8); Z = __builtin_amdgcn_mfma_f32_32x32x16_bf16(kf, QF[ks], Z, 0, 0, 0); } } while (0)
#define ATT_MASK(Z) do { _Pragma("unroll") for (int r = 0; r < 16; ++r) { const int sl = (r & 3) + 8 * (r >> 2) + 4 * hh; Z[r] = (sl >= c) ? -__builtin_inff() : Z[r]; } } while (0)
#define ATT_BACK(Z, RR, O0, O1, V0A, V1A, V0B, V1B) do { f16x8 lf[2]; softplus_pack(Z, lf); f32x16 e = Z + RR; \
        e = __builtin_amdgcn_mfma_f32_32x32x16_f16(uf[0], lf[0], e, 0, 0, 0); e = __builtin_amdgcn_mfma_f32_32x32x16_f16(uf[1], lf[1], e, 0, 0, 0); \
        bf16x8 pf[2]; exp_pack(e, pf); \
        { const float z0 = Z[0]; const float cum0 = (z0 == -__builtin_inff()) ? RR : (e[0] - z0); \
          const auto rr = __builtin_amdgcn_permlane32_swap(__float_as_uint(cum0), __float_as_uint(cum0), false, false); RR = __uint_as_float(rr[0]); } \
        O0 = __builtin_amdgcn_mfma_f32_32x32x16_bf16(V0A, pf[0], O0, 0, 0, 0); O1 = __builtin_amdgcn_mfma_f32_32x32x16_bf16(V1A, pf[0], O1, 0, 0, 0); \
        O0 = __builtin_amdgcn_mfma_f32_32x32x16_bf16(V0B, pf[1], O0, 0, 0, 0); O1 = __builtin_amdgcn_mfma_f32_32x32x16_bf16(V1B, pf[1], O1, 0, 0, 0); } while (0)
    for (int ks0 = tq0 + 32; ks0 >= 0; ks0 -= 32) {
        asm volatile("" ::: "memory");
#pragma unroll
        for (int j = 0; j < 4; ++j) { const int key = lkey + 8 * j;
            *(u32x4*)(Kw + key * KROW + lch * 8) = kreg[j];
            *(LAS u32x4*)(Vw + key * 128 + 16 * (lch ^ (((key >> 1) & 1) << 2))) = vreg[j]; }
        asm volatile("" ::: "memory");
        if (ks0 >= 32) {
#pragma unroll
            for (int j = 0; j < 4; ++j) { const bf16_t* rp = kvbase + (size_t)(ks0 - 32 + 8 * j) * NPROJ; kreg[j] = *(const u32x4*)(rp + C_K); vreg[j] = *(const u32x4*)(rp + C_VB); }
        }
        bf16x8 v00, v10, v01, v11;
        { const s16x4 a0 = __builtin_amdgcn_ds_read_tr16_b64_v4i16((LAS s16x4*)(Vw + troff[0])), a1 = __builtin_amdgcn_ds_read_tr16_b64_v4i16((LAS s16x4*)(Vw + troff[0] + 1024));
          const s16x4 b0 = __builtin_amdgcn_ds_read_tr16_b64_v4i16((LAS s16x4*)(Vw + troff[1])), b1 = __builtin_amdgcn_ds_read_tr16_b64_v4i16((LAS s16x4*)(Vw + troff[1] + 1024));
          const s16x4 c0 = __builtin_amdgcn_ds_read_tr16_b64_v4i16((LAS s16x4*)(Vw + troff[0] + 2048)), c1 = __builtin_amdgcn_ds_read_tr16_b64_v4i16((LAS s16x4*)(Vw + troff[0] + 3072));
          const s16x4 d0 = __builtin_amdgcn_ds_read_tr16_b64_v4i16((LAS s16x4*)(Vw + troff[1] + 2048)), d1 = __builtin_amdgcn_ds_read_tr16_b64_v4i16((LAS s16x4*)(Vw + troff[1] + 3072));
          v00 = (bf16x8){a0[0], a0[1], a0[2], a0[3], a1[0], a1[1], a1[2], a1[3]}; v10 = (bf16x8){b0[0], b0[1], b0[2], b0[3], b1[0], b1[1], b1[2], b1[3]};
          v01 = (bf16x8){c0[0], c0[1], c0[2], c0[3], c1[0], c1[1], c1[2], c1[3]}; v11 = (bf16x8){d0[0], d0[1], d0[2], d0[3], d1[0], d1[1], d1[2], d1[3]}; }
        if (ks0 < tq0 && !doneA && !doneB) {
            f32x16 zA, zB; ATT_QK(zA, qfA); ATT_QK(zB, qfB);
            ATT_BACK(zB, RB, oB0, oB1, v00, v10, v01, v11);
            ATT_BACK(zA, RA, oA0, oA1, v00, v10, v01, v11);
        } else {
            if (!doneB) { f32x16 zB; ATT_QK(zB, qfB); if (ks0 == tq0 + 32) ATT_MASK(zB); ATT_BACK(zB, RB, oB0, oB1, v00, v10, v01, v11); }
            if (!doneA && ks0 <= tq0) { f32x16 zA; ATT_QK(zA, qfA); if (ks0 == tq0) ATT_MASK(zA); ATT_BACK(zA, RA, oA0, oA1, v00, v10, v01, v11); }
        }
        doneB = doneB || (__builtin_amdgcn_ballot_w64(RB > -140.0f) == 0ull);
        doneA = doneA || (ks0 <= tq0 && __builtin_amdgcn_ballot_w64(RA > -140.0f) == 0ull);
        if (doneA && doneB) break;
    }
#undef ATT_QK
#undef ATT_MASK
#undef ATT_BACK
    float* reg = (float*)(lds + wave * WAVE_LDS + 9728);
#pragma unroll
    for (int g = 0; g < 2; ++g) {
      const int t = lane >> 1, half = lane & 1; const size_t tok = tokbase + tq0 + 32 * g + t;
      const bf16_t* zp = proj + tok * NPROJ + C_ZB + h * 64 + half * 16; bf16_t* yp = yb + tok * D_MODEL + 512 + h * 64 + half * 16;
      u32x4 zz[2][2];
#pragma unroll
      for (int dt = 0; dt < 2; ++dt) { zz[dt][0] = *(const u32x4*)(zp + dt * 32); zz[dt][1] = *(const u32x4*)(zp + dt * 32 + 8); }
#pragma unroll
      for (int dt = 0; dt < 2; ++dt) { f32x4 ov[4]; tile_transpose(reg, g ? (dt ? oB1 : oB0) : (dt ? oA1 : oA0), 0.f, c, hh, lane, ov);
#pragma unroll
          for (int q = 0; q < 2; ++q) { const u32x4 z4 = zz[dt][q]; const f32x4 a = ov[2 * q], b2 = ov[2 * q + 1]; u32x4 o;
              o[0] = cvt_pk_bf16(bflo(z4[0]) * a[0], bfhi(z4[0]) * a[1]); o[1] = cvt_pk_bf16(bflo(z4[1]) * a[2], bfhi(z4[1]) * a[3]);
              o[2] = cvt_pk_bf16(bflo(z4[2]) * b2[0], bfhi(z4[2]) * b2[1]); o[3] = cvt_pk_bf16(bflo(z4[3]) * b2[2], bfhi(z4[3]) * b2[3]);
              *(u32x4*)(yp + dt * 32 + 8 * q) = o; } } }
}

constexpr int VROW = 136;
__device__ __forceinline__ void sgu_item(const Params& p, unsigned char* lds, const int ch, const int hf) {
    const bf16_t* proj = (const bf16_t*)(p.ws + OFF_PROJ); bf16_t* yb = (bf16_t*)(p.ws + OFF_Y); const bf16_t* wsp = (const bf16_t*)(p.ws + OFF_WSP);
    int tid = threadIdx.x; asm volatile("" : "+v"(tid)); const int lane = tid & 63, wave = __builtin_amdgcn_readfirstlane(tid >> 6), c = lane & 31, hh = lane >> 5;
    bf16_t* vw = (bf16_t*)(lds + wave * WAVE_LDS);
    const size_t tok0 = (size_t)ch * CHUNK;
    const int g = hf * 4 + (wave >> 1), ct = wave & 1, ch0 = g * 64 + ct * 32;
    u32x4 vv[2][4]; f32x4 st[2][4];
#pragma unroll
    for (int i = 0; i < 2; ++i) { const bf16_t* vp = proj + (tok0 + lane + 64 * i) * NPROJ + C_V + ch0; const float* sp = (const float*)(p.ws + OFF_VST) + (tok0 + lane + 64 * i) * 16;
#pragma unroll
        for (int j = 0; j < 4; ++j) { vv[i][j] = *(const u32x4*)(vp + 8 * j); st[i][j] = *(const f32x4*)(sp + 4 * j); } }
    bf16x8 wf[20];
#pragma unroll
    for (int tt = 0; tt < 4; ++tt) {
#pragma unroll
        for (int ks = 0; ks < 2 * (tt + 1); ++ks) wf[tt * (tt + 1) + ks] = *(const bf16x8*)(wsp + ((size_t)(((g * 4 + tt) * 8 + ks) * 64 + lane)) * 8); }
#pragma unroll
    for (int i = 0; i < 2; ++i) { const int sidx = lane + 64 * i;
        const float s1 = ((st[i][0][0] + st[i][0][2]) + (st[i][1][0] + st[i][1][2])) + ((st[i][2][0] + st[i][2][2]) + (st[i][3][0] + st[i][3][2]));
        const float s2 = ((st[i][0][1] + st[i][0][3]) + (st[i][1][1] + st[i][1][3])) + ((st[i][2][1] + st[i][2][3]) + (st[i][3][1] + st[i][3][3]));
        const float mean = s1 * (1.0f / 512.f); const float var = fmaxf(s2 * (1.0f / 512.f) - mean * mean, 0.f); const float rstd = 1.0f / sqrtf(var + LN_EPS);
#pragma unroll
        for (int j = 0; j < 4; ++j)
#pragma unroll
            for (int e = 0; e < 4; ++e) { const int cl = 8 * j + 2 * e; const unsigned w = vv[i][j][e];
                const float a = (bflo(w) - mean) * rstd * p.sgu_g[ch0 + cl] + p.sgu_b[ch0 + cl], bb = (bfhi(w) - mean) * rstd * p.sgu_g[ch0 + cl + 1] + p.sgu_b[ch0 + cl + 1];
                vw[cl * VROW + sidx] = f2bf(a); vw[(cl + 1) * VROW + sidx] = f2bf(bb); } }
    asm volatile("" ::: "memory");
    const bf16_t* vrow = vw + c * VROW + hh * 8;
    float* reg = (float*)(lds + wave * WAVE_LDS + 9728);
#pragma unroll
    for (int tt = 0; tt < 4; ++tt) {
        const float bs = p.b_sp[g * CHUNK + tt * 32 + c];
        const int t2 = lane >> 1, half = lane & 1; const size_t tok = tok0 + tt * 32 + t2;
        const bf16_t* up = proj + tok * NPROJ + C_U + ch0 + half * 16; const bf16_t* zp = proj + tok * NPROJ + C_ZA + ch0 + half * 16; bf16_t* yp = yb + tok * D_MODEL + ch0 + half * 16;
        const u32x4 u0 = *(const u32x4*)(up), u1 = *(const u32x4*)(up + 8), z0 = *(const u32x4*)(zp), z1 = *(const u32x4*)(zp + 8);
        f32x16 acc = bcast16(0.f);
#pragma unroll
        for (int ks = 0; ks < 2 * (tt + 1); ++ks) { const bf16x8 af = *(const bf16x8*)(vrow + ks * 16); acc = __builtin_amdgcn_mfma_f32_32x32x16_bf16(af, wf[tt * (tt + 1) + ks], acc, 0, 0, 0); }
        f32x4 mv[4]; tile_transpose(reg, acc, bs, c, hh, lane, mv);
#pragma unroll
        for (int q = 0; q < 2; ++q) { const u32x4 uu = q ? u1 : u0, zz = q ? z1 : z0; const f32x4 a = mv[2 * q], b2 = mv[2 * q + 1]; u32x4 o;
            o[0] = cvt_pk_bf16(bflo(zz[0]) * bflo(uu[0]) * a[0], bfhi(zz[0]) * bfhi(uu[0]) * a[1]); o[1] = cvt_pk_bf16(bflo(zz[1]) * bflo(uu[1]) * a[2], bfhi(zz[1]) * bfhi(uu[1]) * a[3]);
            o[2] = cvt_pk_bf16(bflo(zz[2]) * bflo(uu[2]) * b2[0], bfhi(zz[2]) * bfhi(uu[2]) * b2[1]); o[3] = cvt_pk_bf16(bflo(zz[3]) * bflo(uu[3]) * b2[2], bfhi(zz[3]) * bfhi(uu[3]) * b2[3]);
            *(u32x4*)(yp + 8 * q) = o; }
    }
    asm volatile("" ::: "memory");
}

__device__ void p_mixers(const Params& p, unsigned char* lds) {
    const int wave = __builtin_amdgcn_readfirstlane((int)threadIdx.x >> 6);
    for (int it = blockIdx.x; it < 256; it += gridDim.x) {
        const int xcd = it & 7, slot = it >> 3; const int bh = xcd * 8 + (slot >> 2), pr = slot & 3;
        if (wave < 4) sgu_item(p, lds, it >> 1, it & 1);
        attn_wave_item(p, lds, bh >> 3, bh & 7, wave * 4 + pr);
        if (wave >= 4) sgu_item(p, lds, it >> 1, it & 1);
    }
}

__device__ void p_ln(const Params& p) {
    int tid = threadIdx.x; asm volatile("" : "+v"(tid)); const int lane = tid & 63, wave = tid >> 6;
    for (int row = blockIdx.x * 8 + wave; row < NTOK; row += gridDim.x * 8) {
        float* rp = p.out + (size_t)row * D_MODEL; f32x4 v[4]; float s = 0.f;
#pragma unroll
        for (int j = 0; j < 4; ++j) { v[j] = *(const f32x4*)(rp + lane * 4 + 256 * j); s += (v[j][0] + v[j][1]) + (v[j][2] + v[j][3]); }
#pragma unroll
        for (int o = 32; o; o >>= 1) s += __shfl_xor(s, o);
        const float mu = s * (1.0f / 1024.f); float q = 0.f;
#pragma unroll
        for (int j = 0; j < 4; ++j) { const f32x4 d = v[j] - mu; q += (d[0] * d[0] + d[1] * d[1]) + (d[2] * d[2] + d[3] * d[3]); }
#pragma unroll
        for (int o = 32; o; o >>= 1) q += __shfl_xor(q, o);
        const float rstd = 1.0f / sqrtf(q * (1.0f / 1024.f) + LN_EPS);
#pragma unroll
        for (int j = 0; j < 4; ++j) { const int col = lane * 4 + 256 * j; const f32x4 g = *(const f32x4*)(p.ln_g + col), bb = *(const f32x4*)(p.ln_b + col);
            *(f32x4*)(rp + col) = (v[j] - mu) * rstd * g + bb; }
    }
}

#if MODE == 0
__global__ void __launch_bounds__(NT, 2) mega(Params p) {
    extern __shared__ __attribute__((aligned(16))) unsigned char lds[];
    volatile LAS unsigned* st = (volatile LAS unsigned*)((LAS unsigned char*)lds + 131072);
    if (threadIdx.x == 0) { st[0] = 0u; st[1] = 0u; st[2] = 0u; st[3] = 0u; }
    __syncthreads();
    const XcdBarrier bar = xcd_barrier_post(g_bar, st);
    if (p.pad == 0x7fffffff) cg::this_grid().sync();
    p0_prologue(p, lds); xcd_barrier(bar);
    p_hconv(p); xcd_barrier(bar);
    p_inproj(p, lds); xcd_barrier(bar);
    p_mixers(p, lds); xcd_barrier(bar);
    const bool fused = (gridDim.x == 256);
    p_outproj(p, lds, bar, fused);
    if (!fused) { xcd_barrier(bar); p_ln(p); }
    xcd_barrier_retire(g_bar);
}
#else
__global__ void __launch_bounds__(NT, 2) mega(Params p) { extern __shared__ __attribute__((aligned(16))) unsigned char lds[]; p0_prologue(p, lds); }
__global__ void __launch_bounds__(NT, 2) k_ph1(Params p) { p_hconv(p); }
__global__ void __launch_bounds__(NT, 2) k_ph2(Params p) { extern __shared__ __attribute__((aligned(16))) unsigned char lds[]; p_inproj(p, lds); }
__global__ void __launch_bounds__(NT, 2) k_ph3(Params p) { extern __shared__ __attribute__((aligned(16))) unsigned char lds[]; p_mixers(p, lds); }
__global__ void __launch_bounds__(NT, 2) k_ph4(Params p) { extern __shared__ __attribute__((aligned(16))) unsigned char lds[]; XcdBarrier bar{}; p_outproj(p, lds, bar, false); }
__global__ void __launch_bounds__(NT, 2) k_ph5(Params p) { p_ln(p); }
#endif

extern "C" void kernel_launch(void* const* d_in, const int* in_sizes, int n_in, void* d_out, int out_size, void* d_ws, size_t ws_size, hipStream_t stream) {
    static int grid_blocks = 0;
    if (!grid_blocks) {
        int dev = 0, cus = 0, per_cu = 0;
        (void)hipGetDevice(&dev);
        (void)hipDeviceGetAttribute(&cus, hipDeviceAttributeMultiprocessorCount, dev);
        if (hipFuncSetAttribute((const void*)mega, hipFuncAttributeMaxDynamicSharedMemorySize, LDS_BYTES) != hipSuccess) fprintf(stderr, "hipFuncSetAttribute failed\n");
        if (hipOccupancyMaxActiveBlocksPerMultiprocessor(&per_cu, (const void*)mega, NT, LDS_BYTES) != hipSuccess || per_cu < 1) { fprintf(stderr, "occupancy query: %d\n", per_cu); per_cu = 1; }
        (void)hipGetLastError();
        if (per_cu > 1) per_cu = 1;
        grid_blocks = cus * per_cu;
    }
    Params p{};
    p.x = (const float*)d_in[0]; p.c = (const float*)d_in[1]; p.w_ada = (const float*)d_in[2]; p.b_ada = (const float*)d_in[3]; p.w_in = (const float*)d_in[4];
    p.sgu_g = (const float*)d_in[5]; p.sgu_b = (const float*)d_in[6]; p.w_sp = (const float*)d_in[7]; p.b_sp = (const float*)d_in[8]; p.w_out = (const float*)d_in[9];
    p.ln_g = (const float*)d_in[10]; p.ln_b = (const float*)d_in[11]; p.out = (float*)d_out; p.ws = (unsigned char*)d_ws; p.phase = 0; p.pad = 0;
#if MODE == 0
    void* args[] = {&p};
    hipError_t e = hipLaunchCooperativeKernel((const void*)mega, dim3(grid_blocks), dim3(NT), args, LDS_BYTES, stream);
    if (e != hipSuccess) fprintf(stderr, "cooperative launch failed: %s (grid %d)\n", hipGetErrorString(e), grid_blocks);
#else
    hipFuncSetAttribute((const void*)k_ph2, hipFuncAttributeMaxDynamicSharedMemorySize, LDS_BYTES);
    hipFuncSetAttribute((const void*)k_ph3, hipFuncAttributeMaxDynamicSharedMemorySize, LDS_BYTES);
    hipFuncSetAttribute((const void*)k_ph4, hipFuncAttributeMaxDynamicSharedMemorySize, LDS_BYTES);
    hipLaunchKernelGGL(mega, dim3(grid_blocks), dim3(NT), LDS_BYTES, stream, p);
    hipLaunchKernelGGL(k_ph1, dim3(grid_blocks), dim3(NT), 0, stream, p);
    hipLaunchKernelGGL(k_ph2, dim3(grid_blocks), dim3(NT), LDS_BYTES, stream, p);
    hipLaunchKernelGGL(k_ph3, dim3(grid_blocks), dim3(NT), LDS_BYTES, stream, p);
    hipLaunchKernelGGL(k_ph4, dim3(grid_blocks), dim3(NT), LDS_BYTES, stream, p);
    hipLaunchKernelGGL(k_ph5, dim3(grid_blocks), dim3(NT), 0, stream, p);
#endif
}
```
